# Optimizing an MI355X kernel written in HIP

```python
import jax, jax.numpy as jnp
from jax import lax
import numpy as np

D_MODEL = 1024
BATCH = 8
SEQ = 4096
DEPTH = 2

N_EVEN = (DEPTH + 1) // 2
N_ODD = DEPTH // 2
EPS = 1e-6

D_RNN = D_MODEL // 2
RNN_BLOCKS = 8
RNN_BLOCK_W = D_RNN // RNN_BLOCKS
CONV_W = 4
RGLRU_C = 8.0
FOX_HEADS = 8
FOX_HEAD_DIM = 64
D_FOX = FOX_HEADS * FOX_HEAD_DIM
Q_BLOCK = 128
EVEN_PROJ = 2 * D_RNN + 3 * D_FOX + FOX_HEADS
EVEN_MIX = D_RNN + D_FOX
GLA_HEADS = 4
GLA_DK = D_MODEL // 2
GLA_DV = D_MODEL
GLA_HEAD_DK = GLA_DK // GLA_HEADS
GLA_HEAD_DV = GLA_DV // GLA_HEADS
GATE_RANK = 16
GATE_TAU = 16.0
GLA_CHUNK = 64
ODD_PROJ = 2 * GLA_DK + 2 * GLA_DV + GATE_RANK
N_EXPERTS = 32
N_GROUPS = 4
EXPERTS_PER_GROUP = N_EXPERTS // N_GROUPS
TOP_K = 2
D_EXPERT = D_MODEL // 2
ROUTE_BLOCK = 128

kernel_name = 'hybrid_rglru_fox_gla_grouped_moe_adaln'

F32 = jnp.float32


def rms_norm(x, gain):
    xf = x.astype(F32)
    xf = xf * lax.rsqrt(jnp.mean(xf * xf, axis=-1, keepdims=True) + EPS)
    return (xf * gain.astype(F32)).astype(x.dtype)


def causal_depthwise_conv(x, w, bias):
    ch = x.shape[-1]
    y = lax.conv_general_dilated(x, w[:, None, :], window_strides=(1,), padding=[(CONV_W - 1, 0)],
                                 dimension_numbers=('NWC', 'WIO', 'NWC'), feature_group_count=ch)
    return y + bias


def _linear_combine(left, right):
    a1, b1 = left
    a2, b2 = right
    return a1 * a2, a2 * b1 + b2


def rg_lru(x, r_w, r_b, i_w, i_b, lam):
    b, s, _ = x.shape
    xb = x.reshape(b, s, RNN_BLOCKS, RNN_BLOCK_W)
    r = jax.nn.sigmoid(jnp.einsum('bsnd,nde->bsne', xb, r_w.astype(F32)) + r_b.astype(F32)).reshape(b, s, D_RNN)
    gi = jax.nn.sigmoid(jnp.einsum('bsnd,nde->bsne', xb, i_w.astype(F32)) + i_b.astype(F32)).reshape(b, s, D_RNN)
    log_a = -RGLRU_C * jax.nn.softplus(-lam.astype(F32)) * r
    a = jnp.exp(log_a)
    u = jnp.sqrt(-jnp.expm1(2.0 * log_a)) * (gi * x)
    _, h = lax.associative_scan(_linear_combine, (a, u), axis=1)
    return h


def fox_attention(q, k, v, log_f):
    b, h, s, hd = q.shape
    n_blk = s // Q_BLOCK
    cum = jnp.cumsum(log_f, axis=-1)
    scale = hd ** -0.5
    q_blocks = jnp.moveaxis(q.reshape(b, h, n_blk, Q_BLOCK, hd), 2, 0)
    c_blocks = jnp.moveaxis(cum.reshape(b, h, n_blk, Q_BLOCK), 2, 0)
    k_pos = jnp.arange(s)

    def one_block(args):
        idx, qb, cb = args
        logits = jnp.einsum('bhqd,bhkd->bhqk', qb, k) * scale
        logits = logits + (cb[..., :, None] - cum[..., None, :])
        q_pos = idx * Q_BLOCK + jnp.arange(Q_BLOCK)
        causal = k_pos[None, :] <= q_pos[:, None]
        p = jax.nn.softmax(jnp.where(causal, logits, -jnp.inf), axis=-1)
        return jnp.einsum('bhqk,bhkd->bhqd', p, v)

    out = lax.map(one_block, (jnp.arange(n_blk), q_blocks, c_blocks))
    return jnp.moveaxis(out, 0, 2).reshape(b, h, s, hd)


def gla_chunked(q, k, v, log_g):
    b, h, s, dk = q.shape
    dv = v.shape[-1]
    n = s // GLA_CHUNK
    q = q.reshape(b, h, n, GLA_CHUNK, dk) * (dk ** -0.5)
    k = k.reshape(b, h, n, GLA_CHUNK, dk)
    v = v.reshape(b, h, n, GLA_CHUNK, dv)
    cum = jnp.cumsum(log_g.reshape(b, h, n, GLA_CHUNK, dk), axis=3)
    last = cum[:, :, :, -1:, :]
    q_t = q * jnp.exp(cum)
    k_t = k * jnp.exp(-cum)
    k_end = k * jnp.exp(last - cum)
    mask = jnp.tril(jnp.ones((GLA_CHUNK, GLA_CHUNK), dtype=bool))
    intra = jnp.where(mask, jnp.einsum('bhnqd,bhnkd->bhnqk', q_t, k_t), 0.0)
    o_intra = jnp.einsum('bhnqk,bhnkv->bhnqv', intra, v)
    kv = jnp.einsum('bhnkd,bhnkv->bhndv', k_end, v)
    decay = jnp.exp(last[:, :, :, 0, :])

    def step(state, inp):
        dec, kv_n = inp
        return state * dec[..., None] + kv_n, state

    _, states = lax.scan(step, jnp.zeros((b, h, dk, dv), F32), (jnp.moveaxis(decay, 2, 0), jnp.moveaxis(kv, 2, 0)))
    states = jnp.moveaxis(states, 0, 2)
    o_inter = jnp.einsum('bhnqd,bhndv->bhnqv', q_t, states)
    return (o_intra + o_inter).reshape(b, h, s, dv)


def even_mixer(h, w_in, conv_w, conv_b, r_w, r_b, i_w, i_b, lam, forget_b, q_gain, k_gain, w_out):
    b, s, _ = h.shape
    proj = (h @ w_in).astype(F32)
    splits = np.cumsum([D_RNN, D_RNN, D_FOX, D_FOX, D_FOX]).tolist()
    x_rnn, gate_rnn, q, k, v, f_logit = jnp.split(proj, splits, axis=-1)
    x_rnn = causal_depthwise_conv(x_rnn, conv_w.astype(F32), conv_b.astype(F32))
    y_rnn = rg_lru(x_rnn, r_w, r_b, i_w, i_b, lam) * jax.nn.gelu(gate_rnn)
    def heads(t):
        return t.reshape(b, s, FOX_HEADS, FOX_HEAD_DIM).transpose(0, 2, 1, 3)
    qh = rms_norm(heads(q), q_gain)
    kh = rms_norm(heads(k), k_gain)
    log_f = jax.nn.log_sigmoid(f_logit + forget_b.astype(F32)).transpose(0, 2, 1)
    y_fox = fox_attention(qh, kh, heads(v), log_f).transpose(0, 2, 1, 3).reshape(b, s, D_FOX)
    y = jnp.concatenate([y_rnn, y_fox], axis=-1).astype(h.dtype)
    return y @ w_out


def odd_mixer(h, w_in, gate_w2, gate_b, out_gain, w_out):
    b, s, _ = h.shape
    proj = (h @ w_in).astype(F32)
    splits = np.cumsum([GLA_DK, GLA_DK, GLA_DV, GLA_DV]).tolist()
    q, k, v, r, g_low = jnp.split(proj, splits, axis=-1)
    log_g = jax.nn.log_sigmoid(g_low @ gate_w2.astype(F32) + gate_b.astype(F32)) / GATE_TAU
    def heads(t, d):
        return t.reshape(b, s, GLA_HEADS, d).transpose(0, 2, 1, 3)
    o = gla_chunked(heads(q, GLA_HEAD_DK), heads(k, GLA_HEAD_DK), heads(v, GLA_HEAD_DV), heads(log_g, GLA_HEAD_DK))
    o = rms_norm(o, out_gain).transpose(0, 2, 1, 3).reshape(b, s, GLA_DV)
    y = (o * jax.nn.silu(r)).astype(h.dtype)
    return y @ w_out


def moe_ffn(h, router_w, router_b, w1, w3, w2):
    b, s, d = h.shape
    t = h.reshape(-1, d)
    n_tok = t.shape[0]
    scores = jax.nn.sigmoid(t.astype(F32) @ router_w.astype(F32))
    sel = (scores + router_b.astype(F32)).reshape(n_tok, N_GROUPS, EXPERTS_PER_GROUP)
    group_score = lax.top_k(sel, 2)[0].sum(-1)
    g_idx = jnp.argmax(group_score, axis=-1)
    in_group = jnp.take_along_axis(sel, g_idx[:, None, None], axis=1)[:, 0]
    _, local = lax.top_k(in_group, TOP_K)
    e_idx = g_idx[:, None] * EXPERTS_PER_GROUP + local
    gw = jnp.take_along_axis(scores, e_idx, axis=-1)
    gw = gw / jnp.sum(gw, axis=-1, keepdims=True)
    m = n_tok * TOP_K
    flat_e = e_idx.reshape(-1)
    flat_tok = jnp.repeat(jnp.arange(n_tok), TOP_K)
    flat_w = gw.reshape(-1)
    order = jnp.argsort(flat_e)
    e_sorted = flat_e[order]
    tok_sorted = flat_tok[order]
    counts = jnp.bincount(flat_e, length=N_EXPERTS)
    starts = jnp.cumsum(counts) - counts
    padded = (counts + ROUTE_BLOCK - 1) // ROUTE_BLOCK * ROUTE_BLOCK
    pend = jnp.cumsum(padded)
    pstarts = pend - padded
    dest = pstarts[e_sorted] + (jnp.arange(m) - starts[e_sorted])
    n_blocks = -(-m // ROUTE_BLOCK) + N_EXPERTS
    p_len = n_blocks * ROUTE_BLOCK
    x_pad = jnp.zeros((p_len, d), t.dtype).at[dest].set(t[tok_sorted])
    blk_e = jnp.minimum(jnp.searchsorted(pend, jnp.arange(n_blocks) * ROUTE_BLOCK, side='right'), N_EXPERTS - 1)

    def run_block(args):
        xb, e = args
        hid = jax.nn.silu(xb @ w1[e]) * (xb @ w3[e])
        return hid @ w2[e]

    y_pad = lax.map(run_block, (x_pad.reshape(n_blocks, ROUTE_BLOCK, d), blk_e)).reshape(p_len, d)
    y_sorted = y_pad[dest].astype(F32) * flat_w[order][:, None]
    out = jax.ops.segment_sum(y_sorted, tok_sorted, num_segments=n_tok)
    return out.astype(h.dtype).reshape(b, s, d)


def setup_inputs(seed: int = 0) -> dict:
    key = jax.random.key(seed)
    ks = iter(jax.random.split(key, 64))

    def nrm(shape, scale):
        return jax.random.normal(next(ks), shape, F32) * scale

    u = jax.random.uniform(next(ks), (N_EVEN, D_RNN), F32, 0.9, 0.999)
    a0 = u ** (1.0 / RGLRU_C)
    ev_lam = jnp.log(a0) - jnp.log1p(-a0)
    ev_forget_b = jnp.broadcast_to(jnp.linspace(1.0, 5.0, FOX_HEADS, dtype=F32), (N_EVEN, FOX_HEADS)) + nrm((N_EVEN, FOX_HEADS), 0.1)
    return {
        'x': nrm((BATCH, SEQ, D_MODEL), 1.0),
        'c': nrm((BATCH, D_MODEL), 1.0),
        'router_w': nrm((D_MODEL, N_EXPERTS), D_MODEL ** -0.5),
        'router_b': nrm((N_EXPERTS,), 0.01),
        'ada_w': nrm((DEPTH, D_MODEL, 6 * D_MODEL), 0.5 * D_MODEL ** -0.5),
        'ada_b': nrm((DEPTH, 6 * D_MODEL), 0.02),
        'norm_mix': 1.0 + nrm((DEPTH, D_MODEL), 0.02),
        'norm_ffn': 1.0 + nrm((DEPTH, D_MODEL), 0.02),
        'ev_w_in': nrm((N_EVEN, D_MODEL, EVEN_PROJ), D_MODEL ** -0.5),
        'ev_conv_w': nrm((N_EVEN, CONV_W, D_RNN), 0.5),
        'ev_conv_b': nrm((N_EVEN, D_RNN), 0.02),
        'ev_r_w': nrm((N_EVEN, RNN_BLOCKS, RNN_BLOCK_W, RNN_BLOCK_W), RNN_BLOCK_W ** -0.5),
        'ev_r_b': nrm((N_EVEN, RNN_BLOCKS, RNN_BLOCK_W), 0.02),
        'ev_i_w': nrm((N_EVEN, RNN_BLOCKS, RNN_BLOCK_W, RNN_BLOCK_W), RNN_BLOCK_W ** -0.5),
        'ev_i_b': nrm((N_EVEN, RNN_BLOCKS, RNN_BLOCK_W), 0.02),
        'ev_lam': ev_lam,
        'ev_forget_b': ev_forget_b,
        'ev_q_gain': 1.0 + nrm((N_EVEN, FOX_HEAD_DIM), 0.02),
        'ev_k_gain': 1.0 + nrm((N_EVEN, FOX_HEAD_DIM), 0.02),
        'ev_w_out': nrm((N_EVEN, EVEN_MIX, D_MODEL), EVEN_MIX ** -0.5),
        'od_w_in': nrm((N_ODD, D_MODEL, ODD_PROJ), D_MODEL ** -0.5),
        'od_gate_w2': nrm((N_ODD, GATE_RANK, GLA_DK), GATE_RANK ** -0.5),
        'od_gate_b': nrm((N_ODD, GLA_DK), 0.02),
        'od_out_gain': 1.0 + nrm((N_ODD, GLA_HEAD_DV), 0.02),
        'od_w_out': nrm((N_ODD, GLA_DV, D_MODEL), GLA_DV ** -0.5),
        'moe_w1': nrm((DEPTH, N_EXPERTS, D_MODEL, D_EXPERT), D_MODEL ** -0.5),
        'moe_w3': nrm((DEPTH, N_EXPERTS, D_MODEL, D_EXPERT), D_MODEL ** -0.5),
        'moe_w2': nrm((DEPTH, N_EXPERTS, D_EXPERT, D_MODEL), D_EXPERT ** -0.5),
    }


def reference(x, c, router_w, router_b, ada_w, ada_b, norm_mix, norm_ffn,
              ev_w_in, ev_conv_w, ev_conv_b, ev_r_w, ev_r_b, ev_i_w, ev_i_b, ev_lam, ev_forget_b,
              ev_q_gain, ev_k_gain, ev_w_out,
              od_w_in, od_gate_w2, od_gate_b, od_out_gain, od_w_out,
              moe_w1, moe_w3, moe_w2):
    for layer in range(DEPTH):
        mod = (jax.nn.silu(c) @ ada_w[layer] + ada_b[layer])[:, None, :]
        sh_m, sc_m, g_m, sh_f, sc_f, g_f = jnp.split(mod, 6, axis=-1)
        h = rms_norm(x, norm_mix[layer]) * (1.0 + sc_m) + sh_m
        j = layer // 2
        if layer % 2 == 0:
            y = even_mixer(h, ev_w_in[j], ev_conv_w[j], ev_conv_b[j], ev_r_w[j], ev_r_b[j], ev_i_w[j], ev_i_b[j],
                           ev_lam[j], ev_forget_b[j], ev_q_gain[j], ev_k_gain[j], ev_w_out[j])
        else:
            y = odd_mixer(h, od_w_in[j], od_gate_w2[j], od_gate_b[j], od_out_gain[j], od_w_out[j])
        x = (x + g_m * y).astype(x.dtype)
        h = rms_norm(x, norm_ffn[layer]) * (1.0 + sc_f) + sh_f
        x = (x + g_f * moe_ffn(h, router_w, router_b, moe_w1[layer], moe_w3[layer], moe_w2[layer])).astype(x.dtype)
    return x
```

```cpp
#include <hip/hip_runtime.h>
#include <cstdio>
#include <cstdint>

#define LAS __attribute__((address_space(3)))
typedef unsigned short bf16_t;
typedef float f32x4 __attribute__((ext_vector_type(4)));
typedef unsigned u32x4 __attribute__((ext_vector_type(4)));
typedef unsigned u32x2 __attribute__((ext_vector_type(2)));

namespace cfg {
constexpr int D = 1024, B = 8, S = 4096, T = B * S;
constexpr int D_RNN = 512, FH = 8, EVEN_PROJ = 2568, P0W = 2560;
constexpr int GH = 4, GDK = 512, HDK = 128, HDV = 256, ODD_PROJ = 3088, P1W = 3072;
constexpr int NE = 32, DE = 512, LCAP = 32768;
constexpr float EPS = 1e-6f, LOG2E = 1.4426950408889634f, C2 = 0.125f * LOG2E;
constexpr size_t MiB = 1u << 20;
constexpr size_t WS_CTL = 0;
constexpr size_t WS_MOD = 1 * MiB;
constexpr size_t WS_EIDX = 2 * MiB;
constexpr size_t WS_GW = 2 * MiB + 512 * 1024;
constexpr size_t WS_LOGF = 3 * MiB;
constexpr size_t WS_FB = 4 * MiB;
constexpr size_t WS_GLOW = 5 * MiB;
constexpr size_t WS_DECAY = 7 * MiB;
constexpr size_t WS_LIST = 8 * MiB;
constexpr size_t WS_WIN0T = 12 * MiB;
constexpr size_t WS_WOUT0T = 17 * MiB;
constexpr size_t WS_WIN1T = 19 * MiB;
constexpr size_t WS_WOUT1T = 25 * MiB;
constexpr size_t WS_W13T = 28 * MiB;
constexpr size_t WS_W2T = 156 * MiB;
constexpr size_t WS_XN = 220 * MiB;
constexpr size_t WS_YMIX = 284 * MiB;
constexpr size_t WS_AMAT = 348 * MiB;
constexpr size_t WS_PROJ = 364 * MiB;
constexpr size_t WS_HID = 364 * MiB;
constexpr size_t WS_YBUF = 436 * MiB;
constexpr size_t WS_END = 564 * MiB;
constexpr int CW_CNT = 0;
constexpr int CW_QUEUE = 64;
constexpr int CW_BAR = 4096;
constexpr size_t CTL_ZERO_BYTES = 64 * 1024;
}
using namespace cfg;

__device__ __forceinline__ float bf2f(bf16_t v) { return __uint_as_float((unsigned)v << 16); }
__device__ __forceinline__ unsigned f2bf(float f) { unsigned u = __float_as_uint(f); return (u + 0x7fffu + ((u >> 16) & 1u)) >> 16; }
__device__ __forceinline__ unsigned pk2(float lo, float hi) { return f2bf(lo) | (f2bf(hi) << 16); }
__device__ __forceinline__ float sigmoidf_(float x) { return 1.f / (1.f + __expf(-x)); }
__device__ __forceinline__ float siluf_(float x) { return x * sigmoidf_(x); }
__device__ __forceinline__ float softplusf_(float x) { return fmaxf(x, 0.f) + log1pf(__expf(-fabsf(x))); }
__device__ __forceinline__ float logsigmoidf_(float x) { return -softplusf_(-x); }
__device__ __forceinline__ float geluf_(float x) { return 0.5f * x * (1.f + tanhf(0.7978845608028654f * (x + 0.044715f * x * x * x))); }
__device__ __forceinline__ float wave_sum(float v) {
#pragma unroll
    for (int o = 1; o < 64; o <<= 1) v += __shfl_xor(v, o);
    return v;
}


#define XB_TMO      128
#define XB_XCNT(j)  (256  + 64 * (j))
#define XB_XSUB(j)  (1280 + 64 * (j))
#define XB_XGEN(j)  (2304 + 64 * (j))
#define XB_TOP      3328
#define XB_TOPGEN   3392
#define XCD_BAR_WORDS 3456
#define XB_SPIN_CAP (1u << 18)

__device__ __forceinline__ unsigned xb_ld(unsigned* p)              { return __hip_atomic_load(p, __ATOMIC_RELAXED, __HIP_MEMORY_SCOPE_AGENT); }
__device__ __forceinline__ unsigned xb_add(unsigned* p, unsigned v) { return __hip_atomic_fetch_add(p, v, __ATOMIC_RELAXED, __HIP_MEMORY_SCOPE_AGENT); }
__device__ __forceinline__ unsigned xb_xcc_id() { return (unsigned)__builtin_amdgcn_s_getreg((3 << 11) | 20) & 0xFu; }
#define XB_SPIN(cond, bar) do { unsigned _sp = 0; while (cond) { __builtin_amdgcn_s_sleep(1); \
    if ((++_sp & 255u) == 0u) { if (xb_ld(&(bar)[XB_TMO])) break; if (_sp > XB_SPIN_CAP) { atomicAdd(&(bar)[XB_TMO], 1u); break; } } } } while (0)

struct XcdBarrier {
    unsigned* bar; unsigned x;
    volatile LAS unsigned* st;
};

__device__ __forceinline__ XcdBarrier xcd_barrier_post(unsigned* bar, volatile LAS unsigned* st) {
    XcdBarrier b; b.bar = bar; b.x = xb_xcc_id(); b.st = st;
    if (threadIdx.x == 0) (void)xb_add(&bar[XB_XCNT(b.x)], 1u);
    return b;
}
__device__ __forceinline__ void xcd_barrier_complete(unsigned* bar, unsigned x, unsigned& nloc, unsigned& nx) {
    const unsigned G = gridDim.x * gridDim.y * gridDim.z;
    unsigned sum, cnt, mine, sp = 0u;
    for (;;) {
        sum = 0u; cnt = 0u; mine = 0u;
#pragma unroll
        for (unsigned j = 0; j < 16; ++j) { const unsigned c = xb_ld(&bar[XB_XCNT(j)]); sum += c; cnt += (c > 0u) ? 1u : 0u; mine = (j == x) ? c : mine; }
        if (sum == G) break;
        __builtin_amdgcn_s_sleep(1);
        if ((++sp & 255u) == 0u) { if (xb_ld(&bar[XB_TMO])) break; if (sp > XB_SPIN_CAP) { atomicAdd(&bar[XB_TMO], 1u); break; } }
    }
    nloc = mine > 0u ? mine : 1u; nx = cnt > 0u ? cnt : 1u;
}

__device__ __forceinline__ void xcd_barrier(const XcdBarrier& b) {
    asm volatile("s_waitcnt vmcnt(0)" ::: "memory");
    __syncthreads();
    if (threadIdx.x == 0) {
        unsigned* bar = b.bar;
        __builtin_amdgcn_s_waitcnt(0);
        unsigned nloc = b.st[0], nx = b.st[1];
        if (nloc == 0u) { xcd_barrier_complete(bar, b.x, nloc, nx); b.st[0] = nloc; b.st[1] = nx; }
        const unsigned old = xb_add(&bar[XB_XSUB(b.x)], 1u);
        const unsigned gen = old / nloc;
        if (old + 1u == (gen + 1u) * nloc) {
            __builtin_amdgcn_fence(__ATOMIC_RELEASE, "agent");
            asm volatile("s_waitcnt vmcnt(0)" ::: "memory");
            const unsigned og = xb_add(&bar[XB_TOP], 1u);
            const unsigned tg = og / nx;
            if (og + 1u == (tg + 1u) * nx) xb_add(&bar[XB_TOPGEN], 1u);
            else XB_SPIN(xb_ld(&bar[XB_TOPGEN]) == tg, bar);
            __builtin_amdgcn_fence(__ATOMIC_ACQUIRE, "agent");
            xb_add(&bar[XB_XGEN(b.x)], 1u);
            asm volatile("s_waitcnt vmcnt(0)" ::: "memory");
        } else {
            XB_SPIN(xb_ld(&bar[XB_XGEN(b.x)]) == gen, bar);
            __builtin_amdgcn_fence(__ATOMIC_ACQUIRE, "agent");
            asm volatile("s_waitcnt vmcnt(0)" ::: "memory");
        }
    }
    __syncthreads();
}


namespace nk {
__device__ __forceinline__ void route_pick(const float* sel, const float* sc, int& e1, int& e2, float& w1, float& w2) {
    int bg = 0; float bgs = -INFINITY;
    for (int g = 0; g < 4; ++g) {
        float m1 = -INFINITY, m2 = -INFINITY;
        for (int i = 0; i < 8; ++i) { const float v = sel[g * 8 + i]; if (v > m1) { m2 = m1; m1 = v; } else if (v > m2) m2 = v; }
        if (m1 + m2 > bgs) { bgs = m1 + m2; bg = g; }
    }
    int i1 = 0; float v1 = -INFINITY;
    for (int i = 0; i < 8; ++i) if (sel[bg * 8 + i] > v1) { v1 = sel[bg * 8 + i]; i1 = i; }
    int i2 = 0; float v2 = -INFINITY;
    for (int i = 0; i < 8; ++i) if (i != i1 && sel[bg * 8 + i] > v2) { v2 = sel[bg * 8 + i]; i2 = i; }
    e1 = bg * 8 + i1; e2 = bg * 8 + i2; const float s1 = sc[e1], s2 = sc[e2], inv = 1.f / (s1 + s2); w1 = s1 * inv; w2 = s2 * inv;
}
template <int MODE> __global__ void __launch_bounds__(256) k_rownorm(const float* xin, float* res, const bf16_t* ybuf, const float* gw_in, const float* modl_prev,
        const float* gain, const float* modl, int sh_off, int sc_off, bf16_t* xn, const float* wext, int ldw, int col0, const float* fbias, float* ext_out,
        const float* rw, const float* rb, int* eidx, float* gw_out, unsigned* cnt, int* list) {
    const int t = blockIdx.x, b = t / S, tid = threadIdx.x;
    __shared__ float hrow[D]; __shared__ float red[256]; __shared__ float sc[32], sel[32];
    float v[4]; float ss = 0.f;
    for (int i = 0; i < 4; ++i) {
        const int col = tid + 256 * i; float x = xin[(size_t)t * D + col];
        if (MODE == 2) {
            const float y0 = bf2f(ybuf[((size_t)t * 2) * D + col]), y1 = bf2f(ybuf[((size_t)t * 2 + 1) * D + col]);
            x = x + modl_prev[(size_t)b * 6 * D + 5 * D + col] * (gw_in[t * 2] * y0 + gw_in[t * 2 + 1] * y1);
            res[(size_t)t * D + col] = x;
        }
        v[i] = x; ss += x * x;
    }
    red[tid] = ss; __syncthreads();
    for (int o = 128; o > 0; o >>= 1) { if (tid < o) red[tid] += red[tid + o]; __syncthreads(); }
    const float rstd = rsqrtf(red[0] / D + EPS);
    const float* m = modl + (size_t)b * 6 * D;
    for (int i = 0; i < 4; ++i) { const int col = tid + 256 * i; const float h = v[i] * rstd * gain[col] * (1.f + m[sc_off + col]) + m[sh_off + col]; hrow[col] = h; xn[(size_t)t * D + col] = (bf16_t)f2bf(h); }
    __syncthreads();
    if (MODE == 0 || MODE == 2) {
        const int NX = (MODE == 0) ? 8 : 16;
        if (tid < NX * 16) {
            const int j = tid / 16, part = tid % 16; float a = 0.f;
            for (int k = part * 64; k < part * 64 + 64; ++k) a += hrow[k] * wext[(size_t)k * ldw + col0 + j];
            for (int o = 1; o < 16; o <<= 1) a += __shfl_xor(a, o);
            if (part == 0) ext_out[(size_t)t * NX + j] = (MODE == 0) ? logsigmoidf_(a + fbias[j]) : a;
        }
    }
    if (MODE == 1) {
        const int e = tid / 8, part = tid % 8; float a = 0.f;
        for (int k = part * 128; k < part * 128 + 128; ++k) a += hrow[k] * rw[k * NE + e];
        for (int o = 1; o < 8; o <<= 1) a += __shfl_xor(a, o);
        if (part == 0) { const float s = sigmoidf_(a); sc[e] = s; sel[e] = s + rb[e]; }
        __syncthreads();
        if (tid == 0) {
            int e1, e2; float w1, w2; route_pick(sel, sc, e1, e2, w1, w2);
            eidx[t * 2] = e1; eidx[t * 2 + 1] = e2; gw_out[t * 2] = w1; gw_out[t * 2 + 1] = w2;
            const unsigned p1 = atomicAdd(&cnt[e1], 1u); list[e1 * LCAP + p1] = t * 2;
            const unsigned p2 = atomicAdd(&cnt[e2], 1u); list[e2 * LCAP + p2] = t * 2 + 1;
        }
    }
}
__host__ __device__ __forceinline__ int win0_row(int n) { const int lc = n & 255, wc = lc >> 6, bj = (lc >> 5) & 1, j = lc & 31; return (n & ~255) + 128 * bj + 32 * wc + j; }
template <int MODE> __global__ void __launch_bounds__(256) k_gemm(const bf16_t* A, int lda, const bf16_t* Bt, int K, void* Cv, int ldc, const float* X, const float* g,
                                                                  const unsigned* cnt, const int* list) {
    const int bx = blockIdx.x, by = blockIdx.y, e = blockIdx.z, tid = threadIdx.x;
    int n_e = 0, hid0 = 0;
    if (MODE >= 3) { n_e = (int)cnt[e]; if (by * 64 >= n_e) return; for (int i = 0; i < e; ++i) hid0 += ((int)cnt[i] + 255) / 256 * 256; Bt += (size_t)e * (MODE == 3 ? 1024 * 1024 : 1024 * 512); }
    __shared__ float As[16][65], Bs[16][65], B3s[MODE == 3 ? 16 : 1][65];
    const int tr = tid / 16, tc = tid % 16, lr = tid / 4, lk = (tid % 4) * 4;
    float acc[4][4] = {}, acc3[4][4] = {};
    long arow; bool av = true;
    if (MODE == 3) { const int r = by * 64 + lr; av = r < n_e; arow = av ? (list[e * LCAP + r] >> 1) : 0; }
    else if (MODE == 4) { arow = hid0 + by * 64 + lr; }
    else arow = (long)by * 64 + lr;
    int brow, brow3 = 0;
    { const int n = bx * 64 + lr; if (MODE == 0) brow = win0_row(n); else if (MODE == 3) { brow = 256 * (n / 128) + (n % 128); brow3 = brow + 128; } else brow = n; }
    for (int k0 = 0; k0 < K; k0 += 16) {
        u32x2 a = av ? *(const u32x2*)(A + (size_t)arow * lda + k0 + lk) : u32x2{0u, 0u};
        As[lk + 0][lr] = __uint_as_float(a.x << 16); As[lk + 1][lr] = __uint_as_float(a.x & 0xffff0000u); As[lk + 2][lr] = __uint_as_float(a.y << 16); As[lk + 3][lr] = __uint_as_float(a.y & 0xffff0000u);
        u32x2 w = *(const u32x2*)(Bt + (size_t)brow * K + k0 + lk);
        Bs[lk + 0][lr] = __uint_as_float(w.x << 16); Bs[lk + 1][lr] = __uint_as_float(w.x & 0xffff0000u); Bs[lk + 2][lr] = __uint_as_float(w.y << 16); Bs[lk + 3][lr] = __uint_as_float(w.y & 0xffff0000u);
        if (MODE == 3) { u32x2 w3 = *(const u32x2*)(Bt + (size_t)brow3 * K + k0 + lk);
            B3s[lk + 0][lr] = __uint_as_float(w3.x << 16); B3s[lk + 1][lr] = __uint_as_float(w3.x & 0xffff0000u); B3s[lk + 2][lr] = __uint_as_float(w3.y << 16); B3s[lk + 3][lr] = __uint_as_float(w3.y & 0xffff0000u); }
        __syncthreads();
#pragma unroll
        for (int k = 0; k < 16; ++k) {
            float a4[4], b4[4], c4[4];
            for (int i = 0; i < 4; ++i) { a4[i] = As[k][tr * 4 + i]; b4[i] = Bs[k][tc * 4 + i]; if (MODE == 3) c4[i] = B3s[k][tc * 4 + i]; }
            for (int i = 0; i < 4; ++i) for (int j = 0; j < 4; ++j) { acc[i][j] += a4[i] * b4[j]; if (MODE == 3) acc3[i][j] += a4[i] * c4[j]; }
        }
        __syncthreads();
    }
    for (int i = 0; i < 4; ++i) {
        const int r = by * 64 + tr * 4 + i; long orow = r;
        if (MODE == 3) { if (r >= n_e) continue; orow = hid0 + r; }
        if (MODE == 4) { if (r >= n_e) continue; orow = list[e * LCAP + r]; }
        for (int j = 0; j < 4; ++j) {
            const int col = bx * 64 + tc * 4 + j; float v = acc[i][j];
            if (MODE == 2) { const int b = r / S; ((float*)Cv)[(size_t)orow * ldc + col] = X[(size_t)r * ldc + col] + g[(size_t)b * 6 * D + col] * v; }
            else { if (MODE == 3) v = siluf_(v) * acc3[i][j]; ((bf16_t*)Cv)[(size_t)orow * ldc + col] = (bf16_t)f2bf(v); }
        }
    }
}
__global__ void __launch_bounds__(1024) k_qknorm(bf16_t* proj, const float* qg, const float* kg) {
    const int t = blockIdx.x, hh = threadIdx.x >> 6, d = threadIdx.x & 63;
    bf16_t* p = proj + (size_t)t * P0W + 1024 + hh * 64;
    const float x = bf2f(p[d]); const float ss = wave_sum(x * x);
    p[d] = (bf16_t)f2bf(x * rsqrtf(ss / 64.f + EPS) * (hh < 8 ? qg[d] * C2 : kg[d]));
}
__global__ void k_cumf(const float* logf, float* fb) {
    const int bh = threadIdx.x; if (bh >= 64) return; const int b = bh >> 3, h = bh & 7; float c = 0.f;
    for (int s = 0; s < S; ++s) { c += logf[((size_t)b * S + s) * 8 + h]; fb[(size_t)bh * S + s] = -LOG2E * c; }
}
__global__ void __launch_bounds__(64) k_rnn(const bf16_t* proj, const float* cw, const float* cb, const float* rw, const float* rb, const float* iw, const float* ib, const float* lam, bf16_t* ymix) {
    const int b = blockIdx.y, n = blockIdx.x, e = threadIdx.x, ch = n * 64 + e;
    __shared__ float xc[64];
    float wr[64], wi[64];
    for (int d = 0; d < 64; ++d) { wr[d] = rw[(n * 64 + d) * 64 + e]; wi[d] = iw[(n * 64 + d) * 64 + e]; }
    const float c0 = cw[ch], c1 = cw[D_RNN + ch], c2 = cw[2 * D_RNN + ch], c3 = cw[3 * D_RNN + ch], bias = cb[ch], rbe = rb[ch], ibe = ib[ch];
    const float la = -8.0f * softplusf_(-lam[ch]);
    float x0 = 0.f, x1 = 0.f, x2 = 0.f, h = 0.f;
    const bf16_t* p = proj + (size_t)b * S * P0W;
    for (int t = 0; t < S; ++t) {
        const float x3 = bf2f(p[(size_t)t * P0W + ch]);
        const float x = bias + c0 * x0 + c1 * x1 + c2 * x2 + c3 * x3; x0 = x1; x1 = x2; x2 = x3;
        xc[e] = x; __syncthreads();
        float r = rbe, g = ibe;
        for (int d = 0; d < 64; ++d) { const float xv = xc[d]; r += xv * wr[d]; g += xv * wi[d]; }
        __syncthreads();
        r = sigmoidf_(r); g = sigmoidf_(g);
        const float log_a = la * r, a = __expf(log_a), u = sqrtf(fmaxf(1.f - __expf(2.f * log_a), 0.f)) * (g * x);
        h = a * h + u;
        ymix[((size_t)b * S + t) * D + ch] = (bf16_t)f2bf(h * geluf_(bf2f(p[(size_t)t * P0W + D_RNN + ch])));
    }
}
__global__ void __launch_bounds__(64) k_fox(const bf16_t* proj, const float* fb, bf16_t* ymix) {
    const int b = blockIdx.z, h = blockIdx.y, t = blockIdx.x * 64 + threadIdx.x;
    __shared__ float Ks[64][64], Vs[64][64], Cs[64];
    const bf16_t* p = proj + (size_t)b * S * P0W; const float* fbh = fb + ((size_t)b * 8 + h) * S;
    float q[64], o[64];
    for (int d = 0; d < 64; ++d) { q[d] = bf2f(p[(size_t)t * P0W + 1024 + h * 64 + d]); o[d] = 0.f; }
    float m = -INFINITY, l = 0.f;
    for (int s0 = 0; s0 <= (int)blockIdx.x * 64; s0 += 64) {
        __syncthreads();
        for (int i = threadIdx.x; i < 64 * 64; i += 64) { const int r = i >> 6, d = i & 63; Ks[r][d] = bf2f(p[(size_t)(s0 + r) * P0W + 1536 + h * 64 + d]); Vs[r][d] = bf2f(p[(size_t)(s0 + r) * P0W + 2048 + h * 64 + d]); }
        Cs[threadIdx.x] = fbh[s0 + threadIdx.x];
        __syncthreads();
        for (int r = 0; r < 64; ++r) {
            if (s0 + r > t) break;
            float sc = Cs[r];
            for (int d = 0; d < 64; ++d) sc += q[d] * Ks[r][d];
            const float mn = fmaxf(m, sc), f = exp2f(m - mn), pp = exp2f(sc - mn);
            l = l * f + pp;
            for (int d = 0; d < 64; ++d) o[d] = o[d] * f + pp * Vs[r][d];
            m = mn;
        }
    }
    const float il = 1.f / l;
    for (int d = 0; d < 64; ++d) ymix[((size_t)b * S + t) * D + D_RNN + h * 64 + d] = (bf16_t)f2bf(o[d] * il);
}
__global__ void __launch_bounds__(256) k_gla(const bf16_t* proj, const float* glow, const float* w2, const float* gb, bf16_t* o) {
    const int b = blockIdx.z, h = blockIdx.y, vs = blockIdx.x, dv = threadIdx.x & 31, dg = threadIdx.x >> 5;
    float Sreg[16]; for (int i = 0; i < 16; ++i) Sreg[i] = 0.f;
    __shared__ float part[8][32]; __shared__ float w2s[16][128];
    for (int i = threadIdx.x; i < 16 * 128; i += 256) w2s[i / 128][i % 128] = w2[(i / 128) * GDK + h * 128 + (i % 128)];
    __syncthreads();
    const float qs = 0.08838834764831845f;
    for (int t = 0; t < S; ++t) {
        const size_t row = (size_t)b * S + t; const bf16_t* pr = proj + row * P1W; const float v = bf2f(pr[1024 + h * 256 + vs * 32 + dv]); float po = 0.f;
        float gl[16]; for (int j = 0; j < 16; ++j) gl[j] = glow[row * 16 + j];
        for (int i = 0; i < 16; ++i) {
            const int dkl = dg * 16 + i, dk = h * 128 + dkl; float z = gb[dk];
            for (int j = 0; j < 16; ++j) z += gl[j] * w2s[j][dkl];
            const float al = __expf(logsigmoidf_(z) * (1.f / 16.f));
            Sreg[i] = al * Sreg[i] + bf2f(pr[512 + dk]) * v; po += bf2f(pr[dk]) * qs * Sreg[i];
        }
        part[dg][dv] = po; __syncthreads();
        if (dg == 0) { float s = 0.f; for (int g = 0; g < 8; ++g) s += part[g][dv]; o[row * D + h * 256 + vs * 32 + dv] = (bf16_t)f2bf(s); }
        __syncthreads();
    }
}
__global__ void __launch_bounds__(256) k_glapost(const bf16_t* o, const bf16_t* proj, const float* gain, bf16_t* y) {
    const int t = blockIdx.x, h = blockIdx.y, v = threadIdx.x;
    const float x = bf2f(o[(size_t)t * D + h * 256 + v]);
    __shared__ float red[256]; red[v] = x * x; __syncthreads();
    for (int s = 128; s > 0; s >>= 1) { if (v < s) red[v] += red[v + s]; __syncthreads(); }
    const float rstd = rsqrtf(red[0] / 256.f + EPS);
    y[(size_t)t * D + h * 256 + v] = (bf16_t)f2bf(x * rstd * gain[v] * siluf_(bf2f(proj[(size_t)t * P1W + 2048 + h * 256 + v])));
}
__global__ void k_final(const float* x, const bf16_t* ybuf, const float* gw, const float* modl, float* out) {
    const size_t i = (size_t)blockIdx.x * 256 + threadIdx.x; const int t = (int)(i / D), col = (int)(i % D), b = t / S;
    out[i] = x[i] + modl[(size_t)b * 6 * D + 5 * D + col] * (gw[t * 2] * bf2f(ybuf[((size_t)t * 2) * D + col]) + gw[t * 2 + 1] * bf2f(ybuf[((size_t)t * 2 + 1) * D + col]));
}
}


namespace pg8 {
typedef short bf16x8 __attribute__((ext_vector_type(8)));
constexpr int BM = 256, BK = 64, HALF = 128, HTB = HALF * BK * 2, STAGE_BYTES = 8 * HTB, NXCD = 8;
__host__ __device__ __forceinline__ int lds_byte(int r, int c) { const int st = (r >> 4) * 2 + (c >> 5), rr = r & 15, cc = c & 31, ob = rr * 64 + cc * 2; return st * 1024 + (ob ^ (((ob >> 9) & 1) << 5)); }
__host__ __device__ __forceinline__ void stage_rc(int b, int& R, int& C) { const int st = b / 1024, sb = b % 1024, swz = sb ^ (((sb >> 9) & 1) << 5); R = (st >> 1) * 16 + swz / 64; C = (st & 1) * 32 + (swz % 64) / 2; }
__host__ __device__ __forceinline__ int perm32(int rho) { const int n = rho >> 4, i = rho & 15; return 8 * (i >> 2) + 4 * n + (i & 3); }
__device__ __forceinline__ unsigned cvt_pk_bf16(float lo, float hi) { unsigned r; asm volatile("v_cvt_pk_bf16_f32 %0, %1, %2" : "=v"(r) : "v"(lo), "v"(hi)); return r; }
__device__ __forceinline__ int xcd_remap(int L, int nwg) { const int q = nwg / NXCD, r = nwg % NXCD, xcd = L % NXCD, off = L / NXCD; return (xcd < r ? xcd * (q + 1) : r * (q + 1) + (xcd - r) * q) + off; }

struct Unit { int pm, pn, e, nrow; };

template <class Epi, class Sched, bool ALIGN_EPI>
__device__ __forceinline__ void gemm_phase(LAS unsigned char* lds, const char* Abase, const int K, const Sched& S, const Epi& E) {
    int tid = threadIdx.x; asm volatile("" : "+v"(tid));
    const int wid = __builtin_amdgcn_readfirstlane(tid >> 6), lane = tid & 63, wr = wid >> 2, wc = wid & 3, fr = lane & 15, fq = lane >> 4;
    const int nt = K / BK;
    int RA[2], CA[2]; unsigned voffB[2];
#pragma unroll
    for (int i = 0; i < 2; ++i) { int R, C; stage_rc(tid * 16 + i * 8192, R, C); const int Rb = Epi::PERM ? ((R & ~31) + perm32(R & 31)) : R; RA[i] = R; CA[i] = C; voffB[i] = (unsigned)(Rb * K + C) * 2u; }
    const size_t kstep = (size_t)(BK * 2);
    const size_t hstep = (size_t)HALF * K * 2;
    const unsigned ldsw = (unsigned)wid * 1024u;
    const int aoff = lds_byte(wr * 64 + fr, fq * 8), boff = lds_byte(wc * 32 + fr, fq * 8);
#define PG8_SA(b, h) (((b) * 2 + (h)) * HTB)
#define PG8_SB(b, h) ((4 + (b) * 2 + (h)) * HTB)
#define PG8_STAGE(bufoff, gbase, voff) do { _Pragma("unroll") for (int _i = 0; _i < 2; ++_i) \
        __builtin_amdgcn_global_load_lds((const unsigned*)((const char*)(gbase) + (voff)[_i]), (LAS unsigned*)(lds + (bufoff) + ldsw + _i * 8192), 16, 0, 0); } while (0)
#define PG8_LDA(dst, b, h) do { _Pragma("unroll") for (int m = 0; m < 4; ++m) _Pragma("unroll") for (int k = 0; k < 2; ++k) dst[m][k] = *(const LAS bf16x8*)(lds + PG8_SA(b, h) + aoff + m * 2048 + k * 1024); } while (0)
#define PG8_LDB(dst, b, h) do { _Pragma("unroll") for (int n = 0; n < 2; ++n) _Pragma("unroll") for (int k = 0; k < 2; ++k) dst[n][k] = *(const LAS bf16x8*)(lds + PG8_SB(b, h) + boff + n * 2048 + k * 1024); } while (0)
#define PG8_MMA(ai, bj, At, Bt) do { __builtin_amdgcn_s_setprio(1); _Pragma("unroll") for (int m = 0; m < 4; ++m) _Pragma("unroll") for (int n = 0; n < 2; ++n) _Pragma("unroll") for (int k = 0; k < 2; ++k) \
        acc[ai][bj][m][n] = __builtin_amdgcn_mfma_f32_16x16x32_bf16(Bt[n][k], At[m][k], acc[ai][bj][m][n], 0, 0, 0); __builtin_amdgcn_s_setprio(0); } while (0)
#define PG8_WAIT_V(n) asm volatile("s_waitcnt vmcnt(" #n ")" ::: "memory")
#define PG8_WAIT_L(n) asm volatile("s_waitcnt lgkmcnt(" #n ")" ::: "memory")
#define PG8_BAR __builtin_amdgcn_s_barrier()
#define PG8_SCHED __builtin_amdgcn_sched_barrier(0)
    Unit cur, nxt; int ui = 0;
    if (!S.next(0, cur)) return;
    f32x4 acc[2][2][4][2];
#pragma unroll
    for (int a = 0; a < 2; ++a)
#pragma unroll
        for (int b = 0; b < 2; ++b)
#pragma unroll
            for (int m = 0; m < 4; ++m)
#pragma unroll
                for (int n = 0; n < 2; ++n) acc[a][b][m][n] = (f32x4){0.f, 0.f, 0.f, 0.f};
    bf16x8 At[4][2], B0[2][2], B1[2][2];
    unsigned cvo[2][2], nvo[2][2];
    S.a_offs(cur, RA, CA, cvo);
    const char* cB = S.b_base(cur);
    PG8_STAGE(PG8_SB(0, 0), cB, voffB); PG8_STAGE(PG8_SB(0, 1), cB + hstep, voffB); PG8_STAGE(PG8_SA(0, 0), Abase, cvo[0]); PG8_STAGE(PG8_SA(0, 1), Abase, cvo[1]);
    if (wr == 1) PG8_BAR;
    PG8_WAIT_V(2); PG8_BAR;
    PG8_STAGE(PG8_SB(1, 0), cB + kstep, voffB); PG8_STAGE(PG8_SA(1, 0), Abase + kstep, cvo[0]); PG8_STAGE(PG8_SB(1, 1), cB + hstep + kstep, voffB);
    PG8_WAIT_V(6); PG8_BAR;
    for (;;) {
        const bool has_next = S.next(ui + 1, nxt);
        if (has_next) S.a_offs(nxt, RA, CA, nvo); else { nvo[0][0] = cvo[0][0]; nvo[0][1] = cvo[0][1]; nvo[1][0] = cvo[1][0]; nvo[1][1] = cvo[1][1]; }
        const char* nB = has_next ? S.b_base(nxt) : cB;
        for (int t = 0; t < nt; t += 2) {
            const bool last = (t == nt - 2);
            const char* a1 = Abase + (size_t)(t + 1) * kstep;
            const char* a2 = last ? Abase : Abase + (size_t)(t + 2) * kstep; const char* b2 = last ? nB : cB + (size_t)(t + 2) * kstep;
            const char* a3 = a2 + kstep; const char* b3 = b2 + kstep;
            unsigned vo2[2][2];
            vo2[0][0] = last ? nvo[0][0] : cvo[0][0]; vo2[0][1] = last ? nvo[0][1] : cvo[0][1]; vo2[1][0] = last ? nvo[1][0] : cvo[1][0]; vo2[1][1] = last ? nvo[1][1] : cvo[1][1];
            PG8_LDB(B0, 0, 0); PG8_LDB(B1, 0, 1); PG8_SCHED; PG8_LDA(At, 0, 0); PG8_STAGE(PG8_SA(1, 1), a1, cvo[1]);
            PG8_WAIT_V(8); PG8_WAIT_L(0); PG8_BAR; PG8_MMA(0, 0, At, B0); PG8_MMA(0, 1, At, B1); PG8_BAR; PG8_SCHED;
            PG8_LDA(At, 0, 1); PG8_STAGE(PG8_SB(0, 0), b2, voffB); PG8_STAGE(PG8_SB(0, 1), b2 + hstep, voffB); PG8_STAGE(PG8_SA(0, 0), a2, vo2[0]);
            PG8_WAIT_V(8); PG8_WAIT_L(0); PG8_BAR; PG8_MMA(1, 0, At, B0); PG8_MMA(1, 1, At, B1); PG8_BAR; PG8_SCHED;
            PG8_LDB(B0, 1, 0); PG8_LDB(B1, 1, 1); PG8_SCHED; PG8_LDA(At, 1, 0); PG8_STAGE(PG8_SA(0, 1), a2, vo2[1]);
            PG8_WAIT_V(8); PG8_WAIT_L(0); PG8_BAR; PG8_MMA(0, 0, At, B0); PG8_MMA(0, 1, At, B1); PG8_BAR; PG8_SCHED;
            PG8_LDA(At, 1, 1); PG8_STAGE(PG8_SB(1, 0), b3, voffB); PG8_STAGE(PG8_SB(1, 1), b3 + hstep, voffB); PG8_STAGE(PG8_SA(1, 0), a3, vo2[0]);
            PG8_WAIT_V(8); PG8_WAIT_L(0); PG8_BAR; PG8_MMA(1, 0, At, B0); PG8_MMA(1, 1, At, B1); PG8_BAR; PG8_SCHED;
        }
        if constexpr (ALIGN_EPI) { if (wr == 0) PG8_BAR; }
        E(acc, cur, wr, wc, fr, fq);
        if (!has_next) break;
#pragma unroll
        for (int a = 0; a < 2; ++a)
#pragma unroll
            for (int b = 0; b < 2; ++b)
#pragma unroll
                for (int m = 0; m < 4; ++m)
#pragma unroll
                    for (int n = 0; n < 2; ++n) acc[a][b][m][n] = (f32x4){0.f, 0.f, 0.f, 0.f};
        cur = nxt; cB = nB; ++ui;
        cvo[0][0] = nvo[0][0]; cvo[0][1] = nvo[0][1]; cvo[1][0] = nvo[1][0]; cvo[1][1] = nvo[1][1];
        if constexpr (ALIGN_EPI) { if (wr == 1) PG8_BAR; }
    }
    PG8_WAIT_V(0);
    if constexpr (!ALIGN_EPI) { if (wr == 0) PG8_BAR; }
    PG8_BAR;
#undef PG8_SA
#undef PG8_SB
#undef PG8_STAGE
#undef PG8_LDA
#undef PG8_LDB
#undef PG8_MMA
#undef PG8_WAIT_V
#undef PG8_WAIT_L
#undef PG8_BAR
#undef PG8_SCHED
}

struct DenseSched {
    int nM, nN, nwg, G, c, K; const char* Bt;
    __device__ __forceinline__ void init(int M, int N, int K_, const void* Bt_, int G_, int c_) { nM = M / BM; nN = N / BM; nwg = nM * nN; G = G_; c = c_; K = K_; Bt = (const char*)Bt_; }
    __device__ __forceinline__ bool next(int i, Unit& u) const {
        const long L = (long)i * G + c; if (L >= nwg) return false;
        const int wgid = xcd_remap((int)L, nwg);
        const int nig = 8 * nN, gid = wgid / nig, fm = gid * 8, gsz = (nM - fm) < 8 ? (nM - fm) : 8;
        u.pm = fm + ((wgid % nig) % gsz); u.pn = (wgid % nig) / gsz; u.e = 0; u.nrow = 256; return true;
    }
    __device__ __forceinline__ void a_offs(const Unit& u, const int (&RA)[2], const int (&CA)[2], unsigned (&vo)[2][2]) const {
#pragma unroll
        for (int h = 0; h < 2; ++h)
#pragma unroll
            for (int i = 0; i < 2; ++i) vo[h][i] = (unsigned)((u.pm * BM + h * HALF + RA[i]) * K + CA[i]) * 2u;
    }
    __device__ __forceinline__ const char* b_base(const Unit& u) const { return Bt + (size_t)u.pn * BM * K * 2; }
};
template <bool GATHER> struct MoeSched {
    const unsigned* cnt; const int* list; const char* Bt; size_t bstride; int K, G, c, ntile, nwg;
    LAS const int* tpre;
    __device__ __forceinline__ void init(const unsigned* cnt_, const int* list_, const void* Bt_, size_t bstride_, int K_, int G_, int c_, LAS int* tp) {
        cnt = cnt_; list = list_; Bt = (const char*)Bt_; bstride = bstride_; K = K_; G = G_; c = c_; tpre = tp;
        if (threadIdx.x == 0) { int p = 0; for (int e = 0; e < NE; ++e) { tp[e] = p; p += ((int)cnt_[e] + 255) >> 8; } tp[NE] = p; }
        __syncthreads();
        ntile = tp[NE]; nwg = ntile * 4;
    }
    __device__ __forceinline__ bool next(int i, Unit& u) const {
        const long L = (long)i * G + c; if (L >= nwg) return false;
        const int wgid = xcd_remap((int)L, nwg);
        u.pm = wgid >> 2; u.pn = wgid & 3;
        int e = 0;
#pragma unroll 1
        for (int j = 1; j < NE; ++j) if (tpre[j] <= u.pm) e = j;
        u.e = e; const int rt = u.pm - tpre[e]; const int left = (int)cnt[e] - rt * 256; u.nrow = left < 256 ? left : 256; return true;
    }
    __device__ __forceinline__ void a_offs(const Unit& u, const int (&RA)[2], const int (&CA)[2], unsigned (&vo)[2][2]) const {
        const int rt = u.pm - tpre[u.e];
#pragma unroll
        for (int h = 0; h < 2; ++h)
#pragma unroll
            for (int i = 0; i < 2; ++i) {
                const int r = h * HALF + RA[i];
                if (GATHER) { const int rr = r < u.nrow ? r : 0; const int ent = list[u.e * LCAP + rt * 256 + rr]; vo[h][i] = (unsigned)((ent >> 1) * K + CA[i]) * 2u; }
                else vo[h][i] = (unsigned)((u.pm * BM + r) * K + CA[i]) * 2u;
            }
    }
    __device__ __forceinline__ const char* b_base(const Unit& u) const { return Bt + (size_t)u.e * bstride + (size_t)u.pn * BM * K * 2; }
};

struct EpiProj0 {
    static constexpr bool PERM = true;
    bf16_t* O; const float* qg; const float* kg;
    __device__ __forceinline__ void operator()(const f32x4 (&acc)[2][2][4][2], const Unit& u, int wr, int wc, int fr, int fq) const {
        const int seg = u.pn >> 1;
        float gsc[2][2][4];
        const bool nrm = (seg == 2 || seg == 3);
        if (nrm) { const float* gp = (seg == 2) ? qg : kg; const float s = (seg == 2) ? C2 : 1.f;
#pragma unroll
            for (int bj = 0; bj < 2; ++bj)
#pragma unroll
                for (int n = 0; n < 2; ++n) { const f32x4 gv = *(const f32x4*)(gp + 32 * bj + 8 * fq + 4 * n); gsc[bj][n][0] = gv[0] * s; gsc[bj][n][1] = gv[1] * s; gsc[bj][n][2] = gv[2] * s; gsc[bj][n][3] = gv[3] * s; } }
        const int col0 = u.pn * BM + 64 * wc + 8 * fq;
#pragma unroll
        for (int ai = 0; ai < 2; ++ai)
#pragma unroll
            for (int m = 0; m < 4; ++m) {
                bf16_t* rowp = O + (size_t)(u.pm * BM + ai * HALF + wr * 64 + m * 16 + fr) * P0W + col0;
                float rs = 1.f;
                if (nrm) { float ss = 0.f;
#pragma unroll
                    for (int bj = 0; bj < 2; ++bj)
#pragma unroll
                        for (int n = 0; n < 2; ++n) { const f32x4 v = acc[ai][bj][m][n]; ss += (v[0] * v[0] + v[1] * v[1]) + (v[2] * v[2] + v[3] * v[3]); }
                    ss += __shfl_xor(ss, 16); ss += __shfl_xor(ss, 32); rs = rsqrtf(ss * (1.f / 64.f) + EPS); }
#pragma unroll
                for (int bj = 0; bj < 2; ++bj) { f32x4 v0 = acc[ai][bj][m][0], v1 = acc[ai][bj][m][1];
                    if (nrm) {
#pragma unroll
                        for (int q = 0; q < 4; ++q) { v0[q] = v0[q] * rs * gsc[bj][0][q]; v1[q] = v1[q] * rs * gsc[bj][1][q]; } }
                    u32x4 w; w.x = cvt_pk_bf16(v0[0], v0[1]); w.y = cvt_pk_bf16(v0[2], v0[3]); w.z = cvt_pk_bf16(v1[0], v1[1]); w.w = cvt_pk_bf16(v1[2], v1[3]);
                    *(u32x4*)(rowp + 32 * bj) = w; }
            }
    }
};
struct EpiBf16 {
    static constexpr bool PERM = true;
    bf16_t* O; int ldc;
    __device__ __forceinline__ void operator()(const f32x4 (&acc)[2][2][4][2], const Unit& u, int wr, int wc, int fr, int fq) const {
        const int col0 = u.pn * BM + wc * 32 + 8 * fq;
#pragma unroll
        for (int ai = 0; ai < 2; ++ai)
#pragma unroll
            for (int m = 0; m < 4; ++m) { bf16_t* rowp = O + (size_t)(u.pm * BM + ai * HALF + wr * 64 + m * 16 + fr) * ldc + col0;
#pragma unroll
                for (int bj = 0; bj < 2; ++bj) { const f32x4 v0 = acc[ai][bj][m][0], v1 = acc[ai][bj][m][1];
                    u32x4 w; w.x = cvt_pk_bf16(v0[0], v0[1]); w.y = cvt_pk_bf16(v0[2], v0[3]); w.z = cvt_pk_bf16(v1[0], v1[1]); w.w = cvt_pk_bf16(v1[2], v1[3]);
                    *(u32x4*)(rowp + bj * HALF) = w; } }
    }
};
struct EpiResid {
    static constexpr bool PERM = false;
    const float* X; float* O; const float* g;
    __device__ __forceinline__ void operator()(const f32x4 (&acc)[2][2][4][2], const Unit& u, int wr, int wc, int fr, int fq) const {
        const int col0 = u.pn * BM + wc * 32 + 4 * fq; const int b = (u.pm * BM) / S;
        f32x4 gv[2][2];
#pragma unroll
        for (int bj = 0; bj < 2; ++bj)
#pragma unroll
            for (int n = 0; n < 2; ++n) gv[bj][n] = *(const f32x4*)(g + (size_t)b * 6 * D + col0 + bj * HALF + n * 16);
#pragma unroll
        for (int ai = 0; ai < 2; ++ai)
#pragma unroll
            for (int m = 0; m < 4; ++m) { const size_t off = (size_t)(u.pm * BM + ai * HALF + wr * 64 + m * 16 + fr) * D + col0;
#pragma unroll
                for (int bj = 0; bj < 2; ++bj)
#pragma unroll
                    for (int n = 0; n < 2; ++n) { const f32x4 xv = *(const f32x4*)(X + off + bj * HALF + n * 16); *(f32x4*)(O + off + bj * HALF + n * 16) = xv + gv[bj][n] * acc[ai][bj][m][n]; } }
    }
};
struct EpiMoe1 {
    static constexpr bool PERM = true;
    bf16_t* H;
    __device__ __forceinline__ void operator()(const f32x4 (&acc)[2][2][4][2], const Unit& u, int wr, int wc, int fr, int fq) const {
        const int col0 = u.pn * 128 + wc * 32 + 8 * fq;
#pragma unroll
        for (int ai = 0; ai < 2; ++ai)
#pragma unroll
            for (int m = 0; m < 4; ++m) { bf16_t* rowp = H + (size_t)(u.pm * BM + ai * HALF + wr * 64 + m * 16 + fr) * DE + col0;
                float h[8];
#pragma unroll
                for (int n = 0; n < 2; ++n)
#pragma unroll
                    for (int q = 0; q < 4; ++q) { const float a = acc[ai][0][m][n][q], b3 = acc[ai][1][m][n][q]; h[n * 4 + q] = a * b3 * __builtin_amdgcn_rcpf(1.f + __expf(-a)); }
                u32x4 w; w.x = cvt_pk_bf16(h[0], h[1]); w.y = cvt_pk_bf16(h[2], h[3]); w.z = cvt_pk_bf16(h[4], h[5]); w.w = cvt_pk_bf16(h[6], h[7]);
                *(u32x4*)rowp = w; }
    }
};
struct EpiMoe2 {
    static constexpr bool PERM = true;
    bf16_t* Y; const int* list; LAS const int* tpre;
    __device__ __forceinline__ void operator()(const f32x4 (&acc)[2][2][4][2], const Unit& u, int wr, int wc, int fr, int fq) const {
        const int col0 = u.pn * BM + wc * 32 + 8 * fq; const int rt = u.pm - tpre[u.e];
#pragma unroll
        for (int ai = 0; ai < 2; ++ai)
#pragma unroll
            for (int m = 0; m < 4; ++m) { const int r = ai * HALF + wr * 64 + m * 16 + fr;
                if (r < u.nrow) { const int ent = list[u.e * LCAP + rt * 256 + r]; bf16_t* rowp = Y + (size_t)ent * D + col0;
#pragma unroll
                    for (int bj = 0; bj < 2; ++bj) { const f32x4 v0 = acc[ai][bj][m][0], v1 = acc[ai][bj][m][1];
                        u32x4 w; w.x = cvt_pk_bf16(v0[0], v0[1]); w.y = cvt_pk_bf16(v0[2], v0[3]); w.z = cvt_pk_bf16(v1[0], v1[1]); w.w = cvt_pk_bf16(v1[2], v1[3]);
                        *(u32x4*)(rowp + bj * HALF) = w; } } }
    }
};
}

constexpr int NWAVES = 8, NTHREADS = 512, LDS_BYTES = 163840;
constexpr bool OPT_GEMM = true, OPT_MOE = true, OPT_ROW = true, OPT_MIX0 = true, OPT_GLA = true;
struct Args { const float* in[28]; float* out; unsigned char* ws; int ph_lo, ph_hi; };
struct Frame {
    LAS unsigned char* lds; int tid, lane, wave, G, bid;
    float* out; unsigned char* ws;
};
constexpr int LDS_PTRS = LDS_BYTES - 512;
__device__ __forceinline__ const float* in_ptr(const Frame& F, int i) {
    const unsigned long long v = *(const volatile LAS unsigned long long*)(F.lds + LDS_PTRS + 8 * i);
    const unsigned lo = __builtin_amdgcn_readfirstlane((unsigned)v), hi = __builtin_amdgcn_readfirstlane((unsigned)(v >> 32));
    return (const float*)(((unsigned long long)hi << 32) | lo);
}
#define INP(i) in_ptr(F, (i))
__device__ __forceinline__ void frame_refresh(Frame& F) {
    int t = threadIdx.x; asm volatile("" : "+v"(t)); F.tid = t; F.lane = t & 63; F.wave = __builtin_amdgcn_readfirstlane(t >> 6);
}
enum { I_X = 0, I_C, I_RW, I_RB, I_ADAW, I_ADAB, I_NMIX, I_NFFN, I_EWIN, I_ECW, I_ECB, I_ERW, I_ERB, I_EIW, I_EIB, I_ELAM, I_EFB, I_EQG, I_EKG, I_EWOUT,
       I_OWIN, I_OGW2, I_OGB, I_OGAIN, I_OWOUT, I_W1, I_W3, I_W2 };

__device__ __forceinline__ void transpose_item(const float* W, int ldw, int k0, int n0, bf16_t* WT, int ldt, int drow0, LAS float* scr, int lane) {
#pragma unroll 8
    for (int i = 0; i < 32; ++i) { const int kk = 2 * i + (lane >> 5); scr[kk * 33 + (lane & 31)] = W[(size_t)(k0 + kk) * ldw + n0 + (lane & 31)]; }
    asm volatile("s_waitcnt lgkmcnt(0)" ::: "memory");
    const int c = lane & 7;
#pragma unroll
    for (int j = 0; j < 4; ++j) { const int n = (lane >> 3) + 8 * j; const LAS float* s = scr + (8 * c) * 33 + n;
        u32x4 o; o.x = pk2(s[0 * 33], s[1 * 33]); o.y = pk2(s[2 * 33], s[3 * 33]); o.z = pk2(s[4 * 33], s[5 * 33]); o.w = pk2(s[6 * 33], s[7 * 33]);
        *(u32x4*)(WT + (size_t)(drow0 + n) * ldt + k0 + 8 * c) = o; }
    asm volatile("s_waitcnt lgkmcnt(0)" ::: "memory");
}
__device__ __forceinline__ void ph_prologue(Frame& F) {
    if (F.bid < 192) {
        LAS float* sc = (LAS float*)F.lds;
        LAS float* red = (LAS float*)(F.lds + 32768);
        for (int i = F.tid; i < B * D; i += NTHREADS) sc[i] = siluf_(INP(I_C)[i]);
        __syncthreads();
        const int l = F.bid / 96, cb = F.bid % 96, col = cb * 64 + F.lane;
        const float* w = INP(I_ADAW) + (size_t)l * D * 6 * D + col;
        float acc[8] = {};
        for (int k = F.wave * 128; k < F.wave * 128 + 128; ++k) { const float wv = w[(size_t)k * 6 * D];
#pragma unroll
            for (int b = 0; b < 8; ++b) acc[b] += sc[b * D + k] * wv; }
#pragma unroll
        for (int b = 0; b < 8; ++b) red[(F.wave * 8 + b) * 64 + F.lane] = acc[b];
        __syncthreads();
        { const int b = F.tid >> 6, c = F.tid & 63; float s = INP(I_ADAB)[l * 6 * D + cb * 64 + c];
          for (int wv = 0; wv < 8; ++wv) s += red[(wv * 8 + b) * 64 + c];
          ((float*)(F.ws + WS_MOD))[((size_t)l * B + b) * 6 * D + cb * 64 + c] = s; }
        __syncthreads();
    }
    LAS float* scr = (LAS float*)(F.lds + F.wave * 8704);
    const int gw = F.bid * NWAVES + F.wave, NGW = F.G * NWAVES;
    constexpr int I0 = 16 * 80, I1 = 16 * 32, I2 = 16 * 96, I3 = 16 * 32, IM = 64 * 256;
    constexpr int NIT = I0 + I1 + I2 + I3 + 3 * IM;
    for (int it = gw; it < NIT; it += NGW) {
        int r = it;
        if (r < I0) { const int kb = r / 80, nb = r % 80, n0 = nb * 32; transpose_item(INP(I_EWIN), EVEN_PROJ, kb * 64, n0, (bf16_t*)(F.ws + WS_WIN0T), D, nk::win0_row(n0), scr, F.lane); continue; } r -= I0;
        if (r < I1) { const int kb = r / 32, nb = r % 32; transpose_item(INP(I_EWOUT), D, kb * 64, nb * 32, (bf16_t*)(F.ws + WS_WOUT0T), D, nb * 32, scr, F.lane); continue; } r -= I1;
        if (r < I2) { const int kb = r / 96, nb = r % 96; transpose_item(INP(I_OWIN), ODD_PROJ, kb * 64, nb * 32, (bf16_t*)(F.ws + WS_WIN1T), D, nb * 32, scr, F.lane); continue; } r -= I2;
        if (r < I3) { const int kb = r / 32, nb = r % 32; transpose_item(INP(I_OWOUT), D, kb * 64, nb * 32, (bf16_t*)(F.ws + WS_WOUT1T), D, nb * 32, scr, F.lane); continue; } r -= I3;
        if (r < 2 * IM) {
            const int which = r / IM; r -= which * IM; const int le = r / 256, q = r % 256, kb = q / 16, nb = q % 16, n0 = nb * 32;
            transpose_item(INP(which ? I_W3 : I_W1) + (size_t)le * D * DE, DE, kb * 64, n0, (bf16_t*)(F.ws + WS_W13T) + (size_t)le * 1024 * 1024, D, 256 * (n0 / 128) + (n0 % 128) + 128 * which, scr, F.lane); continue; }
        r -= 2 * IM;
        { const int le = r / 256, q = r % 256, kb = q / 32, nb = q % 32;
          transpose_item(INP(I_W2) + (size_t)le * DE * D, D, kb * 64, nb * 32, (bf16_t*)(F.ws + WS_W2T) + (size_t)le * 1024 * 512, DE, nb * 32, scr, F.lane); }
    }
}


namespace attn_body {
using bf16=unsigned short;
using bf16x8=__attribute__((ext_vector_type(8)))short;
using f32x4v=__attribute__((ext_vector_type(4)))float;
using s16x4=__attribute__((ext_vector_type(4)))short;
using f32x16=__attribute__((ext_vector_type(16)))float;
using u32x4=__attribute__((ext_vector_type(4)))unsigned;
constexpr int BATCH=8,NHEAD=8,SEQ=4096,D=64,DM=2560,DMO=1024;
constexpr int NW=8,QBLK=32,QB=QBLK*NW,KVBLK=64,NQB=SEQ/QB;
constexpr int ATTN_PITCH=DM, ATTN_UNIT_ROWS=QB;
__device__ __forceinline__ int crow(int r,int hi){return (r&3)+8*(r>>2)+4*hi;}
#define SBAR() __builtin_amdgcn_sched_barrier(0)
__device__ __forceinline__ void cmask(f32x16&p0,f32x16&p1,int jb,int qrel,int hi){
  const float NEG=-INFINITY; int kb=64*jb+4*hi;
  #pragma unroll
  for(int r=0;r<16;++r){int kv=kb+(r&3)+8*(r>>2); if(kv>qrel)p0[r]=NEG; if(kv+32>qrel)p1[r]=NEG;}
}

constexpr int NSLOT=3, SLOTB=8192;
constexpr int LDS_K=0, LDS_V=NSLOT*SLOTB, LDS_WS=2*NSLOT*SLOTB, LDS_OST=LDS_WS+NW*64*4, LDS_FB=LDS_OST+NW*4096, LDS_BYTES=LDS_FB+SEQ*4;
constexpr float C2=0.125f*1.4426950408889634f;
__device__ __forceinline__ void glds16(const void*gsrc,unsigned lds_dst){unsigned keep;
  asm volatile("s_mov_b32 %0, m0\n\ts_mov_b32 m0, %2\n\ts_nop 0\n\tglobal_load_lds_dwordx4 %1, off\n\ts_mov_b32 m0, %0":"=&s"(keep):"v"(gsrc),"s"(lds_dst):"memory");}
__device__ __forceinline__ float max3f(float a,float b,float c){float r;asm("v_max3_f32 %0, %1, %2, %3":"=v"(r):"v"(a),"v"(b),"v"(c));return r;}
__device__ __forceinline__ float max2f(float a,float b){float r;asm("v_max_f32_e32 %0, %1, %2":"=v"(r):"v"(a),"v"(b));return r;}
__device__ __forceinline__ float fadd_s(float a,float b){float r;asm("v_add_f32_e32 %0, %1, %2":"=v"(r):"v"(a),"v"(b));return r;}
__device__ __forceinline__ float fsub_s(float a,float b){float r;asm("v_sub_f32_e32 %0, %1, %2":"=v"(r):"v"(a),"v"(b));return r;}
typedef float f32x2_t __attribute__((ext_vector_type(2))); typedef __bf16 bf16x2_t __attribute__((ext_vector_type(2)));
__device__ __forceinline__ unsigned cvtpk_s(float lo,float hi){f32x2_t v={lo,hi};bf16x2_t b=__builtin_convertvector(v,bf16x2_t);return __builtin_bit_cast(unsigned,b);}
#define WAIT_BAR(N) asm volatile("s_waitcnt vmcnt(" #N ") lgkmcnt(0)\n\ts_barrier":::"memory")

__device__ __forceinline__ void qkt(f32x16&p0,f32x16&p1,const char*Kslot,const bf16x8*qr,const f32x16&negm,int r32,int hi){
  const char*kb=Kslot+hi*1024+r32*16;
  #pragma unroll
  for(int d0=0;d0<4;++d0){
    const bf16x8 b0=*reinterpret_cast<const bf16x8*>(kb+d0*2048);
    const bf16x8 b1=*reinterpret_cast<const bf16x8*>(kb+d0*2048+512);
    if(d0==0){p0=__builtin_amdgcn_mfma_f32_32x32x16_bf16(b0,qr[0],negm,0,0,0);p1=__builtin_amdgcn_mfma_f32_32x32x16_bf16(b1,qr[0],negm,0,0,0);}
    else{p0=__builtin_amdgcn_mfma_f32_32x32x16_bf16(b0,qr[d0],p0,0,0,0);p1=__builtin_amdgcn_mfma_f32_32x32x16_bf16(b1,qr[d0],p1,0,0,0);}}
}
typedef __attribute__((address_space(3))) const char* lds_cptr;
typedef short v4i16_t __attribute__((ext_vector_type(4)));
__device__ __forceinline__ void kload8(bf16x8*kf,lds_cptr kp){
  kf[0]=*(const __attribute__((address_space(3))) bf16x8*)(kp);      kf[1]=*(const __attribute__((address_space(3))) bf16x8*)(kp+512);
  kf[2]=*(const __attribute__((address_space(3))) bf16x8*)(kp+2048); kf[3]=*(const __attribute__((address_space(3))) bf16x8*)(kp+2560);
  kf[4]=*(const __attribute__((address_space(3))) bf16x8*)(kp+4096); kf[5]=*(const __attribute__((address_space(3))) bf16x8*)(kp+4608);
  kf[6]=*(const __attribute__((address_space(3))) bf16x8*)(kp+6144); kf[7]=*(const __attribute__((address_space(3))) bf16x8*)(kp+6656);
}
__device__ __forceinline__ void kload2(bf16x8*kf,lds_cptr kp,int j){ kf[2*j]=*(const __attribute__((address_space(3))) bf16x8*)(kp+j*2048); kf[2*j+1]=*(const __attribute__((address_space(3))) bf16x8*)(kp+j*2048+512); }
__device__ __forceinline__ s16x4 vtr(lds_cptr p){ return __builtin_bit_cast(s16x4,__builtin_amdgcn_ds_read_tr16_b64_v4i16((__attribute__((address_space(3))) v4i16_t*)p)); }
__device__ __forceinline__ float rowmax(const f32x16&p0,const f32x16&p1){
  float a=max3f(p0[0],p0[1],p1[0]),b=max3f(p0[2],p0[3],p1[1]);a=max3f(a,p1[2],p1[3]);
  #pragma unroll
  for(int r=4;r<16;r+=4){a=max3f(a,p0[r],p0[r+1]);b=max3f(b,p0[r+2],p0[r+3]);a=max3f(a,p1[r],p1[r+1]);b=max3f(b,p1[r+2],p1[r+3]);}
  const float m=max2f(a,b);
  auto rr=__builtin_amdgcn_permlane32_swap(__float_as_uint(m),__float_as_uint(m),false,false);
  return max2f(__uint_as_float(rr[0]),__uint_as_float(rr[1]));
}
__device__ __forceinline__ void pv(f32x16*o,int vb,bf16x8 pa0,bf16x8 pa1,bf16x8 pa2,bf16x8 pa3){
  #pragma unroll
  for(int d0=0;d0<2;++d0){s16x4 lo[4],hi[4];
    #pragma unroll
    for(int ks=0;ks<4;++ks){
      asm volatile("ds_read_b64_tr_b16 %0,%1 offset:%c2":"=&v"(lo[ks]):"v"(vb),"i"(d0*4096+ks*1024):"memory");
      asm volatile("ds_read_b64_tr_b16 %0,%1 offset:%c2":"=&v"(hi[ks]):"v"(vb),"i"(d0*4096+ks*1024+512):"memory");}
    asm volatile("s_waitcnt lgkmcnt(0)":::"memory");SBAR();
    #define PK(k) (bf16x8){lo[k][0],lo[k][1],lo[k][2],lo[k][3],hi[k][0],hi[k][1],hi[k][2],hi[k][3]}
    o[d0]=__builtin_amdgcn_mfma_f32_32x32x16_bf16(pa0,PK(0),o[d0],0,0,0);
    o[d0]=__builtin_amdgcn_mfma_f32_32x32x16_bf16(pa1,PK(1),o[d0],0,0,0);
    o[d0]=__builtin_amdgcn_mfma_f32_32x32x16_bf16(pa2,PK(2),o[d0],0,0,0);
    o[d0]=__builtin_amdgcn_mfma_f32_32x32x16_bf16(pa3,PK(3),o[d0],0,0,0);
    #undef PK
  }
}

#ifndef ATTN_STORE16
#define ATTN_STORE16(p,v) (*(u32x4*)(p)=(v))
#endif
template<int THRL> __device__ __forceinline__ void attn_unit(int b,int h,int qb,const bf16*Q,const bf16*__restrict__ K,const bf16*__restrict__ V,bf16*O,char*shm,const float*FBg){
  int tid=threadIdx.x; asm volatile("":"+v"(tid)); const int lane=tid&63,r32=lane&31,hi=lane>>5; const int wid=__builtin_amdgcn_readfirstlane(tid>>6);
  const long rowbase=(long)b*SEQ; const int q0=qb*QB;
  const bf16*Qw=Q+(rowbase+q0+wid*QBLK)*DM+h*D;
  const bf16*Kh=K+rowbase*DM+h*D,*Vh=V+rowbase*DM+h*D;
  const unsigned lds0=(unsigned)(uintptr_t)shm;
  float*wsf=(float*)(shm+LDS_WS)+wid*64;
  const bf16*ksrc=Kh+(long)lane*DM+wid*8;
  const bf16*vsrc=Vh+(long)(16*(wid&3)+(lane>>2))*DM+(wid>>2)*32+(lane&3)*8;
  const unsigned kdst=lds0+LDS_K+wid*1024, vdst=lds0+LDS_V+wid*1024;
  #define DMA_K(t,slot) glds16(ksrc+(long)(t)*KVBLK*DM,(unsigned)__builtin_amdgcn_readfirstlane(kdst+(slot)))
  #define DMA_V(t,slot) glds16(vsrc+(long)(t)*KVBLK*DM,(unsigned)__builtin_amdgcn_readfirstlane(vdst+(slot)))
  const int vb0=(int)(lds0+LDS_V)+((lane>>4)&1)*32+(lane&3)*8+(4*hi+((lane&15)>>2))*64;
  const char*Kbase=shm+LDS_K; bf16x8 kf[8];
  const lds_cptr shm3=(lds_cptr)shm; const lds_cptr kp0=shm3+LDS_K+hi*1024+r32*16; const lds_cptr vp0=shm3+LDS_V+((lane>>4)&1)*32+(lane&3)*8+(4*hi+((lane&15)>>2))*64;
  const int NT=(q0+QB)/KVBLK;
  typedef __attribute__((address_space(3))) const f32x4v* lds_f4p;
  { float*fbl=(float*)(shm+LDS_FB); const float*src=FBg+((long)b*NHEAD+h)*SEQ; for(int i=tid*4;i<q0+QB;i+=2048)*(f32x4v*)(fbl+i)=*(const f32x4v*)(src+i); }
  asm volatile("s_waitcnt vmcnt(0) lgkmcnt(0)\n\ts_barrier":::"memory");
  const lds_f4p fbp=(lds_f4p)((__attribute__((address_space(3))) const char*)shm+LDS_FB+hi*16);
  #define BIN(Pn,g,idx,tn) do{ const f32x4v b_=(fbp+(tn)*16)[idx]; Pn[4*(g)]=b_[0]-mhat; Pn[4*(g)+1]=b_[1]-mhat; Pn[4*(g)+2]=b_[2]-mhat; Pn[4*(g)+3]=b_[3]-mhat; }while(0)
  #define ADDB(P0,P1,t) do{ const lds_f4p fp_=fbp+(t)*16; _Pragma("unroll") for(int g_=0;g_<4;++g_){ const f32x4v b0_=fp_[2*g_], b1_=fp_[2*g_+8]; \
      P0[4*g_]+=b0_[0];P0[4*g_+1]+=b0_[1];P0[4*g_+2]+=b0_[2];P0[4*g_+3]+=b0_[3]; P1[4*g_]+=b1_[0];P1[4*g_+1]+=b1_[1];P1[4*g_+2]+=b1_[2];P1[4*g_+3]+=b1_[3]; } }while(0)
  DMA_K(0,0);DMA_V(0,0);DMA_K(1,SLOTB);
  bf16x8 qr[4];
  #pragma unroll
  for(int d0=0;d0<4;++d0)qr[d0]=*reinterpret_cast<const bf16x8*>(&Qw[(long)r32*DM+d0*16+hi*8]);
  float mhat=0.f,l_reg=0.f;f32x16 o[2];o[0]=f32x16{};o[1]=f32x16{};
  const int qrel=wid*QBLK+r32;
  #define CMASK(P0,P1,t) do{int jb_=(t)-(NT-4); if(jb_>=0)cmask(P0,P1,jb_,qrel,hi);}while(0)
  bool resc=false;
  #define START(P0,P1) do{ const float rm=rowmax(P0,P1); resc=false; \
    { const float dl=rm; mhat=fadd_s(mhat,dl); \
      _Pragma("unroll") for(int r=0;r<16;++r){P0[r]=fsub_s(P0[r],dl);P1[r]=fsub_s(P1[r],dl);} } \
    _Pragma("unroll") for(int r=0;r<16;++r)P0[r]=__builtin_amdgcn_exp2f(P0[r]); }while(0)
  #define RESC() do{ if(resc){ asm volatile("s_waitcnt lgkmcnt(0)":::"memory"); \
      _Pragma("unroll") for(int d_=0;d_<2;++d_) _Pragma("unroll") for(int r=0;r<16;++r)o[d_][r]*=wsf[crow(r,hi)]; } }while(0)
  f32x16 pA0,pA1,pB0,pB1;
  int sl_prev=0,sl_cur=0,sl_next=SLOTB;
  #define ROT() do{sl_prev=sl_cur;sl_cur=sl_next;sl_next=(sl_next==(NSLOT-1)*SLOTB)?0:sl_next+SLOTB;}while(0)
  DMA_K(2,2*SLOTB);
  WAIT_BAR(3);
  qkt(pA0,pA1,Kbase,qr,f32x16{},r32,hi);asm volatile("s_nop 15\n\ts_nop 7":"+v"(pA0),"+v"(pA1));ADDB(pA0,pA1,0);CMASK(pA0,pA1,0);
  START(pA0,pA1);
  _Pragma("unroll") for(int r=0;r<16;++r)pA1[r]=__builtin_amdgcn_exp2f(pA1[r]);
  { _Pragma("unroll") for(int g_=0;g_<4;++g_){ BIN(pB0,g_,2*g_,1); BIN(pB1,g_,2*g_+8,1); } }
  WAIT_BAR(0);
  DMA_K(3,0);DMA_V(1,SLOTB);
  ROT();
  kload8(kf,kp0+sl_cur);
  WAIT_BAR(2);
  s16x4 vlo[8],vhi[8]; u32x4 pw0,pw1,pw2,pw3;
  #define PKW(P,B) cvtpk_s(P[B],P[B+1])
  #define PAF(k) __builtin_bit_cast(bf16x8,pw##k)
  #define VFR(i) (bf16x8){vlo[i][0],vlo[i][1],vlo[i][2],vlo[i][3],vhi[i][0],vhi[i][1],vhi[i][2],vhi[i][3]}
  #define PIN(x) asm volatile("":"+v"(x))
  #define MX3(a,b,c) __builtin_fmaxf(__builtin_fmaxf((a),(b)),(c))
  #define GAPA(MF,A0,A1,A2,A3,W0,W1,PW) do{ MF; sacc+=A0; sacc+=A1; sacc+=A2; sacc+=A3; PIN(sacc); W0; W1; PIN(PW); SBAR(); }while(0)
  #define EX(v) __builtin_amdgcn_exp2f(v)
  #define GAPB(MF,X,B,TAIL) do{ MF; X[B]=EX(X[B]); X[B+1]=EX(X[B+1]); X[B+2]=EX(X[B+2]); X[B+3]=EX(X[B+3]); PIN(X); TAIL; SBAR(); }while(0)
  #define VRD(i) do{ vlo[i]=vtr(vp_+(((i)>>2)*4096+((i)&3)*1024)); vhi[i]=vtr(vp_+(((i)>>2)*4096+((i)&3)*1024+512)); }while(0)
  #define KRD(G,j) do{ if(G){ kload2(kf,kp0+sl_next,j); SBAR(); } }while(0)
  #define STEP(C0,C1,P0,P1,t,GK,GV,GL) do{ SBAR(); \
    const lds_cptr vp_=vp0+sl_prev; \
    VRD(0); SBAR(); float sacc=(P0[0]+P0[1]); \
    GAPA(C0=__builtin_amdgcn_mfma_f32_32x32x16_bf16(kf[0],qr[0],C0,0,0,0), P0[2],P0[3],P0[4],P0[5],     pw0[0]=PKW(P0,0), pw0[1]=PKW(P0,2), pw0); \
    VRD(4); SBAR(); GAPA(C1=__builtin_amdgcn_mfma_f32_32x32x16_bf16(kf[1],qr[0],C1,0,0,0), P0[6],P0[7],P0[8],P0[9],     pw0[2]=PKW(P0,4), pw0[3]=PKW(P0,6), pw0); \
    VRD(1); SBAR(); GAPA(C0=__builtin_amdgcn_mfma_f32_32x32x16_bf16(kf[2],qr[1],C0,0,0,0),   P0[10],P0[11],P0[12],P0[13], pw1[0]=PKW(P0,8), pw1[1]=PKW(P0,10), pw1); \
    VRD(5); SBAR(); GAPA(C1=__builtin_amdgcn_mfma_f32_32x32x16_bf16(kf[3],qr[1],C1,0,0,0),   P0[14],P0[15],P1[0],P1[1],   pw1[2]=PKW(P0,12),pw1[3]=PKW(P0,14), pw1); \
    VRD(2); SBAR(); GAPA(C0=__builtin_amdgcn_mfma_f32_32x32x16_bf16(kf[4],qr[2],C0,0,0,0),   P1[2],P1[3],P1[4],P1[5],     pw2[0]=PKW(P1,0), pw2[1]=PKW(P1,2), pw2); \
    VRD(6); SBAR(); GAPA(C1=__builtin_amdgcn_mfma_f32_32x32x16_bf16(kf[5],qr[2],C1,0,0,0),   P1[6],P1[7],P1[8],P1[9],     pw2[2]=PKW(P1,4), pw2[3]=PKW(P1,6), pw2); \
    VRD(3); SBAR(); GAPA(C0=__builtin_amdgcn_mfma_f32_32x32x16_bf16(kf[6],qr[3],C0,0,0,0),   P1[10],P1[11],P1[12],P1[13], pw3[0]=PKW(P1,8), pw3[1]=PKW(P1,10), pw3); \
    VRD(7); SBAR(); GAPA(C1=__builtin_amdgcn_mfma_f32_32x32x16_bf16(kf[7],qr[3],C1,0,0,0),   P1[14],P1[15],0.f,0.f,       pw3[2]=PKW(P1,12),pw3[3]=PKW(P1,14), pw3); \
    l_reg+=sacc; \
    if(GK){DMA_K((t)+3,sl_cur);} if(GV){DMA_V((t)+1,sl_next);} \
    CMASK(C0,C1,t); \
    { float a=MX3(C0[0],C0[1],C1[0]),b=MX3(C0[2],C0[3],C1[1]); a=MX3(a,C1[2],C1[3]); \
      _Pragma("unroll") for(int r=4;r<16;r+=4){a=MX3(a,C0[r],C0[r+1]);b=MX3(b,C0[r+2],C0[r+3]);a=MX3(a,C1[r],C1[r+1]);b=MX3(b,C1[r+2],C1[r+3]);} \
      float rm=__builtin_fmaxf(a,b); { auto rr=__builtin_amdgcn_permlane32_swap(__float_as_uint(rm),__float_as_uint(rm),false,false); rm=__builtin_fmaxf(__uint_as_float(rr[0]),__uint_as_float(rr[1])); } \
      resc=false; \
      if(__builtin_expect(__any(rm>(float)THRL),0)){ const float dl=__builtin_fmaxf(rm,0.f); mhat+=dl; \
        _Pragma("unroll") for(int r=0;r<16;++r){C0[r]-=dl;C1[r]-=dl;} \
        const float f=__builtin_amdgcn_exp2f(-dl); l_reg*=f; if(hi==0)wsf[r32]=f; resc=true; } } \
    SBAR(); \
    GAPB(o[0]=__builtin_amdgcn_mfma_f32_32x32x16_bf16(PAF(0),VFR(0),o[0],0,0,0), C0,0,  if(GL){BIN(P0,0,0,(t)+1);}); \
    GAPB(o[1]=__builtin_amdgcn_mfma_f32_32x32x16_bf16(PAF(0),VFR(4),o[1],0,0,0), C0,4,  if(GL){BIN(P1,0,8,(t)+1);}); \
    KRD(GL,0); GAPB(o[0]=__builtin_amdgcn_mfma_f32_32x32x16_bf16(PAF(1),VFR(1),o[0],0,0,0), C0,8,  if(GL){BIN(P0,1,2,(t)+1);}); \
    KRD(GL,1); GAPB(o[1]=__builtin_amdgcn_mfma_f32_32x32x16_bf16(PAF(1),VFR(5),o[1],0,0,0), C0,12, if(GL){BIN(P1,1,10,(t)+1);}); \
    KRD(GL,2); GAPB(o[0]=__builtin_amdgcn_mfma_f32_32x32x16_bf16(PAF(2),VFR(2),o[0],0,0,0), C1,0,  if(GL){BIN(P0,2,4,(t)+1);}); \
    KRD(GL,3); GAPB(o[1]=__builtin_amdgcn_mfma_f32_32x32x16_bf16(PAF(2),VFR(6),o[1],0,0,0), C1,4,  if(GL){BIN(P1,2,12,(t)+1);}); \
    GAPB(o[0]=__builtin_amdgcn_mfma_f32_32x32x16_bf16(PAF(3),VFR(3),o[0],0,0,0), C1,8,  if(GL){BIN(P0,3,6,(t)+1);}); \
    GAPB(o[1]=__builtin_amdgcn_mfma_f32_32x32x16_bf16(PAF(3),VFR(7),o[1],0,0,0), C1,12, if(GL){BIN(P1,3,14,(t)+1);}); \
    }while(0)
  int t=1;
  #undef CMASK
  #define CMASK(P0,P1,t) do{}while(0)
  for(;t+5<NT;t+=2){
    STEP(pB0,pB1,pA0,pA1,t,true,true,true);     WAIT_BAR(2); RESC(); ROT();
    STEP(pA0,pA1,pB0,pB1,t+1,true,true,true);   WAIT_BAR(2); RESC(); ROT();
  }
  #undef CMASK
  #define CMASK(P0,P1,t) do{int jb_=(t)-(NT-4); if(jb_>=0)cmask(P0,P1,jb_,qrel,hi);}while(0)
  #define ENDW(tt) do{ if((tt)+3<NT){WAIT_BAR(2);} else if((tt)+2<NT){WAIT_BAR(1);} else {WAIT_BAR(0);} }while(0)
  for(;t+1<NT;t+=2){
    STEP(pB0,pB1,pA0,pA1,t,(t+3<NT),(t+1<NT),(t+1<NT));       ENDW(t);   RESC(); ROT();
    STEP(pA0,pA1,pB0,pB1,t+1,(t+4<NT),(t+2<NT),(t+2<NT));     ENDW(t+1); RESC(); ROT();
  }
  STEP(pB0,pB1,pA0,pA1,NT-1,false,false,false); RESC();
  { float sacc=pB0[0]+pB0[1]; _Pragma("unroll") for(int r=2;r<16;++r)sacc+=pB0[r]; _Pragma("unroll") for(int r=0;r<16;++r)sacc+=pB1[r]; l_reg+=sacc;
    pw0=(u32x4){PKW(pB0,0),PKW(pB0,2),PKW(pB0,4),PKW(pB0,6)};pw1=(u32x4){PKW(pB0,8),PKW(pB0,10),PKW(pB0,12),PKW(pB0,14)};pw2=(u32x4){PKW(pB1,0),PKW(pB1,2),PKW(pB1,4),PKW(pB1,6)};pw3=(u32x4){PKW(pB1,8),PKW(pB1,10),PKW(pB1,12),PKW(pB1,14)};
    SBAR(); pv(o,vb0+sl_cur,PAF(0),PAF(1),PAF(2),PAF(3)); }
  #undef PKW
  #undef PAF
  #undef VFR
  #undef PIN
  #undef MX3
  #undef GAPA
  #undef GAPB
  #undef EX
  #undef VRD
  #undef KRD
  #undef STEP
  #undef ENDW
  {auto rr=__builtin_amdgcn_permlane32_swap(__float_as_uint(l_reg),__float_as_uint(l_reg),false,false);l_reg=__uint_as_float(rr[0])+__uint_as_float(rr[1]);}
  if(hi==0)wsf[32+r32]=l_reg;asm volatile("s_waitcnt lgkmcnt(0)":::"memory");
  float rli[16];
  #pragma unroll
  for(int r=0;r<16;++r)rli[r]=__builtin_amdgcn_rcpf(wsf[32+crow(r,hi)]);
  bf16*Ow=O+(rowbase+q0+wid*QBLK)*DMO+h*D;
  { bf16*stg=(bf16*)(shm+LDS_OST)+wid*2048;
    #pragma unroll
    for(int r=0;r<16;++r){const int orow=crow(r,hi);
      #pragma unroll
      for(int d0=0;d0<2;++d0)stg[orow*64+d0*32+r32]=(bf16)f2bf(o[d0][r]*rli[r]);}
    asm volatile("s_waitcnt lgkmcnt(0)":::"memory");
    #pragma unroll
    for(int i=0;i<4;++i){const int row=i*8+(lane>>3),ch=lane&7; const u32x4 v=*(const u32x4*)(stg+row*64+ch*8); ATTN_STORE16(Ow+(long)row*DMO+ch*8,v);} }
  asm volatile("s_waitcnt lgkmcnt(0)\n\ts_barrier":::"memory");
  #undef DMA_K
  #undef DMA_V
  #undef ADDB
  #undef BIN
  #undef CMASK
  #undef START
  #undef RESC
  #undef ROT
}
constexpr int ATTN_LDS_BYTES=LDS_BYTES;
#undef SBAR
#undef WAIT_BAR
}

__device__ __forceinline__ void fb_cumsum(Frame& F) {
    const int gwv = F.bid * NWAVES + F.wave; if (gwv >= 64) return;
    const float* lf = (const float*)(F.ws + WS_LOGF) + ((size_t)(gwv >> 3) * S) * 8 + (gwv & 7);
    float* fb = (float*)(F.ws + WS_FB) + (size_t)gwv * S;
    float v[64]; float run = 0.f;
#pragma unroll
    for (int i = 0; i < 64; ++i) { run += lf[(size_t)(F.lane * 64 + i) * 8]; v[i] = run; }
    float incl = run;
#pragma unroll
    for (int o = 1; o < 64; o <<= 1) { const float n = __shfl_up(incl, o); if (F.lane >= o) incl += n; }
    const float base = incl - run;
#pragma unroll
    for (int i = 0; i < 64; i += 4) { f32x4 o4; o4[0] = -LOG2E * (base + v[i]); o4[1] = -LOG2E * (base + v[i + 1]); o4[2] = -LOG2E * (base + v[i + 2]); o4[3] = -LOG2E * (base + v[i + 3]); *(f32x4*)(fb + F.lane * 64 + i) = o4; }
}
__device__ __forceinline__ void rnn_task(Frame& F, int b, int n) {
    typedef short bf16x8 __attribute__((ext_vector_type(8)));
    typedef float f32x16 __attribute__((ext_vector_type(16)));
    LAS bf16_t* xraw = (LAS bf16_t*)(F.lds);
    LAS bf16_t* graw = (LAS bf16_t*)(F.lds + 16896);
    LAS bf16_t* xcb = (LAS bf16_t*)(F.lds + 33280);
    LAS float* aa = (LAS float*)(F.lds + 51712);
    LAS float* uu = aa + 128 * 64;
    LAS float* seg = (LAS float*)(F.lds + 117248);
    LAS float* carry = (LAS float*)(F.lds + 121344);
    LAS bf16_t* wT = (LAS bf16_t*)(F.lds + 121856);
    const int tid = F.tid, lane = F.lane, wave = F.wave;
    for (int idx = tid; idx < 8192; idx += NTHREADS) { const int g = idx >> 12, d = (idx >> 6) & 63, e = idx & 63; wT[(g * 64 + e) * 72 + d] = (bf16_t)f2bf((g ? INP(I_EIW) : INP(I_ERW))[(n * 64 + d) * 64 + e]); }
    if (tid < 128) carry[tid] = 0.f;
    __syncthreads();
    const int tg = wave & 3, et = wave >> 2, l31 = lane & 31, hi = lane >> 5;
    bf16x8 Br[4], Bi[4];
#pragma unroll
    for (int ks = 0; ks < 4; ++ks) { Br[ks] = *(const LAS bf16x8*)(wT + (32 * et + l31) * 72 + 16 * ks + 8 * hi); Bi[ks] = *(const LAS bf16x8*)(wT + (64 + 32 * et + l31) * 72 + 16 * ks + 8 * hi); }
    const int ec = 32 * et + l31, chg = n * 64 + ec;
    const float rbe = INP(I_ERB)[chg], ibe = INP(I_EIB)[chg], la = -8.0f * softplusf_(-INP(I_ELAM)[chg]);
    const float e0 = INP(I_ECW)[chg], e1 = INP(I_ECW)[D_RNN + chg], e2 = INP(I_ECW)[2 * D_RNN + chg], e3 = INP(I_ECW)[3 * D_RNN + chg], ebias = INP(I_ECB)[chg];
    const int ch = tid & 63, tq = tid >> 6, cch = n * 64 + ch;
    const float c0 = INP(I_ECW)[cch], c1 = INP(I_ECW)[D_RNN + cch], c2 = INP(I_ECW)[2 * D_RNN + cch], c3 = INP(I_ECW)[3 * D_RNN + cch], cbias = INP(I_ECB)[cch];
    const int srow = tid >> 3, spc = tid & 7;
    const bf16_t* px = (const bf16_t*)(F.ws + WS_PROJ) + (size_t)b * S * P0W + n * 64 + spc * 8;
    bf16_t* py = (bf16_t*)(F.ws + WS_YMIX) + (size_t)b * S * D + cch;
    u32x4 xr0, xr1, xh, gr0, gr1;
#define RNN_LOAD(t0) do { const bf16_t* p_ = px + (size_t)((t0) + srow) * P0W; xr0 = *(const u32x4*)p_; xr1 = *(const u32x4*)(p_ + (size_t)64 * P0W); gr0 = *(const u32x4*)(p_ + D_RNN); gr1 = *(const u32x4*)(p_ + (size_t)64 * P0W + D_RNN); \
        xh = (u32x4){0u, 0u, 0u, 0u}; if (tid < 24 && (t0) > 0) xh = *(const u32x4*)(px + (size_t)((t0) - 3 + srow) * P0W); } while (0)
    RNN_LOAD(0);
    int o_st = (srow * 64 + spc * 8) * 2;
    int o_cv = (tq * 16 * 64 + ch) * 2;
    int o_xb = (tq * 16 * 72 + ch) * 2;
    int o_af = ((32 * tg + l31) * 72 + 8 * hi) * 2;
    int o_e2 = ((32 * tg + 4 * hi) * 64 + ec) * 2;
    int o_e4 = ((32 * tg + 4 * hi) * 64 + ec) * 4;
    int o_sc = (tq * 16 * 64 + ch) * 4;
    LAS unsigned char* L = F.lds;
#pragma unroll 1
    for (int c = 0; c < S / 128; ++c) {
        const int t0 = c * 128;
        asm volatile("" : "+v"(o_st), "+v"(o_cv), "+v"(o_xb), "+v"(o_af), "+v"(o_e2), "+v"(o_e4), "+v"(o_sc));
        *(LAS u32x4*)(L + o_st + 3 * 128) = xr0; *(LAS u32x4*)(L + o_st + 67 * 128) = xr1;
        *(LAS u32x4*)(L + 16896 + o_st) = gr0; *(LAS u32x4*)(L + 16896 + o_st + 64 * 128) = gr1;
        if (tid < 24) *(LAS u32x4*)(L + o_st) = xh;
        __syncthreads();
        if (c + 1 < S / 128) RNN_LOAD(t0 + 128);
        { float w0 = bf2f(*(LAS bf16_t*)(L + o_cv)), w1 = bf2f(*(LAS bf16_t*)(L + o_cv + 128)), w2 = bf2f(*(LAS bf16_t*)(L + o_cv + 256));
#pragma unroll
          for (int i = 0; i < 16; ++i) { const float w3 = bf2f(*(LAS bf16_t*)(L + o_cv + (i + 3) * 128)); *(LAS bf16_t*)(L + 33280 + o_xb + i * 144) = (bf16_t)f2bf(cbias + c0 * w0 + c1 * w1 + c2 * w2 + c3 * w3); w0 = w1; w1 = w2; w2 = w3; } }
        __syncthreads();
        { f32x16 R = {}, I = {};
#pragma unroll
          for (int ks = 0; ks < 4; ++ks) { const bf16x8 af = *(const LAS bf16x8*)(L + 33280 + o_af + ks * 32);
              R = __builtin_amdgcn_mfma_f32_32x32x16_bf16(af, Br[ks], R, 0, 0, 0); I = __builtin_amdgcn_mfma_f32_32x32x16_bf16(af, Bi[ks], I, 0, 0, 0); }
#pragma unroll
          for (int r = 0; r < 16; ++r) { const int tk = (r & 3) + 8 * (r >> 2);
              const float xc = ebias + e0 * bf2f(*(LAS bf16_t*)(L + o_e2 + tk * 128)) + e1 * bf2f(*(LAS bf16_t*)(L + o_e2 + (tk + 1) * 128)) + e2 * bf2f(*(LAS bf16_t*)(L + o_e2 + (tk + 2) * 128)) + e3 * bf2f(*(LAS bf16_t*)(L + o_e2 + (tk + 3) * 128));
              const float rr = sigmoidf_(R[r] + rbe), gi = sigmoidf_(I[r] + ibe), log_a = la * rr;
              *(LAS float*)(L + 51712 + o_e4 + tk * 256) = __expf(log_a); *(LAS float*)(L + 51712 + 32768 + o_e4 + tk * 256) = sqrtf(fmaxf(-expm1f(2.f * log_a), 0.f)) * (gi * xc); __builtin_amdgcn_sched_barrier(0); } }
        __syncthreads();
        { float A = 1.f, U = 0.f;
#pragma unroll
          for (int i = 0; i < 16; ++i) { const float a = *(LAS float*)(L + 51712 + o_sc + i * 256), u = *(LAS float*)(L + 51712 + 32768 + o_sc + i * 256); U = a * U + u; A = a * A; }
          seg[tq * 64 + ch] = A; seg[512 + tq * 64 + ch] = U; }
        __syncthreads();
        { float h = carry[(c & 1) * 64 + ch];
          for (int s = 0; s < tq; ++s) h = seg[s * 64 + ch] * h + seg[512 + s * 64 + ch];
          bf16_t* pyc = py + (size_t)(t0 + tq * 16) * D;
#pragma unroll
          for (int i = 0; i < 16; ++i) { h = *(LAS float*)(L + 51712 + o_sc + i * 256) * h + *(LAS float*)(L + 51712 + 32768 + o_sc + i * 256) * 1.f; pyc[(size_t)i * D] = (bf16_t)f2bf(h * geluf_(bf2f(*(LAS bf16_t*)(L + 16896 + o_cv + i * 128)))); if ((i & 3) == 3) __builtin_amdgcn_sched_barrier(0); }
          if (tq == 7) carry[((c + 1) & 1) * 64 + ch] = h; }
        __syncthreads();
    }
#undef RNN_LOAD
}
__device__ __forceinline__ void ph_mixer0(Frame& F, unsigned char* lds_generic) {
    LAS volatile int* qslot = (LAS volatile int*)(F.lds + 160 * 1024 - 64);
    unsigned* qhead = (unsigned*)(F.ws + WS_CTL) + CW_QUEUE;
    const bf16_t* P = (const bf16_t*)(F.ws + WS_PROJ);
#define MIX_FETCH(item) do { if (F.tid == 0) qslot[0] = (int)atomicAdd(qhead, 1u); __syncthreads(); item = qslot[0]; __syncthreads(); } while (0)
    int item; MIX_FETCH(item);
#pragma unroll 1
    while (item < 64) {
#ifndef MK_NO_RNN
        rnn_task(F, item >> 3, item & 7);
#endif
        MIX_FETCH(item); }
#pragma unroll 1
    while (item < 64 + 1024) { const int u = item - 64, qb = 15 - (u >> 6), bh = u & 63;
#ifndef MK_NO_ATTN
        attn_body::attn_unit<8>(bh >> 3, bh & 7, qb, P + 1024, P + 1536, P + 2048, (bf16_t*)(F.ws + WS_YMIX) + D_RNN, (char*)lds_generic, (const float*)(F.ws + WS_FB));
#endif
        MIX_FETCH(item); }
#undef MIX_FETCH
}


namespace gla {
typedef short bf16x8 __attribute__((ext_vector_type(8)));
typedef float f32x16 __attribute__((ext_vector_type(16)));
constexpr int QTP = 136;
__device__ __forceinline__ int dkperm(int c) { return (c & ~12) | ((c & 4) << 1) | ((c & 8) >> 1); }

__device__ __forceinline__ void g1_task(Frame& F, int cidx) {
    const int n = cidx & 63, h = (cidx >> 6) & 3, b = cidx >> 8, tid = F.tid, lane = F.lane, wave = F.wave;
    LAS float* glw = (LAS float*)(F.lds);
    LAS float* segt = (LAS float*)(F.lds + 4096);
    LAS bf16_t* qst = (LAS bf16_t*)(F.lds + 8192);
    LAS bf16_t* kst = (LAS bf16_t*)(F.lds + 8192 + 16384);
    LAS bf16_t* qtl = (LAS bf16_t*)(F.lds + 40960);
    LAS bf16_t* ktl = (LAS bf16_t*)(F.lds + 40960 + 64 * QTP * 2);
    const size_t row0 = (size_t)b * S + n * 64;
    const bf16_t* P = (const bf16_t*)(F.ws + WS_PROJ);
    if (tid < 256) *(LAS f32x4*)(glw + tid * 4) = *(const f32x4*)((const float*)(F.ws + WS_GLOW) + row0 * 16 + tid * 4);
#pragma unroll
    for (int i = 0; i < 2; ++i) { const int p = tid + i * 512, tok = p >> 4, c = p & 15;
        *(LAS u32x4*)(qst + tok * 128 + c * 8) = *(const u32x4*)(P + (row0 + tok) * P1W + h * 128 + c * 8);
        *(LAS u32x4*)(kst + tok * 128 + c * 8) = *(const u32x4*)(P + (row0 + tok) * P1W + 512 + h * 128 + c * 8); }
    const int col = tid & 127, tg4 = tid >> 7, dk = h * 128 + col;
    float w2[16];
#pragma unroll
    for (int j = 0; j < 16; ++j) w2[j] = INP(I_OGW2)[j * GDK + dk];
    const float gb = INP(I_OGB)[dk];
    __syncthreads();
    float cl[16]; float run = 0.f;
#pragma unroll
    for (int i = 0; i < 16; ++i) { const int tok = tg4 * 16 + i; float z = gb;
#pragma unroll
        for (int j4 = 0; j4 < 4; ++j4) { const f32x4 g = *(const LAS f32x4*)(glw + tok * 16 + j4 * 4); z += g[0] * w2[j4 * 4] + g[1] * w2[j4 * 4 + 1] + g[2] * w2[j4 * 4 + 2] + g[3] * w2[j4 * 4 + 3]; }
        run += logsigmoidf_(z) * (1.f / 16.f); cl[i] = run; }
    segt[tg4 * 128 + col] = run;
    __syncthreads();
    float base = 0.f, last = 0.f;
#pragma unroll
    for (int g = 0; g < 4; ++g) { const float s = segt[g * 128 + col]; if (g < tg4) base += s; last += s; }
    const int pc = (col & ~15) | dkperm(col & 15);
    bf16_t* qtg = (bf16_t*)(F.ws + WS_YMIX) + (row0 + tg4 * 16) * GDK + h * 128 + pc;
    bf16_t* keg = (bf16_t*)(F.ws + WS_YMIX + (size_t)T * GDK * 2) + ((size_t)cidx * 128 + col) * 64 + tg4 * 16;
    unsigned kw[8];
#pragma unroll
    for (int i = 0; i < 16; ++i) { const int tok = tg4 * 16 + i; const float cum = base + cl[i];
        const float q = bf2f(qst[tok * 128 + col]) * 0.08838834764831845f, k = bf2f(kst[tok * 128 + col]);
        const float qt = q * __expf(cum), kt = k * __expf(-cum), ke = k * __expf(last - cum);
        const bf16_t qb = (bf16_t)f2bf(qt);
        qtl[tok * QTP + col] = qb; ktl[tok * QTP + col] = (bf16_t)f2bf(kt); qtg[(size_t)i * GDK] = qb;
        if (i & 1) kw[i >> 1] |= f2bf(ke) << 16; else kw[i >> 1] = f2bf(ke); }
    *(u32x4*)keg = (u32x4){kw[0], kw[1], kw[2], kw[3]}; *(u32x4*)(keg + 8) = (u32x4){kw[4], kw[5], kw[6], kw[7]};
    if (tg4 == 0) ((float*)(F.ws + WS_DECAY))[(size_t)cidx * 128 + col] = __expf(last);
    __syncthreads();
    if (wave < 4) {
        const int tt = wave & 1, st = wave >> 1, l31 = lane & 31, hi = lane >> 5;
        f32x16 acc = {};
        if (!(tt == 0 && st == 1)) {
#pragma unroll
            for (int ks = 0; ks < 8; ++ks) { const bf16x8 af = *(const LAS bf16x8*)(qtl + (32 * tt + l31) * QTP + 16 * ks + 8 * hi), bfr = *(const LAS bf16x8*)(ktl + (32 * st + l31) * QTP + 16 * ks + 8 * hi);
                acc = __builtin_amdgcn_mfma_f32_32x32x16_bf16(af, bfr, acc, 0, 0, 0); } }
        bf16_t* am = (bf16_t*)(F.ws + WS_AMAT) + (size_t)cidx * 4096;
        const int s = 32 * st + l31;
#pragma unroll
        for (int r = 0; r < 16; ++r) { const int t = 32 * tt + (r & 3) + 8 * (r >> 2) + 4 * hi; am[t * 64 + s] = (bf16_t)f2bf(s <= t ? acc[r] : 0.f); }
    }
    __syncthreads();
}
__device__ __forceinline__ void ph_g1(Frame& F) { for (int c = F.bid; c < B * GH * 64; c += F.G) g1_task(F, c); }

constexpr int QP = 272, KP = 144, AP = 144, VP = 520;
constexpr int G2_Q = 0, G2_K = G2_Q + 64 * QP, G2_A = G2_K + 128 * KP, G2_V = G2_A + 64 * AP, G2_D = G2_V + 64 * VP, G2_STAGE = G2_D + 512;
struct G2Regs { u32x4 q[2], k[2], a, v[4]; f32x4 d; };
__device__ __forceinline__ void g2_load(G2Regs& R, const unsigned char* ws, int b, int h, int n, int tid) {
    const int cidx = (b * 4 + h) * 64 + n; const size_t row0 = (size_t)b * S + n * 64;
    const bf16_t* QT = (const bf16_t*)(ws + WS_YMIX); const bf16_t* KET = (const bf16_t*)(ws + WS_YMIX + (size_t)T * GDK * 2) + (size_t)cidx * 8192;
    const bf16_t* AM = (const bf16_t*)(ws + WS_AMAT) + (size_t)cidx * 4096; const bf16_t* P = (const bf16_t*)(ws + WS_PROJ);
#pragma unroll
    for (int i = 0; i < 2; ++i) { const int p = tid + i * 512; R.q[i] = *(const u32x4*)(QT + (row0 + (p >> 4)) * GDK + h * 128 + (p & 15) * 8); R.k[i] = *(const u32x4*)(KET + p * 8); }
    R.a = *(const u32x4*)(AM + tid * 8);
#pragma unroll
    for (int i = 0; i < 4; ++i) { const int p = tid + i * 512; R.v[i] = *(const u32x4*)(P + (row0 + (p >> 5)) * P1W + 1024 + h * 256 + (p & 31) * 8); }
    if (tid < 32) R.d = *(const f32x4*)((const float*)(ws + WS_DECAY) + (size_t)cidx * 128 + tid * 4);
}
__device__ __forceinline__ void g2_store(const G2Regs& R, LAS unsigned char* st, int tid) {
#pragma unroll
    for (int i = 0; i < 2; ++i) { const int p = tid + i * 512; *(LAS u32x4*)(st + G2_Q + (p >> 4) * QP + (p & 15) * 16) = R.q[i]; *(LAS u32x4*)(st + G2_K + (p >> 3) * KP + (p & 7) * 16) = R.k[i]; }
    *(LAS u32x4*)(st + G2_A + (tid >> 3) * AP + (tid & 7) * 16) = R.a;
#pragma unroll
    for (int i = 0; i < 4; ++i) { const int p = tid + i * 512; *(LAS u32x4*)(st + G2_V + (p >> 5) * VP + (p & 31) * 16) = R.v[i]; }
    if (tid < 32) *(LAS f32x4*)(st + G2_D + tid * 16) = R.d;
}
__device__ __forceinline__ void g2_task(Frame& F, int bh) {
    const int b = bh >> 2, h = bh & 3, tid = F.tid, lane = F.lane, w = F.wave, l31 = lane & 31, hi = lane >> 5;
    f32x16 St[4];
#pragma unroll
    for (int kt = 0; kt < 4; ++kt) St[kt] = f32x16{};
    G2Regs R;
    g2_load(R, F.ws, b, h, 0, tid); g2_store(R, F.lds, tid);
    __syncthreads();
    bf16_t* Og = (bf16_t*)(F.ws + WS_XN) + ((size_t)b * S) * D + h * 256 + 32 * w + l31;
#pragma unroll 1
    for (int n = 0; n < 64; ++n) {
        LAS unsigned char* st = F.lds + (n & 1) * G2_STAGE;
        if (n + 1 < 64) g2_load(R, F.ws, b, h, n + 1, tid);
        bf16x8 Vf[4];
#pragma unroll
        for (int ks = 0; ks < 4; ++ks) { const LAS unsigned char* vp = st + G2_V + (16 * ks + 8 * hi) * VP + (32 * w + l31) * 2;
#pragma unroll
            for (int j = 0; j < 8; ++j) Vf[ks][j] = (short)*(const LAS bf16_t*)(vp + j * VP); }
        f32x16 O[2] = {f32x16{}, f32x16{}};
#pragma unroll
        for (int tt = 0; tt < 2; ++tt) {
#pragma unroll
            for (int ks = 0; ks < 4; ++ks) { const bf16x8 af = *(const LAS bf16x8*)(st + G2_A + (32 * tt + l31) * AP + (16 * ks + 8 * hi) * 2); O[tt] = __builtin_amdgcn_mfma_f32_32x32x16_bf16(af, Vf[ks], O[tt], 0, 0, 0); } }
#pragma unroll
        for (int kt = 0; kt < 4; ++kt)
#pragma unroll
            for (int s = 0; s < 2; ++s) { union { bf16x8 v; unsigned u[4]; } sf;
#pragma unroll
                for (int q = 0; q < 4; ++q) sf.u[q] = pg8::cvt_pk_bf16(St[kt][8 * s + 2 * q], St[kt][8 * s + 2 * q + 1]);
#pragma unroll
                for (int tt = 0; tt < 2; ++tt) { const bf16x8 qf = *(const LAS bf16x8*)(st + G2_Q + (32 * tt + l31) * QP + (32 * kt + 16 * s + 8 * hi) * 2); O[tt] = __builtin_amdgcn_mfma_f32_32x32x16_bf16(qf, sf.v, O[tt], 0, 0, 0); } }
#pragma unroll
        for (int kt = 0; kt < 4; ++kt) {
#pragma unroll
            for (int g = 0; g < 4; ++g) { const f32x4 dv = *(const LAS f32x4*)(st + G2_D + (32 * kt + 8 * g + 4 * hi) * 4); St[kt][4 * g] *= dv[0]; St[kt][4 * g + 1] *= dv[1]; St[kt][4 * g + 2] *= dv[2]; St[kt][4 * g + 3] *= dv[3]; }
#pragma unroll
            for (int ks = 0; ks < 4; ++ks) { const bf16x8 kf = *(const LAS bf16x8*)(st + G2_K + (32 * kt + l31) * KP + (16 * ks + 8 * hi) * 2); St[kt] = __builtin_amdgcn_mfma_f32_32x32x16_bf16(kf, Vf[ks], St[kt], 0, 0, 0); } }
        bf16_t* oc = Og + (size_t)(n * 64 + 4 * hi) * D;
#pragma unroll
        for (int tt = 0; tt < 2; ++tt)
#pragma unroll
            for (int r = 0; r < 16; ++r) oc[(size_t)(32 * tt + (r & 3) + 8 * (r >> 2)) * D] = (bf16_t)f2bf(O[tt][r]);
        if (n + 1 < 64) g2_store(R, F.lds + ((n + 1) & 1) * G2_STAGE, tid);
        __syncthreads();
    }
}
__device__ __forceinline__ void ph_g2(Frame& F) { if (F.bid < B * GH) g2_task(F, F.bid); }

__device__ __forceinline__ void ph_g3(Frame& F) {
    const int lane = F.lane, gwv = F.bid * NWAVES + F.wave, NGW = F.G * NWAVES;
    const bf16_t* O = (const bf16_t*)(F.ws + WS_XN); const bf16_t* P = (const bf16_t*)(F.ws + WS_PROJ); bf16_t* Y = (bf16_t*)(F.ws + WS_YMIX);
    const f32x4 gn = *(const f32x4*)(INP(I_OGAIN) + 4 * lane);
    for (int t = gwv; t < T; t += NGW) {
#pragma unroll
        for (int j = 0; j < 4; ++j) {
            const u32x2 ov = *(const u32x2*)(O + (size_t)t * D + 256 * j + 4 * lane), rv = *(const u32x2*)(P + (size_t)t * P1W + 2048 + 256 * j + 4 * lane);
            f32x4 o; o[0] = __uint_as_float(ov.x << 16); o[1] = __uint_as_float(ov.x & 0xffff0000u); o[2] = __uint_as_float(ov.y << 16); o[3] = __uint_as_float(ov.y & 0xffff0000u);
            f32x4 r; r[0] = __uint_as_float(rv.x << 16); r[1] = __uint_as_float(rv.x & 0xffff0000u); r[2] = __uint_as_float(rv.y << 16); r[3] = __uint_as_float(rv.y & 0xffff0000u);
            const float rstd = rsqrtf(wave_sum((o[0] * o[0] + o[1] * o[1]) + (o[2] * o[2] + o[3] * o[3])) * (1.f / 256.f) + EPS);
            u32x2 w; w.x = pk2(o[0] * rstd * gn[0] * siluf_(r[0]), o[1] * rstd * gn[1] * siluf_(r[1])); w.y = pk2(o[2] * rstd * gn[2] * siluf_(r[2]), o[3] * rstd * gn[3] * siluf_(r[3]));
            *(u32x2*)(Y + (size_t)t * D + 256 * j + 4 * lane) = w;
        }
    }
}
}

template <int NV> __device__ __forceinline__ void xreduce(float (&v)[NV], int lane) {
    if constexpr (NV >= 32) { const bool up = lane & 32;
#pragma unroll
        for (int i = 0; i < 16; ++i) { const float keep = up ? v[16 + i] : v[i], send = up ? v[i] : v[16 + i]; v[i] = keep + __shfl_xor(send, 32); } }
    if constexpr (NV >= 16) { const bool up = lane & (NV >= 32 ? 16 : 32); const int o = (NV >= 32 ? 16 : 32);
#pragma unroll
        for (int i = 0; i < 8; ++i) { const float keep = up ? v[8 + i] : v[i], send = up ? v[i] : v[8 + i]; v[i] = keep + __shfl_xor(send, o); } }
    if constexpr (NV >= 8) { const int o = (NV >= 32 ? 8 : NV >= 16 ? 16 : 32); const bool up = lane & o;
#pragma unroll
        for (int i = 0; i < 4; ++i) { const float keep = up ? v[4 + i] : v[i], send = up ? v[i] : v[4 + i]; v[i] = keep + __shfl_xor(send, o); } }
    { const int o = (NV >= 32 ? 4 : NV >= 16 ? 8 : 16); const bool up = lane & o;
#pragma unroll
        for (int i = 0; i < 2; ++i) { const float keep = up ? v[2 + i] : v[i], send = up ? v[i] : v[2 + i]; v[i] = keep + __shfl_xor(send, o); } }
    { const int o = (NV >= 32 ? 2 : NV >= 16 ? 4 : 8); const bool up = lane & o;
        const float keep = up ? v[1] : v[0], send = up ? v[0] : v[1]; v[0] = keep + __shfl_xor(send, o); }
    if constexpr (NV >= 32) { v[0] += __shfl_xor(v[0], 1); }
    else if constexpr (NV >= 16) { v[0] += __shfl_xor(v[0], 2); v[0] += __shfl_xor(v[0], 1); }
    else { v[0] += __shfl_xor(v[0], 4); v[0] += __shfl_xor(v[0], 2); v[0] += __shfl_xor(v[0], 1); }
}
template <int MODE> __device__ __forceinline__ void ph_rowpass(Frame& F, int layer) {
    const int lane = F.lane;
    const float* modl = (const float*)(F.ws + WS_MOD) + (size_t)layer * B * 6 * D;
    LAS float* wl = (LAS float*)F.lds;
    constexpr int RWS = 1028;
    if (MODE == 0) { for (int i = F.tid; i < 8 * D; i += NTHREADS) { const int col = i >> 3, hh = i & 7; wl[hh * D + col] = INP(I_EWIN)[(size_t)col * EVEN_PROJ + 2560 + hh]; } }
    if (MODE == 2) { for (int i = F.tid; i < 16 * D; i += NTHREADS) { const int col = i >> 4, j = i & 15; wl[j * D + col] = INP(I_OWIN)[(size_t)col * ODD_PROJ + 3072 + j]; } }
    if (MODE == 1) { for (int i = F.tid; i < 32 * D; i += NTHREADS) { const int col = i >> 5, e = i & 31; wl[e * RWS + col] = INP(I_RW)[i]; } }
    __syncthreads();
    const float* xin = (MODE == 0) ? INP(I_X) : (const float*)F.out;
    bf16_t* xn = (bf16_t*)(F.ws + WS_XN);
    const bf16_t* ybuf = (const bf16_t*)(F.ws + WS_YBUF);
    const float* gwp = (const float*)(F.ws + WS_GW);
    const int gwv = F.bid * NWAVES + F.wave, NGW = F.G * NWAVES;
    for (int ch = gwv; ch < T / 16; ch += NGW) {
        const int row0 = ch * 16, b = row0 / S;
        f32x4 Ac[4], Bc[4], Gc[4];
        if (MODE != 3) { const float* gain = (MODE == 1 ? INP(I_NFFN) : INP(I_NMIX)) + layer * D; const int sho = (MODE == 1) ? 3 * D : 0, sco = (MODE == 1) ? 4 * D : D;
#pragma unroll
            for (int j = 0; j < 4; ++j) { const int c = 4 * lane + 256 * j; const f32x4 g = *(const f32x4*)(gain + c), sc = *(const f32x4*)(modl + (size_t)b * 6 * D + sco + c); Ac[j] = g * (sc + 1.f); Bc[j] = *(const f32x4*)(modl + (size_t)b * 6 * D + sho + c); } }
        if (MODE == 2 || MODE == 3) { const float* mp = (MODE == 2) ? (const float*)(F.ws + WS_MOD) : modl;
#pragma unroll
            for (int j = 0; j < 4; ++j) Gc[j] = *(const f32x4*)(mp + (size_t)b * 6 * D + 5 * D + 4 * lane + 256 * j); }
#pragma unroll 1
        for (int r = 0; r < 16; ++r) {
            const int t = row0 + r;
            int lo4 = 4 * lane; asm volatile("" : "+v"(lo4));
            f32x4 x[4];
#pragma unroll
            for (int j = 0; j < 4; ++j) x[j] = *(const f32x4*)(xin + (size_t)t * D + 4 * lane + 256 * j);
            if (MODE == 2 || MODE == 3) {
                const float g0 = gwp[t * 2], g1 = gwp[t * 2 + 1];
#pragma unroll
                for (int j = 0; j < 4; ++j) { const u32x2 a = *(const u32x2*)(ybuf + ((size_t)t * 2) * D + 4 * lane + 256 * j), c = *(const u32x2*)(ybuf + ((size_t)t * 2 + 1) * D + 4 * lane + 256 * j);
                    f32x4 y; y[0] = g0 * __uint_as_float(a.x << 16) + g1 * __uint_as_float(c.x << 16); y[1] = g0 * __uint_as_float(a.x & 0xffff0000u) + g1 * __uint_as_float(c.x & 0xffff0000u);
                    y[2] = g0 * __uint_as_float(a.y << 16) + g1 * __uint_as_float(c.y << 16); y[3] = g0 * __uint_as_float(a.y & 0xffff0000u) + g1 * __uint_as_float(c.y & 0xffff0000u);
                    x[j] = x[j] + Gc[j] * y; *(f32x4*)(F.out + (size_t)t * D + 4 * lane + 256 * j) = x[j]; }
            }
            if (MODE == 3) continue;
            float ss = 0.f;
#pragma unroll
            for (int j = 0; j < 4; ++j) ss += (x[j][0] * x[j][0] + x[j][1] * x[j][1]) + (x[j][2] * x[j][2] + x[j][3] * x[j][3]);
            const float rstd = rsqrtf(wave_sum(ss) * (1.f / D) + EPS);
            f32x4 h[4];
#pragma unroll
            for (int j = 0; j < 4; ++j) { h[j] = x[j] * rstd * Ac[j] + Bc[j]; u32x2 w; w.x = pk2(h[j][0], h[j][1]); w.y = pk2(h[j][2], h[j][3]); *(u32x2*)(xn + (size_t)t * D + 4 * lane + 256 * j) = w; }
            if (MODE == 0) {
                float a[8];
#pragma unroll
                for (int q = 0; q < 8; ++q) { a[q] = 0.f;
#pragma unroll
                    for (int j = 0; j < 4; ++j) { const f32x4 w = *(const LAS f32x4*)(wl + q * D + lo4 + 256 * j); a[q] += (h[j][0] * w[0] + h[j][1] * w[1]) + (h[j][2] * w[2] + h[j][3] * w[3]); } }
                xreduce<8>(a, lane);
                if ((lane & 7) == 0) { const int q = lane >> 3; ((float*)(F.ws + WS_LOGF))[(size_t)t * 8 + q] = logsigmoidf_(a[0] + INP(I_EFB)[q]); }
            }
            if (MODE == 2) {
                float a[16];
#pragma unroll
                for (int q = 0; q < 16; ++q) { a[q] = 0.f;
#pragma unroll
                    for (int j = 0; j < 4; ++j) { const f32x4 w = *(const LAS f32x4*)(wl + q * D + lo4 + 256 * j); a[q] += (h[j][0] * w[0] + h[j][1] * w[1]) + (h[j][2] * w[2] + h[j][3] * w[3]); } }
                xreduce<16>(a, lane);
                if ((lane & 3) == 0) ((float*)(F.ws + WS_GLOW))[(size_t)t * 16 + (lane >> 2)] = a[0];
            }
            if (MODE == 1) {
                float a[32];
#pragma unroll
                for (int q = 0; q < 32; ++q) { a[q] = 0.f;
#pragma unroll
                    for (int j = 0; j < 4; ++j) { const f32x4 w = *(const LAS f32x4*)(wl + q * RWS + lo4 + 256 * j); a[q] += (h[j][0] * w[0] + h[j][1] * w[1]) + (h[j][2] * w[2] + h[j][3] * w[3]); } }
                xreduce<32>(a, lane);
                const int e = lane >> 1; const float sc = sigmoidf_(a[0]); const float sel = sc + INP(I_RB)[e];
                float m1 = sel, s1 = sc; int e1 = e;
#pragma unroll
                for (int o = 2; o <= 8; o <<= 1) { const float ov = __shfl_xor(m1, o), os = __shfl_xor(s1, o); const int oe = __shfl_xor(e1, o); if (ov > m1 || (ov == m1 && oe < e1)) { m1 = ov; s1 = os; e1 = oe; } }
                float m2 = (e == e1) ? -INFINITY : sel, s2 = sc; int e2 = e;
#pragma unroll
                for (int o = 2; o <= 8; o <<= 1) { const float ov = __shfl_xor(m2, o), os = __shfl_xor(s2, o); const int oe = __shfl_xor(e2, o); if (ov > m2 || (ov == m2 && oe < e2)) { m2 = ov; s2 = os; e2 = oe; } }
                float gs = m1 + m2; int g = e >> 3;
#pragma unroll
                for (int o = 16; o <= 32; o <<= 1) { const float ogs = __shfl_xor(gs, o); const int og = __shfl_xor(g, o); const float os1 = __shfl_xor(s1, o), os2 = __shfl_xor(s2, o); const int oe1 = __shfl_xor(e1, o), oe2 = __shfl_xor(e2, o);
                    if (ogs > gs || (ogs == gs && og < g)) { gs = ogs; g = og; s1 = os1; s2 = os2; e1 = oe1; e2 = oe2; } }
                if (lane == 0) {
                    const float inv = 1.f / (s1 + s2);
                    ((int*)(F.ws + WS_EIDX))[t * 2] = e1; ((int*)(F.ws + WS_EIDX))[t * 2 + 1] = e2;
                    ((float*)(F.ws + WS_GW))[t * 2] = s1 * inv; ((float*)(F.ws + WS_GW))[t * 2 + 1] = s2 * inv;
                    unsigned* cnt = (unsigned*)(F.ws + WS_CTL) + CW_CNT + 32 * layer; int* list = (int*)(F.ws + WS_LIST);
                    const unsigned p1 = atomicAdd(&cnt[e1], 1u); list[e1 * LCAP + p1] = t * 2;
                    const unsigned p2 = atomicAdd(&cnt[e2], 1u); list[e2 * LCAP + p2] = t * 2 + 1;
                }
            }
        }
    }
}

__global__ void __launch_bounds__(NTHREADS, 2) mk_fwd(Args args) {
    extern __shared__ __attribute__((aligned(16))) unsigned char lds_raw[];
    Frame F;
    F.lds = (LAS unsigned char*)lds_raw; F.tid = threadIdx.x; F.lane = F.tid & 63; F.wave = __builtin_amdgcn_readfirstlane(F.tid >> 6); F.G = gridDim.x; F.bid = blockIdx.x;
    if (F.tid == 0) {
#pragma unroll
        for (int i = 0; i < 28; ++i) *(LAS unsigned long long*)(F.lds + LDS_PTRS + 8 * i) = (unsigned long long)args.in[i];
    }
    F.out = args.out; F.ws = args.ws;
    const int lo = args.ph_lo, hi = args.ph_hi;
#define IN(k) (lo <= (k) && (k) < hi)
    volatile LAS unsigned* MISC = (volatile LAS unsigned*)(F.lds + LDS_BYTES - 256);
    if (F.tid < 64) MISC[F.tid] = 0u;
    __syncthreads();
    XcdBarrier bar = xcd_barrier_post((unsigned*)(F.ws + WS_CTL) + CW_BAR, MISC);
#define SEAM(k) do { if (IN(k) && IN((k) + 1)) xcd_barrier(bar); frame_refresh(F); } while (0)
    LAS int* tpre = (LAS int*)(F.lds + pg8::STAGE_BYTES);
    if (IN(0)) ph_prologue(F);
    SEAM(0);
    if (IN(1)) ph_rowpass<0>(F, 0);
    SEAM(1);
    if (IN(2)) {
        fb_cumsum(F);
        pg8::DenseSched Sd; Sd.init(T, P0W, D, F.ws + WS_WIN0T, F.G, F.bid);
        pg8::EpiProj0 E{(bf16_t*)(F.ws + WS_PROJ), INP(I_EQG), INP(I_EKG)};
        pg8::gemm_phase<pg8::EpiProj0, pg8::DenseSched, true>(F.lds, (const char*)(F.ws + WS_XN), D, Sd, E);
    }
    SEAM(2);
    if (IN(3)) ph_mixer0(F, lds_raw);
    SEAM(3);
#pragma unroll
    for (int l = 0; l < 2; ++l) {
        const int pb = l ? 13 : 4;
        if (l == 1) {
            if (IN(8)) ph_rowpass<2>(F, 1);
            SEAM(8);
            if (IN(9)) {
                pg8::DenseSched Sd; Sd.init(T, P1W, D, F.ws + WS_WIN1T, F.G, F.bid);
                pg8::EpiBf16 E{(bf16_t*)(F.ws + WS_PROJ), P1W};
                pg8::gemm_phase<pg8::EpiBf16, pg8::DenseSched, true>(F.lds, (const char*)(F.ws + WS_XN), D, Sd, E);
            }
            SEAM(9);
            if (IN(10)) gla::ph_g1(F);
            SEAM(10);
            if (IN(11)) gla::ph_g2(F);
            SEAM(11);
            if (IN(12)) gla::ph_g3(F);
            SEAM(12);
        }
        if (IN(pb)) {
            pg8::DenseSched Sd; Sd.init(T, D, D, F.ws + (l ? WS_WOUT1T : WS_WOUT0T), F.G, F.bid);
            pg8::EpiResid E{l ? (const float*)F.out : INP(I_X), F.out, (const float*)(F.ws + WS_MOD) + (size_t)l * B * 6 * D + 2 * D};
            pg8::gemm_phase<pg8::EpiResid, pg8::DenseSched, true>(F.lds, (const char*)(F.ws + WS_YMIX), D, Sd, E);
        }
        SEAM(pb);
        if (IN(pb + 1)) ph_rowpass<1>(F, l);
        SEAM(pb + 1);
        if (IN(pb + 2)) {
            pg8::MoeSched<true> Sm; Sm.init((const unsigned*)(F.ws + WS_CTL) + CW_CNT + 32 * l, (const int*)(F.ws + WS_LIST), F.ws + WS_W13T + (size_t)l * NE * 1024 * 1024 * 2, (size_t)1024 * 1024 * 2, D, F.G, F.bid, tpre);
            pg8::EpiMoe1 E{(bf16_t*)(F.ws + WS_HID)};
            pg8::gemm_phase<pg8::EpiMoe1, pg8::MoeSched<true>, true>(F.lds, (const char*)(F.ws + WS_XN), D, Sm, E);
        }
        SEAM(pb + 2);
        if (IN(pb + 3)) {
            pg8::MoeSched<false> Sm; Sm.init((const unsigned*)(F.ws + WS_CTL) + CW_CNT + 32 * l, (const int*)(F.ws + WS_LIST), F.ws + WS_W2T + (size_t)l * NE * 1024 * 512 * 2, (size_t)1024 * 512 * 2, DE, F.G, F.bid, tpre);
            pg8::EpiMoe2 E{(bf16_t*)(F.ws + WS_YBUF), (const int*)(F.ws + WS_LIST), tpre};
            pg8::gemm_phase<pg8::EpiMoe2, pg8::MoeSched<false>, true>(F.lds, (const char*)(F.ws + WS_HID), DE, Sm, E);
        }
        SEAM(pb + 3);
    }
    if (IN(17)) ph_rowpass<3>(F, 1);
#undef SEAM
#undef IN
}

extern "C" void kernel_launch(void* const* d_in, const int* in_sizes, int n_in, void* d_out, int out_size, void* d_ws, size_t ws_size, hipStream_t stream) {
    static int grid = 0;
    if (grid == 0) {
        if (n_in != 28 || out_size != T * D || ws_size < WS_END) { fprintf(stderr, "kernel_launch: unexpected shapes (n_in %d out %d ws %zu)\n", n_in, out_size, ws_size); grid = -1; return; }
        int dev = 0, cus = 0, per_cu = 0;
        (void)hipGetDevice(&dev); (void)hipDeviceGetAttribute(&cus, hipDeviceAttributeMultiprocessorCount, dev);
        (void)hipFuncSetAttribute((const void*)mk_fwd, hipFuncAttributeMaxDynamicSharedMemorySize, LDS_BYTES);
        if (hipOccupancyMaxActiveBlocksPerMultiprocessor(&per_cu, (const void*)mk_fwd, NTHREADS, LDS_BYTES) != hipSuccess || per_cu < 1) { fprintf(stderr, "occupancy query failed (%d)\n", per_cu); per_cu = 1; }
        (void)hipGetLastError();
        grid = cus * 1;
        if (per_cu < 1) grid = -1;
    }
    if (grid < 0) return;
    const float* in[28]; for (int i = 0; i < 28; ++i) in[i] = (const float*)d_in[i];
    unsigned char* ws = (unsigned char*)d_ws; float* out = (float*)d_out;
    float* mod = (float*)(ws + WS_MOD); int* eidx = (int*)(ws + WS_EIDX); float* gw = (float*)(ws + WS_GW); float* logf = (float*)(ws + WS_LOGF); float* fb = (float*)(ws + WS_FB);
    float* glow = (float*)(ws + WS_GLOW); int* list = (int*)(ws + WS_LIST); unsigned* ctl = (unsigned*)(ws + WS_CTL);
    bf16_t* win0t = (bf16_t*)(ws + WS_WIN0T); bf16_t* wout0t = (bf16_t*)(ws + WS_WOUT0T); bf16_t* win1t = (bf16_t*)(ws + WS_WIN1T); bf16_t* wout1t = (bf16_t*)(ws + WS_WOUT1T);
    bf16_t* w13t = (bf16_t*)(ws + WS_W13T); bf16_t* w2t = (bf16_t*)(ws + WS_W2T); bf16_t* xn = (bf16_t*)(ws + WS_XN); bf16_t* ymix = (bf16_t*)(ws + WS_YMIX);
    bf16_t* proj = (bf16_t*)(ws + WS_PROJ); bf16_t* hid = (bf16_t*)(ws + WS_HID); bf16_t* ybuf = (bf16_t*)(ws + WS_YBUF); bf16_t* obuf = (bf16_t*)(ws + WS_XN);
    auto mk = [&](int lo, int hi) { Args a{}; for (int i = 0; i < 28; ++i) a.in[i] = in[i]; a.out = out; a.ws = ws; a.ph_lo = lo; a.ph_hi = hi;
        hipLaunchKernelGGL(mk_fwd, dim3(grid), dim3(NTHREADS), LDS_BYTES, stream, a); };
    (void)hipMemsetAsync(ws + WS_CTL, 0, CTL_ZERO_BYTES, stream);
    mk(0, 18);
}
```

```cpp
#include <hip/hip_runtime.h>
#include <cstdio>
#include <cstdint>
#include <type_traits>

#define LAS __attribute__((address_space(3)))
typedef unsigned short bf16_t;
typedef float f32x4 __attribute__((ext_vector_type(4)));
typedef unsigned u32x4 __attribute__((ext_vector_type(4)));
typedef unsigned u32x2 __attribute__((ext_vector_type(2)));

namespace cfg {
constexpr int D = 1024, B = 8, S = 4096, T = B * S;
constexpr int D_RNN = 512, FH = 8, EVEN_PROJ = 2568, P0W = 2560;
constexpr int GH = 4, GDK = 512, HDK = 128, HDV = 256, ODD_PROJ = 3088, P1W = 3072;
constexpr int NE = 32, DE = 512, LCAP = 32768;
constexpr float EPS = 1e-6f, LOG2E = 1.4426950408889634f, C2 = 0.125f * LOG2E;
constexpr size_t MiB = 1u << 20;
constexpr size_t WS_CTL = 0;
constexpr size_t WS_MOD = 1 * MiB;
constexpr size_t WS_EIDX = 2 * MiB;
constexpr size_t WS_GW = 2 * MiB + 512 * 1024;
constexpr size_t WS_LOGF = 3 * MiB;
constexpr size_t WS_FB = 4 * MiB;
constexpr size_t WS_GLOW = 5 * MiB;
constexpr size_t WS_DECAY = 7 * MiB;
constexpr size_t WS_LIST = 8 * MiB;
constexpr size_t WS_WIN0T = 12 * MiB;
constexpr size_t WS_WOUT0T = 17 * MiB;
constexpr size_t WS_WIN1T = 19 * MiB;
constexpr size_t WS_WOUT1T = 25 * MiB;
constexpr size_t WS_W13T = 28 * MiB;
constexpr size_t WS_W2T = 156 * MiB;
constexpr size_t WS_RESA = WS_W13T + 64 * MiB, WS_RESB = WS_W13T;
constexpr size_t WS_XN = 220 * MiB;
constexpr size_t WS_YMIX = 284 * MiB;
constexpr size_t WS_AMAT = 348 * MiB;
constexpr size_t WS_PROJ = 364 * MiB;
constexpr size_t WS_HID = 364 * MiB;
constexpr size_t WS_YBUF = 436 * MiB;
constexpr size_t WS_END = 564 * MiB;
constexpr int CW_CNT = 0;
constexpr int CW_QUEUE = 64;
constexpr int CW_BAR = 4096;
constexpr size_t CTL_ZERO_BYTES = 64 * 1024;
}
using namespace cfg;

__device__ __forceinline__ float bf2f(bf16_t v) { return __uint_as_float((unsigned)v << 16); }
__device__ __forceinline__ unsigned f2bf(float f) { unsigned u = __float_as_uint(f); return (u + 0x7fffu + ((u >> 16) & 1u)) >> 16; }
__device__ __forceinline__ unsigned pk2(float lo, float hi) { return f2bf(lo) | (f2bf(hi) << 16); }
__device__ __forceinline__ float sigmoidf_(float x) { return 1.f / (1.f + __expf(-x)); }
__device__ __forceinline__ float siluf_(float x) { return x * sigmoidf_(x); }
__device__ __forceinline__ float softplusf_(float x) { return fmaxf(x, 0.f) + log1pf(__expf(-fabsf(x))); }
__device__ __forceinline__ float logsigmoidf_(float x) { return -softplusf_(-x); }
__device__ __forceinline__ float geluf_(float x) { return 0.5f * x * (1.f + tanhf(0.7978845608028654f * (x + 0.044715f * x * x * x))); }
#define LDS_BARRIER() asm volatile("s_waitcnt lgkmcnt(0)\n\ts_barrier" ::: "memory")
__device__ __forceinline__ unsigned pk4_fp8(float a, float b, float c, float d) { int p = 0; p = __builtin_amdgcn_cvt_pk_fp8_f32(a, b, p, false); p = __builtin_amdgcn_cvt_pk_fp8_f32(c, d, p, true); return (unsigned)p; }
__device__ __forceinline__ float fsigmoid(float x) { return __builtin_amdgcn_rcpf(1.f + __builtin_amdgcn_exp2f(-LOG2E * x)); }
__device__ __forceinline__ float fgelu(float g) { const float z = 0.7978845608028654f * (g + 0.044715f * g * g * g); return g - g * __builtin_amdgcn_rcpf(1.f + __builtin_amdgcn_exp2f(2.f * LOG2E * z)); }
__device__ __forceinline__ float wave_sum(float v) {
#pragma unroll
    for (int o = 1; o < 64; o <<= 1) v += __shfl_xor(v, o);
    return v;
}


#define XB_TMO      128
#define XB_XCNT(j)  (256  + 64 * (j))
#define XB_XSUB(j)  (1280 + 64 * (j))
#define XB_XGEN(j)  (2304 + 64 * (j))
#define XB_TOP      3328
#define XB_TOPGEN   3392
#define XCD_BAR_WORDS 3456
#define XB_SPIN_CAP (1u << 18)

__device__ __forceinline__ unsigned xb_ld(unsigned* p)              { return __hip_atomic_load(p, __ATOMIC_RELAXED, __HIP_MEMORY_SCOPE_AGENT); }
__device__ __forceinline__ unsigned xb_add(unsigned* p, unsigned v) { return __hip_atomic_fetch_add(p, v, __ATOMIC_RELAXED, __HIP_MEMORY_SCOPE_AGENT); }
__device__ __forceinline__ unsigned xb_xcc_id() { return (unsigned)__builtin_amdgcn_s_getreg((3 << 11) | 20) & 0xFu; }
#define XB_SPIN(cond, bar) do { unsigned _sp = 0; while (cond) { __builtin_amdgcn_s_sleep(1); \
    if ((++_sp & 255u) == 0u) { if (xb_ld(&(bar)[XB_TMO])) break; if (_sp > XB_SPIN_CAP) { atomicAdd(&(bar)[XB_TMO], 1u); break; } } } } while (0)

struct XcdBarrier {
    unsigned* bar; unsigned x;
    volatile LAS unsigned* st;
};

__device__ __forceinline__ XcdBarrier xcd_barrier_post(unsigned* bar, volatile LAS unsigned* st) {
    XcdBarrier b; b.bar = bar; b.x = xb_xcc_id(); b.st = st;
    if (threadIdx.x == 0) (void)xb_add(&bar[XB_XCNT(b.x)], 1u);
    return b;
}
__device__ __forceinline__ void xcd_barrier_complete(unsigned* bar, unsigned x, unsigned& nloc, unsigned& nx) {
    const unsigned G = gridDim.x * gridDim.y * gridDim.z;
    unsigned sum, cnt, mine, sp = 0u;
    for (;;) {
        sum = 0u; cnt = 0u; mine = 0u;
#pragma unroll 1
        for (unsigned j = 0; j < 16; ++j) { const unsigned c = xb_ld(&bar[XB_XCNT(j)]); sum += c; cnt += (c > 0u) ? 1u : 0u; mine = (j == x) ? c : mine; }
        if (sum == G) break;
        __builtin_amdgcn_s_sleep(1);
        if ((++sp & 255u) == 0u) { if (xb_ld(&bar[XB_TMO])) break; if (sp > XB_SPIN_CAP) { atomicAdd(&bar[XB_TMO], 1u); break; } }
    }
    nloc = mine > 0u ? mine : 1u; nx = cnt > 0u ? cnt : 1u;
}

__device__ __forceinline__ void xcd_barrier(const XcdBarrier& b) {
    asm volatile("s_waitcnt vmcnt(0)" ::: "memory");
    __syncthreads();
    if (threadIdx.x == 0) {
        unsigned* bar = b.bar; asm volatile("" : "+s"(bar));
        __builtin_amdgcn_s_waitcnt(0);
        unsigned nloc = b.st[0], nx = b.st[1];
        if (nloc == 0u) { xcd_barrier_complete(bar, b.x, nloc, nx); b.st[0] = nloc; b.st[1] = nx; }
        const unsigned old = xb_add(&bar[XB_XSUB(b.x)], 1u);
        const unsigned gen = old / nloc;
        if (old + 1u == (gen + 1u) * nloc) {
            __builtin_amdgcn_fence(__ATOMIC_RELEASE, "agent");
            asm volatile("s_waitcnt vmcnt(0)" ::: "memory");
            const unsigned og = xb_add(&bar[XB_TOP], 1u);
            const unsigned tg = og / nx;
            if (og + 1u == (tg + 1u) * nx) xb_add(&bar[XB_TOPGEN], 1u);
            else XB_SPIN(xb_ld(&bar[XB_TOPGEN]) == tg, bar);
            __builtin_amdgcn_fence(__ATOMIC_ACQUIRE, "agent");
            xb_add(&bar[XB_XGEN(b.x)], 1u);
            asm volatile("s_waitcnt vmcnt(0)" ::: "memory");
        } else {
            XB_SPIN(xb_ld(&bar[XB_XGEN(b.x)]) == gen, bar);
            __builtin_amdgcn_fence(__ATOMIC_ACQUIRE, "agent");
            asm volatile("s_waitcnt vmcnt(0)" ::: "memory");
        }
    }
    __syncthreads();
}


namespace nk {
__host__ __device__ __forceinline__ int win0_row(int n) { const int lc = n & 255, wc = lc >> 6, bj = (lc >> 5) & 1, j = lc & 31; return (n & ~255) + 128 * bj + 32 * wc + j; }
}


namespace pg8 {
typedef short bf16x8 __attribute__((ext_vector_type(8)));
constexpr int BM = 256, BK = 64, HALF = 128, HTB = HALF * BK * 2, STAGE_BYTES = 8 * HTB, NXCD = 8;
__host__ __device__ __forceinline__ int lds_byte(int r, int c) { const int st = (r >> 4) * 2 + (c >> 5), rr = r & 15, cc = c & 31, ob = rr * 64 + cc * 2; return st * 1024 + (ob ^ (((ob >> 9) & 1) << 5)); }
__host__ __device__ __forceinline__ void stage_rc(int b, int& R, int& C) { const int st = b / 1024, sb = b % 1024, swz = sb ^ (((sb >> 9) & 1) << 5); R = (st >> 1) * 16 + swz / 64; C = (st & 1) * 32 + (swz % 64) / 2; }
__host__ __device__ __forceinline__ int perm32(int rho) { const int n = rho >> 4, i = rho & 15; return 8 * (i >> 2) + 4 * n + (i & 3); }
__device__ __forceinline__ unsigned cvt_pk_bf16(float lo, float hi) { unsigned r; asm volatile("v_cvt_pk_bf16_f32 %0, %1, %2" : "=v"(r) : "v"(lo), "v"(hi)); return r; }
__device__ __forceinline__ int xcd_remap(int L, int nwg) { const int q = nwg / NXCD, r = nwg % NXCD, xcd = L % NXCD, off = L / NXCD; return (xcd < r ? xcd * (q + 1) : r * (q + 1) + (xcd - r) * q) + off; }

struct Unit { int pm, pn, e, nrow; };
template <class E, class = void> struct EpiHasPre : std::false_type {};
template <class E> struct EpiHasPre<E, std::void_t<typename E::Pre>> : std::true_type {};
template <class E, bool H> struct EpiPreOf { struct type {}; };
template <class E> struct EpiPreOf<E, true> { typedef typename E::Pre type; };

template <class Epi, class Sched, bool ALIGN_EPI, bool FP8 = false, int SCALE_W = 127>
__device__ __forceinline__ void gemm_phase(LAS unsigned char* lds, const char* Abase, const int K, const Sched& S, const Epi& E) {
    int tid = threadIdx.x; asm volatile("" : "+v"(tid));
    const int wid = __builtin_amdgcn_readfirstlane(tid >> 6), lane = tid & 63, wr = wid >> 2, wc = wid & 3, fr = lane & 15, fq = lane >> 4;
    const int nt = K / BK;
    int RA[2], CA[2]; unsigned voffB[2];
#pragma unroll
    for (int i = 0; i < 2; ++i) { int R, C; stage_rc(tid * 16 + i * 8192, R, C); const int Rb = Epi::PERM ? ((R & ~31) + perm32(R & 31)) : R; RA[i] = R; CA[i] = C; voffB[i] = (unsigned)(Rb * K + C) * 2u; }
    const size_t kstep = (size_t)(BK * 2);
    const size_t hstep = (size_t)HALF * K * 2;
    const unsigned ldsw = (unsigned)wid * 1024u;
    const int aoff = lds_byte(wr * 64 + fr, FP8 ? fq * 16 : fq * 8), boff = lds_byte(wc * 32 + fr, FP8 ? fq * 16 : fq * 8);
    constexpr int KCH = FP8 ? 16 : 1024;
#define PG8_SA(b, h) (((b) * 2 + (h)) * HTB)
#define PG8_SB(b, h) ((4 + (b) * 2 + (h)) * HTB)
#define PG8_STAGE(bufoff, gbase, voff) do { _Pragma("unroll") for (int _i = 0; _i < 2; ++_i) \
        __builtin_amdgcn_global_load_lds((const unsigned*)((const char*)(gbase) + (voff)[_i]), (LAS unsigned*)(lds + (bufoff) + ldsw + _i * 8192), 16, 0, 0); } while (0)
#define PG8_LDA(dst, b, h) do { _Pragma("unroll") for (int m = 0; m < 4; ++m) _Pragma("unroll") for (int k = 0; k < 2; ++k) dst[m][k] = *(const LAS bf16x8*)(lds + PG8_SA(b, h) + aoff + m * 2048 + k * KCH); } while (0)
#define PG8_LDB(dst, b, h) do { _Pragma("unroll") for (int n = 0; n < 2; ++n) _Pragma("unroll") for (int k = 0; k < 2; ++k) dst[n][k] = *(const LAS bf16x8*)(lds + PG8_SB(b, h) + boff + n * 2048 + k * KCH); } while (0)
#define PG8_LD8(p) __builtin_shufflevector(*(const LAS v4i_*)(p), *(const LAS v4i_*)((p) + 16), 0, 1, 2, 3, 4, 5, 6, 7)
#define PG8_LDA8(dst, b, h) do { _Pragma("unroll") for (int m = 0; m < 4; ++m) dst[m] = PG8_LD8(lds + PG8_SA(b, h) + aoff + m * 2048); } while (0)
#define PG8_LDB8(dst, b, h) do { _Pragma("unroll") for (int n = 0; n < 2; ++n) dst[n] = PG8_LD8(lds + PG8_SB(b, h) + boff + n * 2048); } while (0)
#define PG8_MMA8(ai, bj, A8, B8) do { __builtin_amdgcn_s_setprio(1); _Pragma("unroll") for (int m = 0; m < 4; ++m) _Pragma("unroll") for (int n = 0; n < 2; ++n) \
        asm volatile("s_nop 1\n\tv_mfma_scale_f32_16x16x128_f8f6f4 %0, %1, %2, %0, %3, %4 op_sel_hi:[0,0,0]" : "+v"(acc[ai][bj][m][n]) : "v"(B8[n]), "v"(A8[m]), "v"(sclW), "v"(sclA)); \
        __builtin_amdgcn_s_setprio(0); } while (0)
#define PG8_MMA(ai, bj, At, Bt) do { __builtin_amdgcn_s_setprio(1); _Pragma("unroll") for (int m = 0; m < 4; ++m) _Pragma("unroll") for (int n = 0; n < 2; ++n) _Pragma("unroll") for (int k = 0; k < 2; ++k) \
        acc[ai][bj][m][n] = __builtin_amdgcn_mfma_f32_16x16x32_bf16(Bt[n][k], At[m][k], acc[ai][bj][m][n], 0, 0, 0); __builtin_amdgcn_s_setprio(0); } while (0)
#define PG8_WAIT_V(n) asm volatile("s_waitcnt vmcnt(" #n ")" ::: "memory")
#define PG8_WAIT_L(n) asm volatile("s_waitcnt lgkmcnt(" #n ")" ::: "memory")
#define PG8_BAR __builtin_amdgcn_s_barrier()
#define PG8_SCHED __builtin_amdgcn_sched_barrier(0)
    Unit cur, nxt; int ui = 0;
    if (!S.next(0, cur)) return;
    f32x4 acc[2][2][4][2];
#pragma unroll
    for (int a = 0; a < 2; ++a)
#pragma unroll
        for (int b = 0; b < 2; ++b)
#pragma unroll
            for (int m = 0; m < 4; ++m)
#pragma unroll
                for (int n = 0; n < 2; ++n) acc[a][b][m][n] = (f32x4){0.f, 0.f, 0.f, 0.f};
    typedef int v4i_ __attribute__((ext_vector_type(4))); typedef int v8i_ __attribute__((ext_vector_type(8)));
    bf16x8 At[4][2], B0[2][2], B1[2][2];
    v8i_ A8[4], B08[2], B18[2];
    int sclW = SCALE_W * 0x01010101, sclA = 0x7f7f7f7f; asm volatile("" : "+v"(sclW), "+v"(sclA));
    unsigned cvo[2][2], nvo[2][2];
    S.a_offs(cur, RA, CA, cvo);
    const char* cB = S.b_base(cur);
    PG8_STAGE(PG8_SB(0, 0), cB, voffB); PG8_STAGE(PG8_SB(0, 1), cB + hstep, voffB); PG8_STAGE(PG8_SA(0, 0), Abase, cvo[0]); PG8_STAGE(PG8_SA(0, 1), Abase, cvo[1]);
    if (wr == 1) PG8_BAR;
    PG8_WAIT_V(2); PG8_BAR;
    PG8_STAGE(PG8_SB(1, 0), cB + kstep, voffB); PG8_STAGE(PG8_SA(1, 0), Abase + kstep, cvo[0]); PG8_STAGE(PG8_SB(1, 1), cB + hstep + kstep, voffB);
    PG8_WAIT_V(6); PG8_BAR;
    constexpr bool HAS_PRE = EpiHasPre<Epi>::value;
    typename EpiPreOf<Epi, HAS_PRE>::type epre;
    for (;;) {
        if constexpr (HAS_PRE) E.pre(cur, wr, fr, epre);
        const bool has_next = S.next(ui + 1, nxt);
        if (has_next) S.a_offs(nxt, RA, CA, nvo); else { nvo[0][0] = cvo[0][0]; nvo[0][1] = cvo[0][1]; nvo[1][0] = cvo[1][0]; nvo[1][1] = cvo[1][1]; }
        const char* nB = has_next ? S.b_base(nxt) : cB;
        for (int t = 0; t < nt; t += 2) {
            const bool last = (t == nt - 2);
            const char* a1 = Abase + (size_t)(t + 1) * kstep;
            const char* a2 = last ? Abase : Abase + (size_t)(t + 2) * kstep; const char* b2 = last ? nB : cB + (size_t)(t + 2) * kstep;
            const char* a3 = a2 + kstep; const char* b3 = b2 + kstep;
            unsigned vo2[2][2];
            vo2[0][0] = last ? nvo[0][0] : cvo[0][0]; vo2[0][1] = last ? nvo[0][1] : cvo[0][1]; vo2[1][0] = last ? nvo[1][0] : cvo[1][0]; vo2[1][1] = last ? nvo[1][1] : cvo[1][1];
#define PG8_RDB(b) do { if constexpr (FP8) { PG8_LDB8(B08, b, 0); PG8_LDB8(B18, b, 1); } else { PG8_LDB(B0, b, 0); PG8_LDB(B1, b, 1); } } while (0)
#define PG8_RDA(b, h) do { if constexpr (FP8) PG8_LDA8(A8, b, h); else PG8_LDA(At, b, h); } while (0)
#define PG8_MM2(ai) do { if constexpr (FP8) { PG8_SCHED; PG8_MMA8(ai, 0, A8, B08); PG8_MMA8(ai, 1, A8, B18); PG8_SCHED; } else { PG8_MMA(ai, 0, At, B0); PG8_MMA(ai, 1, At, B1); } } while (0)
            PG8_RDB(0); PG8_SCHED; PG8_RDA(0, 0); PG8_STAGE(PG8_SA(1, 1), a1, cvo[1]);
            PG8_WAIT_V(8); PG8_WAIT_L(0); PG8_BAR; PG8_MM2(0); PG8_BAR; PG8_SCHED;
            PG8_RDA(0, 1); PG8_STAGE(PG8_SB(0, 0), b2, voffB); PG8_STAGE(PG8_SB(0, 1), b2 + hstep, voffB); PG8_STAGE(PG8_SA(0, 0), a2, vo2[0]);
            PG8_WAIT_V(8); PG8_WAIT_L(0); PG8_BAR; PG8_MM2(1); PG8_BAR; PG8_SCHED;
            PG8_RDB(1); PG8_SCHED; PG8_RDA(1, 0); PG8_STAGE(PG8_SA(0, 1), a2, vo2[1]);
            PG8_WAIT_V(8); PG8_WAIT_L(0); PG8_BAR; PG8_MM2(0); PG8_BAR; PG8_SCHED;
            PG8_RDA(1, 1); PG8_STAGE(PG8_SB(1, 0), b3, voffB); PG8_STAGE(PG8_SB(1, 1), b3 + hstep, voffB); PG8_STAGE(PG8_SA(1, 0), a3, vo2[0]);
            PG8_WAIT_V(8); PG8_WAIT_L(0); PG8_BAR; PG8_MM2(1); PG8_BAR; PG8_SCHED;
#undef PG8_RDB
#undef PG8_RDA
#undef PG8_MM2
        }
        if constexpr (ALIGN_EPI) { if (wr == 0) PG8_BAR; }
        if constexpr (FP8) asm volatile("s_nop 15\n\ts_nop 15" ::: "memory");
        if constexpr (HAS_PRE) E(acc, cur, wr, wc, fr, fq, epre); else E(acc, cur, wr, wc, fr, fq);
        if (!has_next) break;
#pragma unroll
        for (int a = 0; a < 2; ++a)
#pragma unroll
            for (int b = 0; b < 2; ++b)
#pragma unroll
                for (int m = 0; m < 4; ++m)
#pragma unroll
                    for (int n = 0; n < 2; ++n) acc[a][b][m][n] = (f32x4){0.f, 0.f, 0.f, 0.f};
        cur = nxt; cB = nB; ++ui;
        cvo[0][0] = nvo[0][0]; cvo[0][1] = nvo[0][1]; cvo[1][0] = nvo[1][0]; cvo[1][1] = nvo[1][1];
        if constexpr (ALIGN_EPI) { if (wr == 1) PG8_BAR; }
    }
    PG8_WAIT_V(0);
    if constexpr (!ALIGN_EPI) { if (wr == 0) PG8_BAR; }
    PG8_BAR;
#undef PG8_SA
#undef PG8_SB
#undef PG8_STAGE
#undef PG8_LDA
#undef PG8_LDB
#undef PG8_LD8
#undef PG8_LDA8
#undef PG8_LDB8
#undef PG8_MMA8
#undef PG8_MMA
#undef PG8_WAIT_V
#undef PG8_WAIT_L
#undef PG8_BAR
#undef PG8_SCHED
}

struct DenseSched {
    int nM, nN, nwg, G, c, K; const char* Bt;
    __device__ __forceinline__ void init(int M, int N, int K_, const void* Bt_, int G_, int c_) { nM = M / BM; nN = N / BM; nwg = nM * nN; G = G_; c = c_; K = K_; Bt = (const char*)Bt_; }
    __device__ __forceinline__ bool next(int i, Unit& u) const {
        const long L = (long)i * G + c; if (L >= nwg) return false;
        const int wgid = xcd_remap((int)L, nwg);
        const int nig = 8 * nN, gid = wgid / nig, fm = gid * 8, gsz = (nM - fm) < 8 ? (nM - fm) : 8;
        u.pm = fm + ((wgid % nig) % gsz); u.pn = (wgid % nig) / gsz; u.e = 0; u.nrow = 256; return true;
    }
    __device__ __forceinline__ void a_offs(const Unit& u, const int (&RA)[2], const int (&CA)[2], unsigned (&vo)[2][2]) const {
#pragma unroll
        for (int h = 0; h < 2; ++h)
#pragma unroll
            for (int i = 0; i < 2; ++i) vo[h][i] = (unsigned)((u.pm * BM + h * HALF + RA[i]) * K + CA[i]) * 2u;
    }
    __device__ __forceinline__ const char* b_base(const Unit& u) const { return Bt + (size_t)u.pn * BM * K * 2; }
};
template <bool GATHER> struct MoeSched {
    const unsigned* cnt; const int* list; const char* Bt; size_t bstride; int K, G, c, ntile, nwg;
    LAS const int* tpre;
    __device__ __forceinline__ void init(const unsigned* cnt_, const int* list_, const void* Bt_, size_t bstride_, int K_, int G_, int c_, LAS int* tp) {
        cnt = cnt_; list = list_; Bt = (const char*)Bt_; bstride = bstride_; K = K_; G = G_; c = c_; tpre = tp;
        if (threadIdx.x == 0) { int p = 0; for (int e = 0; e < NE; ++e) { tp[e] = p; p += ((int)cnt_[e] + 255) >> 8; } tp[NE] = p; }
        __syncthreads();
        ntile = tp[NE]; nwg = ntile * 4;
    }
    __device__ __forceinline__ bool next(int i, Unit& u) const {
        const long L = (long)i * G + c; if (L >= nwg) return false;
        const int wgid = xcd_remap((int)L, nwg);
        u.pm = wgid >> 2; u.pn = wgid & 3;
        int e = 0;
#pragma unroll 1
        for (int j = 1; j < NE; ++j) if (tpre[j] <= u.pm) e = j;
        u.e = e; const int rt = u.pm - tpre[e]; const int left = (int)cnt[e] - rt * 256; u.nrow = left < 256 ? left : 256; return true;
    }
    __device__ __forceinline__ void a_offs(const Unit& u, const int (&RA)[2], const int (&CA)[2], unsigned (&vo)[2][2]) const {
        const int rt = u.pm - tpre[u.e];
#pragma unroll
        for (int h = 0; h < 2; ++h)
#pragma unroll
            for (int i = 0; i < 2; ++i) {
                const int r = h * HALF + RA[i];
                if (GATHER) { const int rr = r < u.nrow ? r : 0; const int ent = list[u.e * LCAP + rt * 256 + rr]; vo[h][i] = (unsigned)((ent >> 1) * K + CA[i]) * 2u; }
                else vo[h][i] = (unsigned)((u.pm * BM + r) * K + CA[i]) * 2u;
            }
    }
    __device__ __forceinline__ const char* b_base(const Unit& u) const { return Bt + (size_t)u.e * bstride + (size_t)u.pn * BM * K * 2; }
};

struct EpiProj0 {
    static constexpr bool PERM = true;
    bf16_t* O; const float* qg; const float* kg;
    __device__ __forceinline__ void operator()(const f32x4 (&acc)[2][2][4][2], const Unit& u, int wr, int wc, int fr, int fq) const {
        const int seg = u.pn >> 1;
        float gsc[2][2][4];
        const bool nrm = (seg == 2 || seg == 3);
        if (nrm) { const float* gp = (seg == 2) ? qg : kg; const float s = (seg == 2) ? C2 : 1.f;
#pragma unroll
            for (int bj = 0; bj < 2; ++bj)
#pragma unroll
                for (int n = 0; n < 2; ++n) { const f32x4 gv = *(const f32x4*)(gp + 32 * bj + 8 * fq + 4 * n); gsc[bj][n][0] = gv[0] * s; gsc[bj][n][1] = gv[1] * s; gsc[bj][n][2] = gv[2] * s; gsc[bj][n][3] = gv[3] * s; } }
        const int col0 = u.pn * BM + 64 * wc + 8 * fq;
#pragma unroll
        for (int ai = 0; ai < 2; ++ai)
#pragma unroll
            for (int m = 0; m < 4; ++m) {
                bf16_t* rowp = O + (size_t)(u.pm * BM + ai * HALF + wr * 64 + m * 16 + fr) * P0W + col0;
                float rs = 1.f;
                if (nrm) { float ss = 0.f;
#pragma unroll
                    for (int bj = 0; bj < 2; ++bj)
#pragma unroll
                        for (int n = 0; n < 2; ++n) { const f32x4 v = acc[ai][bj][m][n]; ss += (v[0] * v[0] + v[1] * v[1]) + (v[2] * v[2] + v[3] * v[3]); }
                    ss += __shfl_xor(ss, 16); ss += __shfl_xor(ss, 32); rs = rsqrtf(ss * (1.f / 64.f) + EPS); }
#pragma unroll
                for (int bj = 0; bj < 2; ++bj) { f32x4 v0 = acc[ai][bj][m][0], v1 = acc[ai][bj][m][1];
                    if (nrm) {
#pragma unroll
                        for (int q = 0; q < 4; ++q) { v0[q] = v0[q] * rs * gsc[bj][0][q]; v1[q] = v1[q] * rs * gsc[bj][1][q]; } }
                    u32x4 w; w.x = cvt_pk_bf16(v0[0], v0[1]); w.y = cvt_pk_bf16(v0[2], v0[3]); w.z = cvt_pk_bf16(v1[0], v1[1]); w.w = cvt_pk_bf16(v1[2], v1[3]);
                    *(u32x4*)(rowp + 32 * bj) = w; }
            }
    }
};
struct EpiBf16 {
    static constexpr bool PERM = true;
    bf16_t* O; int ldc;
    __device__ __forceinline__ void operator()(const f32x4 (&acc)[2][2][4][2], const Unit& u, int wr, int wc, int fr, int fq) const {
        const int col0 = u.pn * BM + wc * 32 + 8 * fq;
#pragma unroll
        for (int ai = 0; ai < 2; ++ai)
#pragma unroll
            for (int m = 0; m < 4; ++m) { bf16_t* rowp = O + (size_t)(u.pm * BM + ai * HALF + wr * 64 + m * 16 + fr) * ldc + col0;
#pragma unroll
                for (int bj = 0; bj < 2; ++bj) { const f32x4 v0 = acc[ai][bj][m][0], v1 = acc[ai][bj][m][1];
                    u32x4 w; w.x = cvt_pk_bf16(v0[0], v0[1]); w.y = cvt_pk_bf16(v0[2], v0[3]); w.z = cvt_pk_bf16(v1[0], v1[1]); w.w = cvt_pk_bf16(v1[2], v1[3]);
                    *(u32x4*)(rowp + bj * HALF) = w; } }
    }
};
struct EpiResid {
    static constexpr bool PERM = true;
    const float* XF; const bf16_t* XB; bf16_t* O; const float* g;
    __device__ __forceinline__ void operator()(const f32x4 (&acc)[2][2][4][2], const Unit& u, int wr, int wc, int fr, int fq) const {
        const int col0 = u.pn * BM + wc * 32 + 8 * fq; const int b = (u.pm * BM) / S;
        f32x4 gv[2][2];
#pragma unroll
        for (int bj = 0; bj < 2; ++bj)
#pragma unroll
            for (int n = 0; n < 2; ++n) gv[bj][n] = *(const f32x4*)(g + (size_t)b * 6 * D + col0 + bj * HALF + n * 4);
#pragma unroll
        for (int ai = 0; ai < 2; ++ai)
#pragma unroll
            for (int m = 0; m < 4; ++m) { const size_t off = (size_t)(u.pm * BM + ai * HALF + wr * 64 + m * 16 + fr) * D + col0;
#pragma unroll
                for (int bj = 0; bj < 2; ++bj) { f32x4 x0, x1;
                    if (XF) { x0 = *(const f32x4*)(XF + off + bj * HALF); x1 = *(const f32x4*)(XF + off + bj * HALF + 4); }
                    else { const u32x4 xv = *(const u32x4*)(XB + off + bj * HALF);
                        x0[0] = __uint_as_float(xv.x << 16); x0[1] = __uint_as_float(xv.x & 0xffff0000u); x0[2] = __uint_as_float(xv.y << 16); x0[3] = __uint_as_float(xv.y & 0xffff0000u);
                        x1[0] = __uint_as_float(xv.z << 16); x1[1] = __uint_as_float(xv.z & 0xffff0000u); x1[2] = __uint_as_float(xv.w << 16); x1[3] = __uint_as_float(xv.w & 0xffff0000u); }
                    const f32x4 v0 = x0 + gv[bj][0] * acc[ai][bj][m][0], v1 = x1 + gv[bj][1] * acc[ai][bj][m][1];
                    u32x4 w; w.x = cvt_pk_bf16(v0[0], v0[1]); w.y = cvt_pk_bf16(v0[2], v0[3]); w.z = cvt_pk_bf16(v1[0], v1[1]); w.w = cvt_pk_bf16(v1[2], v1[3]);
                    *(u32x4*)(O + off + bj * HALF) = w; } }
    }
};
struct EpiMoe1 {
    static constexpr bool PERM = true;
    unsigned char* H;
    __device__ __forceinline__ void operator()(const f32x4 (&acc)[2][2][4][2], const Unit& u, int wr, int wc, int fr, int fq) const {
        const int col0 = u.pn * 128 + wc * 32 + 8 * fq;
#pragma unroll
        for (int ai = 0; ai < 2; ++ai)
#pragma unroll
            for (int m = 0; m < 4; ++m) { unsigned char* rowp = H + (size_t)(u.pm * BM + ai * HALF + wr * 64 + m * 16 + fr) * DE + col0;
                float h[8];
#pragma unroll
                for (int n = 0; n < 2; ++n)
#pragma unroll
                    for (int q = 0; q < 4; ++q) { const float a = acc[ai][0][m][n][q], b3 = acc[ai][1][m][n][q]; h[n * 4 + q] = a * b3 * __builtin_amdgcn_rcpf(1.f + __builtin_amdgcn_exp2f(-LOG2E * a)); }
                u32x2 w; w.x = pk4_fp8(h[0], h[1], h[2], h[3]); w.y = pk4_fp8(h[4], h[5], h[6], h[7]);
                *(u32x2*)rowp = w; }
    }
};
struct EpiMoe2 {
    static constexpr bool PERM = true;
    bf16_t* Y; const int* list; LAS const int* tpre;
    struct Pre { int ent[8]; };
    __device__ __forceinline__ void pre(const Unit& u, int wr, int fr, Pre& P) const {
        const int rt = u.pm - tpre[u.e];
#pragma unroll
        for (int i = 0; i < 8; ++i) { const int r = (i >> 2) * HALF + wr * 64 + (i & 3) * 16 + fr; P.ent[i] = list[u.e * LCAP + rt * 256 + (r < u.nrow ? r : 0)]; }
    }
    __device__ __forceinline__ void operator()(const f32x4 (&acc)[2][2][4][2], const Unit& u, int wr, int wc, int fr, int fq, const Pre& P) const {
        const int col0 = u.pn * BM + wc * 32 + 8 * fq;
#pragma unroll
        for (int ai = 0; ai < 2; ++ai)
#pragma unroll
            for (int m = 0; m < 4; ++m) { const int r = ai * HALF + wr * 64 + m * 16 + fr;
                if (r < u.nrow) { unsigned char* rowp = (unsigned char*)Y + (size_t)P.ent[ai * 4 + m] * D + col0;
#pragma unroll
                    for (int bj = 0; bj < 2; ++bj) { const f32x4 v0 = acc[ai][bj][m][0], v1 = acc[ai][bj][m][1];
                        u32x2 w; w.x = pk4_fp8(v0[0], v0[1], v0[2], v0[3]); w.y = pk4_fp8(v1[0], v1[1], v1[2], v1[3]);
                        *(u32x2*)(rowp + bj * HALF) = w; } } }
    }
};
}

constexpr int NWAVES = 8, NTHREADS = 512, LDS_BYTES = 163840;
constexpr int REP[18] = {1, 1, 1, 1, 1, 1, 1, 1, 1, 1, 1, 1, 1, 1, 1, 1, 1, 1};
constexpr int TIMED_PHASE = -1; constexpr float TIME_SCALE = 0.1f; constexpr bool TIMED_LOCAL = false; constexpr int TIMED_BLOCK = 0;
#define REPEAT(k) _Pragma("unroll 1") for (int rep_ = 0; rep_ < REP[k]; ++rep_, __syncthreads())
struct Args { const float* in[28]; float* out; unsigned char* ws; int ph_lo, ph_hi; };
struct Frame {
    LAS unsigned char* lds; int tid, lane, wave, G, bid;
    float* out; unsigned char* ws;
};
constexpr int LDS_PTRS = LDS_BYTES - 512;
__device__ __forceinline__ const float* in_ptr(const Frame& F, int i) {
    const unsigned long long v = *(const volatile LAS unsigned long long*)(F.lds + LDS_PTRS + 8 * i);
    const unsigned lo = __builtin_amdgcn_readfirstlane((unsigned)v), hi = __builtin_amdgcn_readfirstlane((unsigned)(v >> 32));
    return (const float*)(const __attribute__((address_space(1))) float*)(((unsigned long long)hi << 32) | lo);
}
#define INP(i) in_ptr(F, (i))
__device__ __forceinline__ void frame_refresh(Frame& F) {
    int t = threadIdx.x; asm volatile("" : "+v"(t)); F.tid = t; F.lane = t & 63; F.wave = __builtin_amdgcn_readfirstlane(t >> 6);
}
enum { I_X = 0, I_C, I_RW, I_RB, I_ADAW, I_ADAB, I_NMIX, I_NFFN, I_EWIN, I_ECW, I_ECB, I_ERW, I_ERB, I_EIW, I_EIB, I_ELAM, I_EFB, I_EQG, I_EKG, I_EWOUT,
       I_OWIN, I_OGW2, I_OGB, I_OGAIN, I_OWOUT, I_W1, I_W3, I_W2 };

struct TileRegs { f32x4 v[16]; };
__device__ __forceinline__ void tile_load(TileRegs& R, const float* W, int ldw, int k0, int n0, int lane) {
    const int r4 = lane >> 4, c4 = lane & 15;
#pragma unroll
    for (int i = 0; i < 16; ++i) R.v[i] = __builtin_nontemporal_load((const f32x4*)(W + (size_t)(k0 + r4 + 4 * i) * ldw + n0 + 4 * c4));
}
template <bool SPLIT> __device__ __forceinline__ void transpose_fin(const TileRegs& R, int k0, bf16_t* WT, int ldt, int drow0, LAS float* scr, int lane) {
    const int r4 = lane >> 4, c4 = lane & 15;
    const f32x4 (&v)[16] = R.v;
#pragma unroll
    for (int i = 0; i < 16; ++i) { LAS float* p = scr + (r4 + 4 * i) * 65 + 4 * c4; p[0] = v[i][0]; p[1] = v[i][1]; p[2] = v[i][2]; p[3] = v[i][3]; }
    asm volatile("s_waitcnt lgkmcnt(0)" ::: "memory");
    const int c = lane & 7;
#pragma unroll
    for (int j = 0; j < 8; ++j) { const int n = (lane >> 3) + 8 * j; const LAS float* s = scr + (8 * c) * 65 + n;
        u32x4 o; o.x = pk2(s[0 * 65], s[1 * 65]); o.y = pk2(s[2 * 65], s[3 * 65]); o.z = pk2(s[4 * 65], s[5 * 65]); o.w = pk2(s[6 * 65], s[7 * 65]);
        const int drow = drow0 + (SPLIT ? (n & 31) + 128 * (n >> 5) : n);
        *(u32x4*)(WT + (size_t)drow * ldt + k0 + 8 * c) = o; }
    asm volatile("s_waitcnt lgkmcnt(0)" ::: "memory");
}
template <bool SPLIT> __device__ __forceinline__ void transpose_fin8(const TileRegs& R, int k0, unsigned char* WT, int ldt, int drow0, LAS float* scr, int lane) {
    const int r4 = lane >> 4, c4 = lane & 15;
    const f32x4 (&v)[16] = R.v;
#pragma unroll
    for (int i = 0; i < 16; ++i) { LAS float* p = scr + (r4 + 4 * i) * 65 + 4 * c4; p[0] = v[i][0]; p[1] = v[i][1]; p[2] = v[i][2]; p[3] = v[i][3]; }
    asm volatile("s_waitcnt lgkmcnt(0)" ::: "memory");
    const int c = lane & 3;
#pragma unroll
    for (int j = 0; j < 4; ++j) { const int n = (lane >> 2) + 16 * j; const LAS float* s = scr + (16 * c) * 65 + n;
        u32x4 o;
        o.x = pk4_fp8(64.f * s[0 * 65], 64.f * s[1 * 65], 64.f * s[2 * 65], 64.f * s[3 * 65]); o.y = pk4_fp8(64.f * s[4 * 65], 64.f * s[5 * 65], 64.f * s[6 * 65], 64.f * s[7 * 65]);
        o.z = pk4_fp8(64.f * s[8 * 65], 64.f * s[9 * 65], 64.f * s[10 * 65], 64.f * s[11 * 65]); o.w = pk4_fp8(64.f * s[12 * 65], 64.f * s[13 * 65], 64.f * s[14 * 65], 64.f * s[15 * 65]);
        *(u32x4*)(WT + (size_t)(drow0 + (SPLIT ? (n & 31) + 128 * (n >> 5) : n)) * ldt + k0 + 16 * c) = o; }
    asm volatile("s_waitcnt lgkmcnt(0)" ::: "memory");
}
struct ConvItem { const float* W; unsigned char* WT; int ldw, k0, n0, ldt, drow0, kind; };
__device__ __forceinline__ ConvItem moe_item(Frame& F, int l, int it) {
    const int e = it / 384, r = it % 384, which = r >> 7, q = r & 127, le = l * NE + e; ConvItem c;
    if (which < 2) { const int kb = q >> 3, nb = q & 7, n0 = nb * 64;
        c.W = (which ? INP(I_W3) : INP(I_W1)) + (size_t)le * D * DE; c.ldw = DE; c.k0 = kb * 64; c.n0 = n0; c.WT = F.ws + WS_W13T + (size_t)l * 64 * MiB + (size_t)e * 1024 * 1024; c.ldt = D; c.drow0 = 256 * (n0 >> 7) + (n0 & 127) + 128 * which; }
    else { const int kb = q >> 4, nb = q & 15;
        c.W = INP(I_W2) + (size_t)le * DE * D; c.ldw = D; c.k0 = kb * 64; c.n0 = nb * 64; c.WT = F.ws + WS_W2T + (size_t)l * 32 * MiB + (size_t)e * 1024 * 512; c.ldt = DE; c.drow0 = nb * 64; }
    c.kind = 2; return c;
}
__device__ __forceinline__ void conv_finish(const ConvItem& c, const TileRegs& R, LAS float* scr, int lane) {
    if (c.kind == 2) transpose_fin8<false>(R, c.k0, c.WT, c.ldt, c.drow0, scr, lane);
    else if (c.kind == 3) transpose_fin8<true>(R, c.k0, c.WT, c.ldt, c.drow0, scr, lane);
    else if (c.kind == 1) transpose_fin<true>(R, c.k0, (bf16_t*)c.WT, c.ldt, c.drow0, scr, lane);
    else transpose_fin<false>(R, c.k0, (bf16_t*)c.WT, c.ldt, c.drow0, scr, lane);
}
template <class Dec> __device__ __forceinline__ void conv_run(Frame& F, const Dec& dec, int first, int stride, int n, LAS float* scr) {
    if (first >= n) return;
    TileRegs R; ConvItem cur = dec(first); tile_load(R, cur.W, cur.ldw, cur.k0, cur.n0, F.lane);
#pragma unroll 1
    for (int it = first; it < n; it += stride) {
        const int nx = it + stride < n ? it + stride : it;
        const ConvItem nxt = dec(nx);
        TileRegs Rn; tile_load(Rn, nxt.W, nxt.ldw, nxt.k0, nxt.n0, F.lane);
        conv_finish(cur, R, scr, F.lane);
        cur = nxt; R = Rn;
    }
}
constexpr int ND13 = 12 * 256;
__device__ __forceinline__ ConvItem moe_item13(Frame& F, int l, int j) { return moe_item(F, l, (j >> 8) * 384 + (j & 255)); }
__device__ __forceinline__ ConvItem moe_item2(Frame& F, int l, int j) { return moe_item(F, l, (j >> 7) * 384 + 256 + (j & 127)); }
template <class Dec> __device__ __forceinline__ void conv_tail(Frame& F, const Dec& dec, int qi, int n) {
    __syncthreads();
    LAS float* scr = (LAS float*)(F.lds + F.wave * 16640);
    unsigned* qhead = (unsigned*)(F.ws + WS_CTL) + CW_QUEUE + 64 * qi;
    auto fetch = [&]() -> int { int v = 0; if (F.lane == 0) v = (int)atomicAdd(qhead, 1u); return __builtin_amdgcn_readfirstlane(v); };
    int it = fetch(); if (it >= n) return;
    ConvItem cur = dec(it); TileRegs R; tile_load(R, cur.W, cur.ldw, cur.k0, cur.n0, F.lane);
#pragma unroll 1
    for (;;) {
        const int nx = fetch(); const bool more = nx < n;
        const ConvItem nxt = dec(more ? nx : it);
        TileRegs Rn; tile_load(Rn, nxt.W, nxt.ldw, nxt.k0, nxt.n0, F.lane);
        conv_finish(cur, R, scr, F.lane);
        if (!more) break;
        cur = nxt; R = Rn; it = nx;
    }
}
__device__ __forceinline__ void ph_prologue(Frame& F) {
    if (F.bid < 192) {
        LAS float* sc = (LAS float*)F.lds;
        LAS float* red = (LAS float*)(F.lds + 32768);
        { const float* cc = INP(I_C); for (int i = F.tid; i < B * D; i += NTHREADS) sc[(i & (D - 1)) * 8 + (i >> 10)] = siluf_(cc[i]); }
        __syncthreads();
        const int l = F.bid / 96, cb = F.bid % 96, kr = F.lane >> 4, c4 = F.lane & 15;
        const float* w = INP(I_ADAW) + (size_t)l * D * 6 * D + cb * 64 + 4 * c4;
        f32x4 acc[8];
#pragma unroll
        for (int b = 0; b < 8; ++b) acc[b] = (f32x4){0.f, 0.f, 0.f, 0.f};
#pragma unroll 1
        for (int k0 = F.wave * 128; k0 < F.wave * 128 + 128; k0 += 32) {
            f32x4 wv[8];
#pragma unroll
            for (int i = 0; i < 8; ++i) wv[i] = *(const f32x4*)(w + (size_t)(k0 + 4 * i + kr) * 6 * D);
#pragma unroll
            for (int i = 0; i < 8; ++i) { const f32x4 s0 = *(const LAS f32x4*)(sc + (k0 + 4 * i + kr) * 8), s1 = *(const LAS f32x4*)(sc + (k0 + 4 * i + kr) * 8 + 4);
                acc[0] += wv[i] * s0[0]; acc[1] += wv[i] * s0[1]; acc[2] += wv[i] * s0[2]; acc[3] += wv[i] * s0[3]; acc[4] += wv[i] * s1[0]; acc[5] += wv[i] * s1[1]; acc[6] += wv[i] * s1[2]; acc[7] += wv[i] * s1[3]; }
        }
#pragma unroll
        for (int b = 0; b < 8; ++b) {
#pragma unroll
            for (int q = 0; q < 4; ++q) { float v = acc[b][q]; v += __shfl_xor(v, 16); v += __shfl_xor(v, 32); acc[b][q] = v; }
            if (kr == 0) *(LAS f32x4*)(red + (F.wave * 8 + b) * 64 + 4 * c4) = acc[b]; }
        __syncthreads();
        { const int b = F.tid >> 6, c = F.tid & 63; float s = INP(I_ADAB)[l * 6 * D + cb * 64 + c];
          for (int wv = 0; wv < 8; ++wv) s += red[(wv * 8 + b) * 64 + c];
          ((float*)(F.ws + WS_MOD))[((size_t)l * B + b) * 6 * D + cb * 64 + c] = s; }
        __syncthreads();
    }
    constexpr int I0 = 16 * 40, I1 = 16 * 16, IMP = NE * 256 - ND13;
    auto dec = [&](int it) -> ConvItem {
        int r = it; ConvItem c;
        if (r < IMP) return moe_item13(F, 0, ND13 + r);
        r -= IMP; c.kind = 0;
        if (r < I0) { const int kb = r / 40, nb = r % 40, n0 = nb * 64; c.W = INP(I_EWIN); c.ldw = EVEN_PROJ; c.k0 = kb * 64; c.n0 = n0; c.WT = F.ws + WS_WIN0T; c.ldt = D; c.drow0 = nk::win0_row(n0); c.kind = 1; return c; } r -= I0;
        { const int kb = r / 16, nb = r % 16; c.W = INP(I_EWOUT); c.ldw = D; c.k0 = kb * 64; c.n0 = nb * 64; c.WT = F.ws + WS_WOUT0T; c.ldt = D; c.drow0 = nb * 64; return c; }
    };
    conv_tail(F, dec, 11, IMP + I0 + I1);
}
__device__ __forceinline__ void conv_tail_w13(Frame& F) { auto dec = [&](int it) -> ConvItem { return moe_item13(F, 0, it); }; conv_tail(F, dec, 8, ND13); }
__device__ __forceinline__ void conv_tail_w2(Frame& F) { auto dec = [&](int it) -> ConvItem { return moe_item2(F, 0, it); }; conv_tail(F, dec, 9, NE * 128); }
__device__ __forceinline__ void conv_tail_l1(Frame& F) {
    constexpr int I2 = 16 * 48, I3 = 16 * 16;
    auto dec = [&](int it) -> ConvItem {
        int r = it; ConvItem c; c.kind = 0;
        if (r < I2) { const int kb = r / 48, nb = r % 48; c.W = INP(I_OWIN); c.ldw = ODD_PROJ; c.k0 = kb * 64; c.n0 = nb * 64; c.WT = F.ws + WS_WIN1T; c.ldt = D; c.drow0 = nb * 64; c.kind = 2; return c; } r -= I2;
        { const int kb = r / 16, nb = r % 16; c.W = INP(I_OWOUT); c.ldw = D; c.k0 = kb * 64; c.n0 = nb * 64; c.WT = F.ws + WS_WOUT1T; c.ldt = D; c.drow0 = nb * 64; return c; }
    };
    conv_tail(F, dec, 10, I2 + I3);
}

namespace attn_body {
using bf16=unsigned short;
using bf16x8=__attribute__((ext_vector_type(8)))short;
using f32x4v=__attribute__((ext_vector_type(4)))float;
using s16x4=__attribute__((ext_vector_type(4)))short;
using f32x16=__attribute__((ext_vector_type(16)))float;
using u32x4=__attribute__((ext_vector_type(4)))unsigned;
constexpr int BATCH=8,NHEAD=8,SEQ=4096,D=64,DM=2560,DMO=1024;
constexpr int NW=8,QBLK=32,QB=QBLK*NW,KVBLK=64,NQB=SEQ/QB;
constexpr int ATTN_PITCH=DM, ATTN_UNIT_ROWS=QB;
__device__ __forceinline__ int crow(int r,int hi){return (r&3)+8*(r>>2)+4*hi;}
#define SBAR() __builtin_amdgcn_sched_barrier(0)
__device__ __forceinline__ void cmask(f32x16&p0,f32x16&p1,int jb,int qrel,int hi){
  const float NEG=-INFINITY; int kb=64*jb+4*hi;
  #pragma unroll
  for(int r=0;r<16;++r){int kv=kb+(r&3)+8*(r>>2); if(kv>qrel)p0[r]=NEG; if(kv+32>qrel)p1[r]=NEG;}
}

constexpr int NSLOT=3, SLOTB=8192;
constexpr int LDS_K=0, LDS_V=NSLOT*SLOTB, LDS_WS=2*NSLOT*SLOTB, LDS_OST=LDS_WS+NW*64*4, LDS_FB=LDS_OST+NW*4096, LDS_BYTES=LDS_FB+SEQ*4;
constexpr float C2=0.125f*1.4426950408889634f;
__device__ __forceinline__ void glds16(const void*gsrc,unsigned lds_dst){unsigned keep;
  asm volatile("s_mov_b32 %0, m0\n\ts_mov_b32 m0, %2\n\ts_nop 0\n\tglobal_load_lds_dwordx4 %1, off\n\ts_mov_b32 m0, %0":"=&s"(keep):"v"(gsrc),"s"(lds_dst):"memory");}
__device__ __forceinline__ float max3f(float a,float b,float c){float r;asm("v_max3_f32 %0, %1, %2, %3":"=v"(r):"v"(a),"v"(b),"v"(c));return r;}
__device__ __forceinline__ float max2f(float a,float b){float r;asm("v_max_f32_e32 %0, %1, %2":"=v"(r):"v"(a),"v"(b));return r;}
__device__ __forceinline__ float fadd_s(float a,float b){float r;asm("v_add_f32_e32 %0, %1, %2":"=v"(r):"v"(a),"v"(b));return r;}
__device__ __forceinline__ float fsub_s(float a,float b){float r;asm("v_sub_f32_e32 %0, %1, %2":"=v"(r):"v"(a),"v"(b));return r;}
typedef float f32x2_t __attribute__((ext_vector_type(2))); typedef __bf16 bf16x2_t __attribute__((ext_vector_type(2)));
__device__ __forceinline__ unsigned cvtpk_s(float lo,float hi){f32x2_t v={lo,hi};bf16x2_t b=__builtin_convertvector(v,bf16x2_t);return __builtin_bit_cast(unsigned,b);}
#define WAIT_BAR(N) asm volatile("s_waitcnt vmcnt(" #N ") lgkmcnt(0)\n\ts_barrier":::"memory")

__device__ __forceinline__ void qkt(f32x16&p0,f32x16&p1,const char*Kslot,const bf16x8*qr,const f32x16&negm,int r32,int hi){
  const char*kb=Kslot+hi*1024+r32*16;
  #pragma unroll
  for(int d0=0;d0<4;++d0){
    const bf16x8 b0=*reinterpret_cast<const bf16x8*>(kb+d0*2048);
    const bf16x8 b1=*reinterpret_cast<const bf16x8*>(kb+d0*2048+512);
    if(d0==0){p0=__builtin_amdgcn_mfma_f32_32x32x16_bf16(b0,qr[0],negm,0,0,0);p1=__builtin_amdgcn_mfma_f32_32x32x16_bf16(b1,qr[0],negm,0,0,0);}
    else{p0=__builtin_amdgcn_mfma_f32_32x32x16_bf16(b0,qr[d0],p0,0,0,0);p1=__builtin_amdgcn_mfma_f32_32x32x16_bf16(b1,qr[d0],p1,0,0,0);}}
}
typedef __attribute__((address_space(3))) const char* lds_cptr;
typedef short v4i16_t __attribute__((ext_vector_type(4)));
__device__ __forceinline__ void kload8(bf16x8*kf,lds_cptr kp){
  kf[0]=*(const __attribute__((address_space(3))) bf16x8*)(kp);      kf[1]=*(const __attribute__((address_space(3))) bf16x8*)(kp+512);
  kf[2]=*(const __attribute__((address_space(3))) bf16x8*)(kp+2048); kf[3]=*(const __attribute__((address_space(3))) bf16x8*)(kp+2560);
  kf[4]=*(const __attribute__((address_space(3))) bf16x8*)(kp+4096); kf[5]=*(const __attribute__((address_space(3))) bf16x8*)(kp+4608);
  kf[6]=*(const __attribute__((address_space(3))) bf16x8*)(kp+6144); kf[7]=*(const __attribute__((address_space(3))) bf16x8*)(kp+6656);
}
__device__ __forceinline__ void kload2(bf16x8*kf,lds_cptr kp,int j){ kf[2*j]=*(const __attribute__((address_space(3))) bf16x8*)(kp+j*2048); kf[2*j+1]=*(const __attribute__((address_space(3))) bf16x8*)(kp+j*2048+512); }
__device__ __forceinline__ s16x4 vtr(lds_cptr p){ return __builtin_bit_cast(s16x4,__builtin_amdgcn_ds_read_tr16_b64_v4i16((__attribute__((address_space(3))) v4i16_t*)p)); }
__device__ __forceinline__ float rowmax(const f32x16&p0,const f32x16&p1){
  float a=max3f(p0[0],p0[1],p1[0]),b=max3f(p0[2],p0[3],p1[1]);a=max3f(a,p1[2],p1[3]);
  #pragma unroll
  for(int r=4;r<16;r+=4){a=max3f(a,p0[r],p0[r+1]);b=max3f(b,p0[r+2],p0[r+3]);a=max3f(a,p1[r],p1[r+1]);b=max3f(b,p1[r+2],p1[r+3]);}
  const float m=max2f(a,b);
  auto rr=__builtin_amdgcn_permlane32_swap(__float_as_uint(m),__float_as_uint(m),false,false);
  return max2f(__uint_as_float(rr[0]),__uint_as_float(rr[1]));
}
__device__ __forceinline__ void pv(f32x16*o,int vb,bf16x8 pa0,bf16x8 pa1,bf16x8 pa2,bf16x8 pa3){
  #pragma unroll
  for(int d0=0;d0<2;++d0){s16x4 lo[4],hi[4];
    #pragma unroll
    for(int ks=0;ks<4;++ks){
      asm volatile("ds_read_b64_tr_b16 %0,%1 offset:%c2":"=&v"(lo[ks]):"v"(vb),"i"(d0*4096+ks*1024):"memory");
      asm volatile("ds_read_b64_tr_b16 %0,%1 offset:%c2":"=&v"(hi[ks]):"v"(vb),"i"(d0*4096+ks*1024+512):"memory");}
    asm volatile("s_waitcnt lgkmcnt(0)":::"memory");SBAR();
    #define PK(k) (bf16x8){lo[k][0],lo[k][1],lo[k][2],lo[k][3],hi[k][0],hi[k][1],hi[k][2],hi[k][3]}
    o[d0]=__builtin_amdgcn_mfma_f32_32x32x16_bf16(pa0,PK(0),o[d0],0,0,0);
    o[d0]=__builtin_amdgcn_mfma_f32_32x32x16_bf16(pa1,PK(1),o[d0],0,0,0);
    o[d0]=__builtin_amdgcn_mfma_f32_32x32x16_bf16(pa2,PK(2),o[d0],0,0,0);
    o[d0]=__builtin_amdgcn_mfma_f32_32x32x16_bf16(pa3,PK(3),o[d0],0,0,0);
    #undef PK
  }
}

#ifndef ATTN_STORE16
#define ATTN_STORE16(p,v) (*(u32x4*)(p)=(v))
#endif
template<int THRL> __device__ __forceinline__ void attn_unit(int b,int h,int qb,const bf16*Q,const bf16*__restrict__ K,const bf16*__restrict__ V,bf16*O,char*shm,const float*FBg){
  int tid=threadIdx.x; asm volatile("":"+v"(tid)); const int lane=tid&63,r32=lane&31,hi=lane>>5; const int wid=__builtin_amdgcn_readfirstlane(tid>>6);
  const long rowbase=(long)b*SEQ; const int q0=qb*QB;
  const bf16*Qw=Q+(rowbase+q0+wid*QBLK)*DM+h*D;
  const bf16*Kh=K+rowbase*DM+h*D,*Vh=V+rowbase*DM+h*D;
  const unsigned lds0=(unsigned)(uintptr_t)shm;
  float*wsf=(float*)(shm+LDS_WS)+wid*64;
  const bf16*ksrc=Kh+(long)lane*DM+wid*8;
  const bf16*vsrc=Vh+(long)(16*(wid&3)+(lane>>2))*DM+(wid>>2)*32+(lane&3)*8;
  const unsigned kdst=lds0+LDS_K+wid*1024, vdst=lds0+LDS_V+wid*1024;
  #define DMA_K(t,slot) glds16(ksrc+(long)(j0+(t))*KVBLK*DM,(unsigned)__builtin_amdgcn_readfirstlane(kdst+(slot)))
  #define DMA_V(t,slot) glds16(vsrc+(long)(j0+(t))*KVBLK*DM,(unsigned)__builtin_amdgcn_readfirstlane(vdst+(slot)))
  const int vb0=(int)(lds0+LDS_V)+((lane>>4)&1)*32+(lane&3)*8+(4*hi+((lane&15)>>2))*64;
  const char*Kbase=shm+LDS_K; bf16x8 kf[8];
  const lds_cptr shm3=(lds_cptr)shm; const lds_cptr kp0=shm3+LDS_K+hi*1024+r32*16; const lds_cptr vp0=shm3+LDS_V+((lane>>4)&1)*32+(lane&3)*8+(4*hi+((lane&15)>>2))*64;
  const int NT0=(q0+QB)/KVBLK;
  typedef __attribute__((address_space(3))) const f32x4v* lds_f4p;
  { float*fbl=(float*)(shm+LDS_FB); const float*src=FBg+((long)b*NHEAD+h)*SEQ; for(int i=tid*4;i<q0+QB;i+=2048)*(f32x4v*)(fbl+i)=*(const f32x4v*)(src+i); }
  asm volatile("s_waitcnt vmcnt(0) lgkmcnt(0)\n\ts_barrier":::"memory");
  int j0; { const __attribute__((address_space(3))) float*fl=(const __attribute__((address_space(3))) float*)((__attribute__((address_space(3))) char*)shm+LDS_FB);
    const bool far_=(lane<NT0)&&(fl[q0]-fl[64*lane+63]>69.25f); j0=(int)__builtin_popcountll(__ballot(far_))&~1; if(j0>NT0-4)j0=NT0-4; j0=__builtin_amdgcn_readfirstlane(j0); }
  const int NT=NT0-j0;
  const lds_f4p fbp=(lds_f4p)((__attribute__((address_space(3))) const char*)shm+LDS_FB+hi*16)+j0*16;
  #define BIN(Pn,g,idx,tn) do{ const f32x4v b_=(fbp+(tn)*16)[idx]; Pn[4*(g)]=b_[0]-mhat; Pn[4*(g)+1]=b_[1]-mhat; Pn[4*(g)+2]=b_[2]-mhat; Pn[4*(g)+3]=b_[3]-mhat; }while(0)
  #define ADDB(P0,P1,t) do{ const lds_f4p fp_=fbp+(t)*16; _Pragma("unroll") for(int g_=0;g_<4;++g_){ const f32x4v b0_=fp_[2*g_], b1_=fp_[2*g_+8]; \
      P0[4*g_]+=b0_[0];P0[4*g_+1]+=b0_[1];P0[4*g_+2]+=b0_[2];P0[4*g_+3]+=b0_[3]; P1[4*g_]+=b1_[0];P1[4*g_+1]+=b1_[1];P1[4*g_+2]+=b1_[2];P1[4*g_+3]+=b1_[3]; } }while(0)
  DMA_K(0,0);DMA_V(0,0);DMA_K(1,SLOTB);
  bf16x8 qr[4];
  #pragma unroll
  for(int d0=0;d0<4;++d0)qr[d0]=*reinterpret_cast<const bf16x8*>(&Qw[(long)r32*DM+d0*16+hi*8]);
  float mhat=0.f,l_reg=0.f;f32x16 o[2];o[0]=f32x16{};o[1]=f32x16{};
  const int qrel=wid*QBLK+r32;
  #define CMASK(P0,P1,t) do{int jb_=(t)-(NT-4); if(jb_>=0)cmask(P0,P1,jb_,qrel,hi);}while(0)
  bool resc=false;
  #define START(P0,P1) do{ const float rm=rowmax(P0,P1); resc=false; \
    { const float dl=rm; mhat=fadd_s(mhat,dl); \
      _Pragma("unroll") for(int r=0;r<16;++r){P0[r]=fsub_s(P0[r],dl);P1[r]=fsub_s(P1[r],dl);} } \
    _Pragma("unroll") for(int r=0;r<16;++r)P0[r]=__builtin_amdgcn_exp2f(P0[r]); }while(0)
  #define RESC() do{ if(resc){ asm volatile("s_waitcnt lgkmcnt(0)":::"memory"); \
      _Pragma("unroll") for(int d_=0;d_<2;++d_) _Pragma("unroll") for(int r=0;r<16;++r)o[d_][r]*=wsf[crow(r,hi)]; } }while(0)
  f32x16 pA0,pA1,pB0,pB1;
  int sl_prev=0,sl_cur=0,sl_next=SLOTB;
  #define ROT() do{sl_prev=sl_cur;sl_cur=sl_next;sl_next=(sl_next==(NSLOT-1)*SLOTB)?0:sl_next+SLOTB;}while(0)
  DMA_K(2,2*SLOTB);
  WAIT_BAR(3);
  qkt(pA0,pA1,Kbase,qr,f32x16{},r32,hi);asm volatile("s_nop 15\n\ts_nop 7":"+v"(pA0),"+v"(pA1));ADDB(pA0,pA1,0);CMASK(pA0,pA1,0);
  START(pA0,pA1);
  _Pragma("unroll") for(int r=0;r<16;++r)pA1[r]=__builtin_amdgcn_exp2f(pA1[r]);
  { _Pragma("unroll") for(int g_=0;g_<4;++g_){ BIN(pB0,g_,2*g_,1); BIN(pB1,g_,2*g_+8,1); } }
  WAIT_BAR(0);
  DMA_K(3,0);DMA_V(1,SLOTB);
  ROT();
  kload8(kf,kp0+sl_cur);
  WAIT_BAR(2);
  s16x4 vlo[8],vhi[8]; u32x4 pw0,pw1,pw2,pw3;
  #define PKW(P,B) cvtpk_s(P[B],P[B+1])
  #define PAF(k) __builtin_bit_cast(bf16x8,pw##k)
  #define VFR(i) (bf16x8){vlo[i][0],vlo[i][1],vlo[i][2],vlo[i][3],vhi[i][0],vhi[i][1],vhi[i][2],vhi[i][3]}
  #define PIN(x) asm volatile("":"+v"(x))
  #define MX3(a,b,c) __builtin_fmaxf(__builtin_fmaxf((a),(b)),(c))
  #define GAPA(MF,A0,A1,A2,A3,W0,W1,PW) do{ MF; sacc+=A0; sacc+=A1; sacc+=A2; sacc+=A3; PIN(sacc); W0; W1; PIN(PW); SBAR(); }while(0)
  #define EX(v) __builtin_amdgcn_exp2f(v)
  #define GAPB(MF,X,B,TAIL) do{ MF; X[B]=EX(X[B]); X[B+1]=EX(X[B+1]); X[B+2]=EX(X[B+2]); X[B+3]=EX(X[B+3]); PIN(X); TAIL; SBAR(); }while(0)
  #define VRD(i) do{ vlo[i]=vtr(vp_+(((i)>>2)*4096+((i)&3)*1024)); vhi[i]=vtr(vp_+(((i)>>2)*4096+((i)&3)*1024+512)); }while(0)
  #define KRD(G,j) do{ if(G){ kload2(kf,kp0+sl_next,j); SBAR(); } }while(0)
  #define STEP(C0,C1,P0,P1,t,GK,GV,GL) do{ SBAR(); \
    const lds_cptr vp_=vp0+sl_prev; \
    VRD(0); SBAR(); float sacc=(P0[0]+P0[1]); \
    GAPA(C0=__builtin_amdgcn_mfma_f32_32x32x16_bf16(kf[0],qr[0],C0,0,0,0), P0[2],P0[3],P0[4],P0[5],     pw0[0]=PKW(P0,0), pw0[1]=PKW(P0,2), pw0); \
    VRD(4); SBAR(); GAPA(C1=__builtin_amdgcn_mfma_f32_32x32x16_bf16(kf[1],qr[0],C1,0,0,0), P0[6],P0[7],P0[8],P0[9],     pw0[2]=PKW(P0,4), pw0[3]=PKW(P0,6), pw0); \
    VRD(1); SBAR(); GAPA(C0=__builtin_amdgcn_mfma_f32_32x32x16_bf16(kf[2],qr[1],C0,0,0,0),   P0[10],P0[11],P0[12],P0[13], pw1[0]=PKW(P0,8), pw1[1]=PKW(P0,10), pw1); \
    VRD(5); SBAR(); GAPA(C1=__builtin_amdgcn_mfma_f32_32x32x16_bf16(kf[3],qr[1],C1,0,0,0),   P0[14],P0[15],P1[0],P1[1],   pw1[2]=PKW(P0,12),pw1[3]=PKW(P0,14), pw1); \
    VRD(2); SBAR(); GAPA(C0=__builtin_amdgcn_mfma_f32_32x32x16_bf16(kf[4],qr[2],C0,0,0,0),   P1[2],P1[3],P1[4],P1[5],     pw2[0]=PKW(P1,0), pw2[1]=PKW(P1,2), pw2); \
    VRD(6); SBAR(); GAPA(C1=__builtin_amdgcn_mfma_f32_32x32x16_bf16(kf[5],qr[2],C1,0,0,0),   P1[6],P1[7],P1[8],P1[9],     pw2[2]=PKW(P1,4), pw2[3]=PKW(P1,6), pw2); \
    VRD(3); SBAR(); GAPA(C0=__builtin_amdgcn_mfma_f32_32x32x16_bf16(kf[6],qr[3],C0,0,0,0),   P1[10],P1[11],P1[12],P1[13], pw3[0]=PKW(P1,8), pw3[1]=PKW(P1,10), pw3); \
    VRD(7); SBAR(); GAPA(C1=__builtin_amdgcn_mfma_f32_32x32x16_bf16(kf[7],qr[3],C1,0,0,0),   P1[14],P1[15],0.f,0.f,       pw3[2]=PKW(P1,12),pw3[3]=PKW(P1,14), pw3); \
    l_reg+=sacc; \
    if(GK){DMA_K((t)+3,sl_cur);} if(GV){DMA_V((t)+1,sl_next);} \
    CMASK(C0,C1,t); \
    { float a=MX3(C0[0],C0[1],C1[0]),b=MX3(C0[2],C0[3],C1[1]); a=MX3(a,C1[2],C1[3]); \
      _Pragma("unroll") for(int r=4;r<16;r+=4){a=MX3(a,C0[r],C0[r+1]);b=MX3(b,C0[r+2],C0[r+3]);a=MX3(a,C1[r],C1[r+1]);b=MX3(b,C1[r+2],C1[r+3]);} \
      float rm=__builtin_fmaxf(a,b); { auto rr=__builtin_amdgcn_permlane32_swap(__float_as_uint(rm),__float_as_uint(rm),false,false); rm=__builtin_fmaxf(__uint_as_float(rr[0]),__uint_as_float(rr[1])); } \
      resc=false; \
      if(__builtin_expect(__any(rm>(float)THRL),0)){ const float dl=__builtin_fmaxf(rm,0.f); mhat+=dl; \
        _Pragma("unroll") for(int r=0;r<16;++r){C0[r]-=dl;C1[r]-=dl;} \
        const float f=__builtin_amdgcn_exp2f(-dl); l_reg*=f; if(hi==0)wsf[r32]=f; resc=true; } } \
    SBAR(); \
    GAPB(o[0]=__builtin_amdgcn_mfma_f32_32x32x16_bf16(PAF(0),VFR(0),o[0],0,0,0), C0,0,  if(GL){BIN(P0,0,0,(t)+1);}); \
    GAPB(o[1]=__builtin_amdgcn_mfma_f32_32x32x16_bf16(PAF(0),VFR(4),o[1],0,0,0), C0,4,  if(GL){BIN(P1,0,8,(t)+1);}); \
    KRD(GL,0); GAPB(o[0]=__builtin_amdgcn_mfma_f32_32x32x16_bf16(PAF(1),VFR(1),o[0],0,0,0), C0,8,  if(GL){BIN(P0,1,2,(t)+1);}); \
    KRD(GL,1); GAPB(o[1]=__builtin_amdgcn_mfma_f32_32x32x16_bf16(PAF(1),VFR(5),o[1],0,0,0), C0,12, if(GL){BIN(P1,1,10,(t)+1);}); \
    KRD(GL,2); GAPB(o[0]=__builtin_amdgcn_mfma_f32_32x32x16_bf16(PAF(2),VFR(2),o[0],0,0,0), C1,0,  if(GL){BIN(P0,2,4,(t)+1);}); \
    KRD(GL,3); GAPB(o[1]=__builtin_amdgcn_mfma_f32_32x32x16_bf16(PAF(2),VFR(6),o[1],0,0,0), C1,4,  if(GL){BIN(P1,2,12,(t)+1);}); \
    GAPB(o[0]=__builtin_amdgcn_mfma_f32_32x32x16_bf16(PAF(3),VFR(3),o[0],0,0,0), C1,8,  if(GL){BIN(P0,3,6,(t)+1);}); \
    GAPB(o[1]=__builtin_amdgcn_mfma_f32_32x32x16_bf16(PAF(3),VFR(7),o[1],0,0,0), C1,12, if(GL){BIN(P1,3,14,(t)+1);}); \
    }while(0)
  int t=1;
  #undef CMASK
  #define CMASK(P0,P1,t) do{}while(0)
  for(;t+5<NT;t+=2){
    STEP(pB0,pB1,pA0,pA1,t,true,true,true);     WAIT_BAR(2); RESC(); ROT();
    STEP(pA0,pA1,pB0,pB1,t+1,true,true,true);   WAIT_BAR(2); RESC(); ROT();
  }
  #undef CMASK
  #define CMASK(P0,P1,t) do{int jb_=(t)-(NT-4); if(jb_>=0)cmask(P0,P1,jb_,qrel,hi);}while(0)
  #define ENDW(tt) do{ if((tt)+3<NT){WAIT_BAR(2);} else if((tt)+2<NT){WAIT_BAR(1);} else {WAIT_BAR(0);} }while(0)
  for(;t+1<NT;t+=2){
    STEP(pB0,pB1,pA0,pA1,t,(t+3<NT),(t+1<NT),(t+1<NT));       ENDW(t);   RESC(); ROT();
    STEP(pA0,pA1,pB0,pB1,t+1,(t+4<NT),(t+2<NT),(t+2<NT));     ENDW(t+1); RESC(); ROT();
  }
  STEP(pB0,pB1,pA0,pA1,NT-1,false,false,false); RESC();
  { float sacc=pB0[0]+pB0[1]; _Pragma("unroll") for(int r=2;r<16;++r)sacc+=pB0[r]; _Pragma("unroll") for(int r=0;r<16;++r)sacc+=pB1[r]; l_reg+=sacc;
    pw0=(u32x4){PKW(pB0,0),PKW(pB0,2),PKW(pB0,4),PKW(pB0,6)};pw1=(u32x4){PKW(pB0,8),PKW(pB0,10),PKW(pB0,12),PKW(pB0,14)};pw2=(u32x4){PKW(pB1,0),PKW(pB1,2),PKW(pB1,4),PKW(pB1,6)};pw3=(u32x4){PKW(pB1,8),PKW(pB1,10),PKW(pB1,12),PKW(pB1,14)};
    SBAR(); pv(o,vb0+sl_cur,PAF(0),PAF(1),PAF(2),PAF(3)); }
  #undef PKW
  #undef PAF
  #undef VFR
  #undef PIN
  #undef MX3
  #undef GAPA
  #undef GAPB
  #undef EX
  #undef VRD
  #undef KRD
  #undef STEP
  #undef ENDW
  {auto rr=__builtin_amdgcn_permlane32_swap(__float_as_uint(l_reg),__float_as_uint(l_reg),false,false);l_reg=__uint_as_float(rr[0])+__uint_as_float(rr[1]);}
  if(hi==0)wsf[32+r32]=l_reg;asm volatile("s_waitcnt lgkmcnt(0)":::"memory");
  float rli[16];
  #pragma unroll
  for(int r=0;r<16;++r)rli[r]=__builtin_amdgcn_rcpf(wsf[32+crow(r,hi)]);
  bf16*Ow=O+(rowbase+q0+wid*QBLK)*DMO+h*D;
  { bf16*stg=(bf16*)(shm+LDS_OST)+wid*2048;
    #pragma unroll
    for(int r=0;r<16;++r){const int orow=crow(r,hi);
      #pragma unroll
      for(int d0=0;d0<2;++d0)stg[orow*64+d0*32+r32]=(bf16)f2bf(o[d0][r]*rli[r]);}
    asm volatile("s_waitcnt lgkmcnt(0)":::"memory");
    #pragma unroll
    for(int i=0;i<4;++i){const int row=i*8+(lane>>3),ch=lane&7; const u32x4 v=*(const u32x4*)(stg+row*64+ch*8); ATTN_STORE16(Ow+(long)row*DMO+ch*8,v);} }
  asm volatile("s_waitcnt lgkmcnt(0)\n\ts_barrier":::"memory");
  #undef DMA_K
  #undef DMA_V
  #undef ADDB
  #undef BIN
  #undef CMASK
  #undef START
  #undef RESC
  #undef ROT
}
constexpr int ATTN_LDS_BYTES=LDS_BYTES;
#undef SBAR
#undef WAIT_BAR
}

__device__ __forceinline__ void fb_cumsum(Frame& F) {
    const int gwv = F.bid * NWAVES + F.wave; if (gwv >= 64) return;
    const float* lf = (const float*)(F.ws + WS_LOGF) + ((size_t)(gwv >> 3) * S) * 8 + (gwv & 7);
    float* fb = (float*)(F.ws + WS_FB) + (size_t)gwv * S;
    float carry = 0.f;
#pragma unroll 1
    for (int i0 = 0; i0 < 64; i0 += 8) {
        float v[8];
#pragma unroll
        for (int k = 0; k < 8; ++k) v[k] = lf[(size_t)((i0 + k) * 64 + F.lane) * 8];
#pragma unroll
        for (int k = 0; k < 8; ++k) { float x = v[k];
#pragma unroll
            for (int o = 1; o < 64; o <<= 1) { const float n = __shfl_up(x, o); if (F.lane >= o) x += n; }
            x += carry; fb[(i0 + k) * 64 + F.lane] = -LOG2E * x; carry = __shfl(x, 63); }
    }
}
__device__ __forceinline__ void rnn_task(Frame& F, int b, int n, int half) {
    typedef short bf16x8 __attribute__((ext_vector_type(8)));
    constexpr int O_XR = 0, O_GR = 16896, O_XB = 25088, O_AA = 43520, O_UU = 59904, O_SEG = 76288, O_CAR = 80384, O_WT = 80640;
    LAS float* seg = (LAS float*)(F.lds + O_SEG);
    LAS float* carry = (LAS float*)(F.lds + O_CAR);
    LAS bf16_t* wT = (LAS bf16_t*)(F.lds + O_WT);
    const int tid = F.tid, lane = F.lane, wave = F.wave;
    { const float* erw = INP(I_ERW); const float* eiw = INP(I_EIW);
      for (int idx = tid; idx < 4096; idx += NTHREADS) { const int g = idx >> 11, d = (idx >> 5) & 63, e = idx & 31; wT[(g * 32 + e) * 72 + d] = (bf16_t)f2bf((g ? eiw : erw)[(n * 64 + d) * 64 + 32 * half + e]); } }
    if (tid < 64) carry[tid] = 0.f;
    __syncthreads();
    const int l15 = lane & 15, kg = lane >> 4;
    bf16x8 Br[2][2], Bi[2][2];
#pragma unroll
    for (int ks = 0; ks < 2; ++ks)
#pragma unroll
        for (int nt = 0; nt < 2; ++nt) { Br[ks][nt] = *(const LAS bf16x8*)(wT + (16 * nt + l15) * 72 + 32 * ks + 8 * kg); Bi[ks][nt] = *(const LAS bf16x8*)(wT + (32 + 16 * nt + l15) * 72 + 32 * ks + 8 * kg); }
    float rbe[2], ibe[2], la[2], e0[2], e1[2], e2[2], e3[2], ebias[2];
    { const float* erb = INP(I_ERB); const float* eib = INP(I_EIB); const float* elam = INP(I_ELAM); const float* ecw = INP(I_ECW); const float* ecb = INP(I_ECB);
#pragma unroll
      for (int nt = 0; nt < 2; ++nt) { const int chg = n * 64 + 32 * half + 16 * nt + l15;
          rbe[nt] = erb[chg]; ibe[nt] = eib[chg]; la[nt] = -8.0f * softplusf_(-elam[chg]); e0[nt] = ecw[chg]; e1[nt] = ecw[D_RNN + chg]; e2[nt] = ecw[2 * D_RNN + chg]; e3[nt] = ecw[3 * D_RNN + chg]; ebias[nt] = ecb[chg]; } }
    const int ch = tid & 63, tq = tid >> 6, cch = n * 64 + ch;
    float c0, c1, c2, c3, cbias;
    { const float* ecw = INP(I_ECW); c0 = ecw[cch]; c1 = ecw[D_RNN + cch]; c2 = ecw[2 * D_RNN + cch]; c3 = ecw[3 * D_RNN + cch]; cbias = INP(I_ECB)[cch]; }
    const int sch = tid & 31, sg = tid >> 5;
    const int srow = tid >> 3, spc = tid & 7, grow = tid >> 2, gpc = tid & 3;
    const bf16_t* px = (const bf16_t*)(F.ws + WS_PROJ) + (size_t)b * S * P0W + n * 64 + spc * 8;
    const bf16_t* pgt = (const bf16_t*)(F.ws + WS_PROJ) + (size_t)b * S * P0W + D_RNN + n * 64 + 32 * half + gpc * 8;
    bf16_t* py = (bf16_t*)(F.ws + WS_YMIX) + (size_t)b * S * D + n * 64 + 32 * half + sch;
    u32x4 xr0, xr1, xh, gr0;
#define RNN_LOAD(t0) do { const bf16_t* p_ = px + (size_t)((t0) + srow) * P0W; xr0 = *(const u32x4*)p_; xr1 = *(const u32x4*)(p_ + (size_t)64 * P0W); gr0 = *(const u32x4*)(pgt + (size_t)((t0) + grow) * P0W); \
        xh = (u32x4){0u, 0u, 0u, 0u}; if (tid < 24 && (t0) > 0) xh = *(const u32x4*)(px + (size_t)((t0) - 3 + srow) * P0W); } while (0)
    RNN_LOAD(0);
    int o_st = (srow * 64 + spc * 8) * 2;
    int o_gs = (grow * 32 + gpc * 8) * 2;
    int o_cv = (tq * 16 * 64 + ch) * 2;
    int o_xb = (tq * 16 * 72 + ch) * 2;
    int o_af = ((16 * wave + l15) * 72 + 8 * kg) * 2;
    int o_e2 = ((16 * wave + 4 * kg) * 64 + 32 * half + l15) * 2;
    int o_e4 = ((16 * wave + 4 * kg) * 32 + l15) * 4;
    int o_sc = (sg * 8 * 32 + sch) * 4;
    int o_gg = (sg * 8 * 32 + sch) * 2;
    LAS unsigned char* L = F.lds;
#pragma unroll 1
    for (int c = 0; c < S / 128; ++c) {
        const int t0 = c * 128;
        asm volatile("" : "+v"(o_st), "+v"(o_gs), "+v"(o_cv), "+v"(o_xb), "+v"(o_af), "+v"(o_e2), "+v"(o_e4), "+v"(o_sc), "+v"(o_gg));
        *(LAS u32x4*)(L + O_XR + o_st + 3 * 128) = xr0; *(LAS u32x4*)(L + O_XR + o_st + 67 * 128) = xr1;
        *(LAS u32x4*)(L + O_GR + o_gs) = gr0;
        if (tid < 24) *(LAS u32x4*)(L + O_XR + o_st) = xh;
        LDS_BARRIER();
        if (c + 1 < S / 128) RNN_LOAD(t0 + 128);
        { float w0 = bf2f(*(LAS bf16_t*)(L + O_XR + o_cv)), w1 = bf2f(*(LAS bf16_t*)(L + O_XR + o_cv + 128)), w2 = bf2f(*(LAS bf16_t*)(L + O_XR + o_cv + 256));
#pragma unroll
          for (int i = 0; i < 16; ++i) { const float w3 = bf2f(*(LAS bf16_t*)(L + O_XR + o_cv + (i + 3) * 128)); *(LAS bf16_t*)(L + O_XB + o_xb + i * 144) = (bf16_t)f2bf(cbias + c0 * w0 + c1 * w1 + c2 * w2 + c3 * w3); w0 = w1; w1 = w2; w2 = w3; } }
        LDS_BARRIER();
        { f32x4 R[2] = {(f32x4){0.f, 0.f, 0.f, 0.f}, (f32x4){0.f, 0.f, 0.f, 0.f}}, I[2] = {(f32x4){0.f, 0.f, 0.f, 0.f}, (f32x4){0.f, 0.f, 0.f, 0.f}};
#pragma unroll
          for (int ks = 0; ks < 2; ++ks) { const bf16x8 af = *(const LAS bf16x8*)(L + O_XB + o_af + ks * 64);
#pragma unroll
              for (int nt = 0; nt < 2; ++nt) { R[nt] = __builtin_amdgcn_mfma_f32_16x16x32_bf16(af, Br[ks][nt], R[nt], 0, 0, 0); I[nt] = __builtin_amdgcn_mfma_f32_16x16x32_bf16(af, Bi[ks][nt], I[nt], 0, 0, 0); } }
#pragma unroll
          for (int nt = 0; nt < 2; ++nt)
#pragma unroll
              for (int r = 0; r < 4; ++r) {
                  const float xc = ebias[nt] + e0[nt] * bf2f(*(LAS bf16_t*)(L + O_XR + o_e2 + nt * 32 + r * 128)) + e1[nt] * bf2f(*(LAS bf16_t*)(L + O_XR + o_e2 + nt * 32 + (r + 1) * 128))
                                 + e2[nt] * bf2f(*(LAS bf16_t*)(L + O_XR + o_e2 + nt * 32 + (r + 2) * 128)) + e3[nt] * bf2f(*(LAS bf16_t*)(L + O_XR + o_e2 + nt * 32 + (r + 3) * 128));
                  const float rr = fsigmoid(R[nt][r] + rbe[nt]), gi = fsigmoid(I[nt][r] + ibe[nt]), av = __builtin_amdgcn_exp2f(LOG2E * la[nt] * rr);
                  *(LAS float*)(L + O_AA + o_e4 + nt * 64 + r * 128) = av; *(LAS float*)(L + O_UU + o_e4 + nt * 64 + r * 128) = __builtin_amdgcn_sqrtf(fmaxf((1.f - av) * (1.f + av), 0.f)) * (gi * xc); } }
        LDS_BARRIER();
        { float A = 1.f, U = 0.f;
#pragma unroll
          for (int i = 0; i < 8; ++i) { const float a = *(LAS float*)(L + O_AA + o_sc + i * 128), u = *(LAS float*)(L + O_UU + o_sc + i * 128); U = a * U + u; A = a * A; }
          seg[sg * 32 + sch] = A; seg[512 + sg * 32 + sch] = U; }
        LDS_BARRIER();
        { float h = carry[(c & 1) * 32 + sch];
          { float sa[15], su[15];
#pragma unroll
            for (int s = 0; s < 15; ++s) { sa[s] = seg[s * 32 + sch]; su[s] = seg[512 + s * 32 + sch]; }
#pragma unroll
            for (int s = 0; s < 15; ++s) if (s < sg) h = sa[s] * h + su[s]; }
          bf16_t* pyc = py + (size_t)(t0 + sg * 8) * D;
#pragma unroll
          for (int i = 0; i < 8; ++i) { h = *(LAS float*)(L + O_AA + o_sc + i * 128) * h + *(LAS float*)(L + O_UU + o_sc + i * 128); pyc[(size_t)i * D] = (bf16_t)f2bf(h * fgelu(bf2f(*(LAS bf16_t*)(L + O_GR + o_gg + i * 64)))); }
          if (sg == 15) carry[((c + 1) & 1) * 32 + sch] = h; }
        LDS_BARRIER();
    }
#undef RNN_LOAD
}
__device__ __forceinline__ void ph_mixer0(Frame& F, unsigned char* lds_generic, int qi) {
    LAS volatile int* qslot = (LAS volatile int*)(F.lds + 160 * 1024 - 64);
    unsigned* qhead = (unsigned*)(F.ws + WS_CTL) + CW_QUEUE + 64 * qi;
    const bf16_t* P = (const bf16_t*)(F.ws + WS_PROJ);
#define MIX_FETCH(item) do { if (F.tid == 0) qslot[0] = (int)atomicAdd(qhead, 1u); __syncthreads(); item = qslot[0]; __syncthreads(); } while (0)
    int item; MIX_FETCH(item);
#pragma unroll 1
    while (item < 128) {
#ifndef MK_NO_RNN
        rnn_task(F, item >> 4, (item >> 1) & 7, item & 1);
#endif
        MIX_FETCH(item); }
#pragma unroll 1
    while (item < 128 + 1024) { const int u = item - 128, qb = 15 - (u >> 6), bh = u & 63;
#ifndef MK_NO_ATTN
        attn_body::attn_unit<8>(bh >> 3, bh & 7, qb, P + 1024, P + 1536, P + 2048, (bf16_t*)(F.ws + WS_YMIX) + D_RNN, (char*)lds_generic, (const float*)(F.ws + WS_FB));
#endif
        MIX_FETCH(item); }
#undef MIX_FETCH
}


namespace gla {
typedef short bf16x8 __attribute__((ext_vector_type(8)));
typedef float f32x16 __attribute__((ext_vector_type(16)));
constexpr int QTP = 136;
__device__ __forceinline__ int dkperm(int c) { return (c & ~12) | ((c & 4) << 1) | ((c & 8) >> 1); }

struct G1Regs { u32x4 q[2], k[2]; f32x4 g; };
__device__ __forceinline__ void g1_load(G1Regs& R, const unsigned char* ws, int cidx, int tid) {
    const int n = cidx & 63, h = (cidx >> 6) & 3, b = cidx >> 8; const size_t row0 = (size_t)b * S + n * 64;
    const bf16_t* P = (const bf16_t*)(ws + WS_PROJ);
#pragma unroll
    for (int i = 0; i < 2; ++i) { const int p = tid + i * 512, tok = p >> 4, c = p & 15; R.q[i] = *(const u32x4*)(P + (row0 + tok) * P1W + h * 128 + c * 8); R.k[i] = *(const u32x4*)(P + (row0 + tok) * P1W + 512 + h * 128 + c * 8); }
    R.g = *(const f32x4*)((const float*)(ws + WS_GLOW) + row0 * 16 + (tid & 255) * 4);
}
__device__ __forceinline__ float flogsig(float z) { return fminf(z, 0.f) - 0.6931471805599453f * __builtin_amdgcn_logf(1.f + __builtin_amdgcn_exp2f(-LOG2E * fabsf(z))); }
__device__ __forceinline__ void ph_g1(Frame& F) {
    const int tid = F.tid, lane = F.lane, wave = F.wave;
    LAS float* glw = (LAS float*)(F.lds);
    LAS float* segt = (LAS float*)(F.lds + 4096);
    LAS bf16_t* qst = (LAS bf16_t*)(F.lds + 8192);
    LAS bf16_t* kst = (LAS bf16_t*)(F.lds + 8192 + 16384);
    LAS bf16_t* qtl = (LAS bf16_t*)(F.lds + 40960);
    LAS bf16_t* ktl = (LAS bf16_t*)(F.lds + 40960 + 64 * QTP * 2);
    LAS bf16_t* ket = (LAS bf16_t*)(F.lds + 40960 + 128 * QTP * 2);
    LAS bf16_t* aml = (LAS bf16_t*)(F.lds + 40960 + 128 * QTP * 2 + 128 * 72 * 2);
    const int col = tid & 127, tg4 = tid >> 7;
    G1Regs R;
    int cidx = F.bid;
    if (cidx < B * GH * 64) g1_load(R, F.ws, cidx, tid);
#pragma unroll 1
    for (; cidx < B * GH * 64; cidx += F.G) {
        const int n = cidx & 63, h = (cidx >> 6) & 3, b = cidx >> 8, dk = h * 128 + col;
        const size_t row0 = (size_t)b * S + n * 64;
        if (tid < 256) *(LAS f32x4*)(glw + tid * 4) = R.g;
#pragma unroll
        for (int i = 0; i < 2; ++i) { const int p = tid + i * 512, tok = p >> 4, c = p & 15; *(LAS u32x4*)(qst + tok * 128 + c * 8) = R.q[i]; *(LAS u32x4*)(kst + tok * 128 + c * 8) = R.k[i]; }
        float w2[16];
        { const float* gw2 = INP(I_OGW2);
#pragma unroll
          for (int j = 0; j < 16; ++j) w2[j] = gw2[j * GDK + dk]; }
        const float gb = INP(I_OGB)[dk];
        LDS_BARRIER();
        { const int nx = cidx + F.G < B * GH * 64 ? cidx + F.G : cidx; g1_load(R, F.ws, nx, tid); }
        float cl[16]; float run = 0.f;
#pragma unroll
        for (int i = 0; i < 16; ++i) { const int tok = tg4 * 16 + i; float z = gb;
#pragma unroll
            for (int j4 = 0; j4 < 4; ++j4) { const f32x4 g = *(const LAS f32x4*)(glw + tok * 16 + j4 * 4); z += g[0] * w2[j4 * 4] + g[1] * w2[j4 * 4 + 1] + g[2] * w2[j4 * 4 + 2] + g[3] * w2[j4 * 4 + 3]; }
            run += flogsig(z) * (1.f / 16.f); cl[i] = run; }
        segt[tg4 * 128 + col] = run;
        LDS_BARRIER();
        float base = 0.f, last = 0.f;
#pragma unroll
        for (int g = 0; g < 4; ++g) { const float s = segt[g * 128 + col]; if (g < tg4) base += s; last += s; }
        unsigned kw[8];
#pragma unroll
        for (int i = 0; i < 16; ++i) { const int tok = tg4 * 16 + i; const float cum = base + cl[i];
            const float q = bf2f(qst[tok * 128 + col]) * 0.08838834764831845f, k = bf2f(kst[tok * 128 + col]);
            const float ec = __builtin_amdgcn_exp2f(LOG2E * cum), qt = q * ec, kt = k * __builtin_amdgcn_rcpf(ec), ke = k * __builtin_amdgcn_exp2f(LOG2E * (last - cum));
            qtl[tok * QTP + col] = (bf16_t)f2bf(qt); ktl[tok * QTP + col] = (bf16_t)f2bf(kt);
            if (i & 1) kw[i >> 1] |= f2bf(ke) << 16; else kw[i >> 1] = f2bf(ke); }
        *(LAS u32x4*)(ket + col * 72 + tg4 * 16) = (u32x4){kw[0], kw[1], kw[2], kw[3]}; *(LAS u32x4*)(ket + col * 72 + tg4 * 16 + 8) = (u32x4){kw[4], kw[5], kw[6], kw[7]};
        if (tg4 == 0) ((float*)(F.ws + WS_DECAY))[(size_t)cidx * 128 + col] = __builtin_amdgcn_exp2f(LOG2E * last);
        LDS_BARRIER();
        if (wave < 4) {
            const int tt = wave & 1, st = wave >> 1, l31 = lane & 31, hi = lane >> 5;
            f32x16 acc = {};
            if (!(tt == 0 && st == 1)) {
#pragma unroll
                for (int ks = 0; ks < 8; ++ks) { const bf16x8 af = *(const LAS bf16x8*)(qtl + (32 * tt + l31) * QTP + 16 * ks + 8 * hi), bfr = *(const LAS bf16x8*)(ktl + (32 * st + l31) * QTP + 16 * ks + 8 * hi);
                    acc = __builtin_amdgcn_mfma_f32_32x32x16_bf16(af, bfr, acc, 0, 0, 0); } }
            const int s = 32 * st + l31;
#pragma unroll
            for (int r = 0; r < 16; ++r) { const int t = 32 * tt + (r & 3) + 8 * (r >> 2) + 4 * hi; aml[t * 72 + s] = (bf16_t)f2bf(s <= t ? acc[r] : 0.f); }
        }
#pragma unroll
        for (int i = 0; i < 2; ++i) { const int p = tid + i * 512, tok = p >> 4, c = p & 15; const LAS bf16_t* s0 = qtl + tok * QTP + 16 * (c >> 1) + 4 * (c & 1);
            const u32x2 lo = *(const LAS u32x2*)s0, hi2 = *(const LAS u32x2*)(s0 + 8);
            *(u32x4*)((bf16_t*)(F.ws + WS_YMIX) + (row0 + tok) * GDK + h * 128 + c * 8) = (u32x4){lo.x, lo.y, hi2.x, hi2.y}; }
#pragma unroll
        for (int i = 0; i < 2; ++i) { const int p = tid + i * 512, d = p >> 3, c = p & 7;
            *(u32x4*)((bf16_t*)(F.ws + WS_YMIX + (size_t)T * GDK * 2) + ((size_t)cidx * 128 + d) * 64 + c * 8) = *(const LAS u32x4*)(ket + d * 72 + c * 8); }
        LDS_BARRIER();
        { const int t = tid >> 3, c = tid & 7; *(u32x4*)((bf16_t*)(F.ws + WS_AMAT) + (size_t)cidx * 4096 + t * 64 + c * 8) = *(const LAS u32x4*)(aml + t * 72 + c * 8); }
        LDS_BARRIER();
    }
    __syncthreads();
}

constexpr int NSP = 4, G2_CW = 8 / NSP, G2_DV = 256 / NSP;
constexpr int QP = 272, KP = 144, AP = 144, VP = G2_DV * 2 + 8;
constexpr int G2_Q = 0, G2_K = G2_Q + 64 * QP, G2_A = G2_K + 128 * KP, G2_V = G2_A + 64 * AP, G2_D = G2_V + 64 * VP, G2_STAGE = G2_D + 512;
constexpr int G2_LT = 256;
constexpr int G2_VPC = G2_DV / 8, G2_QN = 1024 / G2_LT, G2_AN = 512 / G2_LT, G2_VN = 64 * G2_VPC / G2_LT;
struct G2Regs { u32x4 q[G2_QN], k[G2_QN], a[G2_AN], v[G2_VN]; f32x4 d; };
struct G2Offs { unsigned q[G2_QN], k[G2_QN], a[G2_AN], v[G2_VN], d; };
__device__ __forceinline__ void g2_offs(G2Offs& O, int lt) {
#pragma unroll
    for (int i = 0; i < G2_QN; ++i) { const int p = lt + i * G2_LT; O.q[i] = (unsigned)((p >> 4) * GDK + (p & 15) * 8) * 2u; O.k[i] = (unsigned)p * 16u; }
#pragma unroll
    for (int i = 0; i < G2_AN; ++i) O.a[i] = (unsigned)(lt + i * G2_LT) * 16u;
#pragma unroll
    for (int i = 0; i < G2_VN; ++i) { const int p = lt + i * G2_LT; O.v[i] = (unsigned)((p / G2_VPC) * P1W + (p % G2_VPC) * 8) * 2u; }
    O.d = (unsigned)(lt & 31) * 16u;
}
#define G2_GLD(dst, voff) asm volatile("global_load_dwordx4 %0, %1, %2" : "=v"(dst) : "v"(voff), "s"(ws) : "memory")
__device__ __forceinline__ void g2_load(G2Regs& R, const G2Offs& O, const unsigned char* ws, int b, int h, int part, int n) {
    const unsigned cidx = (unsigned)((b * 4 + h) * 64 + n), row0 = (unsigned)(b * S + n * 64);
    const unsigned oq = (unsigned)WS_YMIX + (row0 * GDK + h * 128) * 2u, ok = (unsigned)(WS_YMIX + (size_t)T * GDK * 2) + cidx * 16384u;
    const unsigned oa = (unsigned)WS_AMAT + cidx * 8192u, ov = (unsigned)WS_PROJ + (row0 * P1W + 1024 + h * 256 + part * G2_DV) * 2u, od = (unsigned)WS_DECAY + cidx * 512u;
#pragma unroll
    for (int i = 0; i < G2_QN; ++i) { const unsigned a0 = oq + O.q[i], a1 = ok + O.k[i]; G2_GLD(R.q[i], a0); G2_GLD(R.k[i], a1); }
#pragma unroll
    for (int i = 0; i < G2_AN; ++i) { const unsigned a0 = oa + O.a[i]; G2_GLD(R.a[i], a0); }
#pragma unroll
    for (int i = 0; i < G2_VN; ++i) { const unsigned a0 = ov + O.v[i]; G2_GLD(R.v[i], a0); }
    { const unsigned a0 = od + O.d; u32x4 t; G2_GLD(t, a0); R.d = __builtin_bit_cast(f32x4, t); }
}
constexpr int G2_NLD = 2 * G2_QN + G2_AN + G2_VN + 1;
__device__ __forceinline__ void g2_store(const G2Regs& R, LAS unsigned char* st, int lt) {
#pragma unroll
    for (int i = 0; i < G2_QN; ++i) { const int p = lt + i * G2_LT; *(LAS u32x4*)(st + G2_Q + (p >> 4) * QP + (p & 15) * 16) = R.q[i]; *(LAS u32x4*)(st + G2_K + (p >> 3) * KP + (p & 7) * 16) = R.k[i]; }
#pragma unroll
    for (int i = 0; i < G2_AN; ++i) { const int p = lt + i * G2_LT; *(LAS u32x4*)(st + G2_A + (p >> 3) * AP + (p & 7) * 16) = R.a[i]; }
#pragma unroll
    for (int i = 0; i < G2_VN; ++i) { const int p = lt + i * G2_LT; *(LAS u32x4*)(st + G2_V + (p / G2_VPC) * VP + (p % G2_VPC) * 16) = R.v[i]; }
    *(LAS f32x4*)(st + G2_D + (lt & 31) * 16) = R.d;
}
constexpr int OP = G2_DV * 2 + 16, G2_OB = 2 * G2_STAGE, G2_OBSZ = 64 * OP;
static_assert(G2_OB + 2 * G2_OBSZ <= LDS_BYTES - 512, "G2 LDS map");
__device__ __forceinline__ bf16x8 pk8(const f32x16& X, int s) {
    typedef float f32x2_t __attribute__((ext_vector_type(2))); typedef __bf16 bf16x2_t __attribute__((ext_vector_type(2)));
    union { bf16x8 v; unsigned u[4]; } r;
#pragma unroll
    for (int q = 0; q < 4; ++q) { f32x2_t p = {X[8 * s + 2 * q], X[8 * s + 2 * q + 1]}; r.u[q] = __builtin_bit_cast(unsigned, __builtin_convertvector(p, bf16x2_t)); }
    return r.v;
}
__device__ __forceinline__ void g2_compute(f32x16 (&St)[4], const LAS unsigned char* st, LAS unsigned char* obuf, int w, int l31, int hi) {
#define SB() __builtin_amdgcn_sched_barrier(0)
#define MF(a, b, c) __builtin_amdgcn_mfma_f32_32x32x16_bf16(a, b, c, 0, 0, 0)
    const LAS unsigned char* pa = st + G2_A + l31 * AP + hi * 16;
    const LAS unsigned char* pq = st + G2_Q + l31 * QP + hi * 16;
    const LAS unsigned char* pk = st + G2_K + l31 * KP + hi * 16;
    bf16x8 fa[8], fb[8], Vf[4];
#pragma unroll
    for (int ks = 0; ks < 4; ++ks) { const LAS unsigned char* vp = st + G2_V + (16 * ks + 8 * hi) * VP + (32 * w + l31) * 2;
#pragma unroll
        for (int j = 0; j < 8; ++j) Vf[ks][j] = (short)*(const LAS bf16_t*)(vp + j * VP); }
#pragma unroll
    for (int i = 0; i < 8; ++i) fa[i] = *(const LAS bf16x8*)(pa + (i >> 2) * 32 * AP + (i & 3) * 32);
    SB();
#pragma unroll
    for (int i = 0; i < 8; ++i) fb[i] = *(const LAS bf16x8*)(pq + (i & 1) * 32 * QP + (i >> 1) * 32);
    SB();
    f32x16 O[2] = {f32x16{}, f32x16{}};
#pragma unroll
    for (int i = 0; i < 8; ++i) O[i >> 2] = MF(fa[i], Vf[i & 3], O[i >> 2]);
    SB();
#pragma unroll
    for (int i = 0; i < 8; ++i) fa[i] = *(const LAS bf16x8*)(pq + (i & 1) * 32 * QP + (4 + (i >> 1)) * 32);
    SB();
#pragma unroll
    for (int c = 0; c < 4; ++c) { const bf16x8 sf = pk8(St[c >> 1], c & 1); O[0] = MF(fb[2 * c], sf, O[0]); O[1] = MF(fb[2 * c + 1], sf, O[1]); }
    SB();
#pragma unroll
    for (int i = 0; i < 8; ++i) fb[i] = *(const LAS bf16x8*)(pk + (i >> 2) * 32 * KP + (i & 3) * 32);
    SB();
#pragma unroll
    for (int c = 0; c < 4; ++c) { const bf16x8 sf = pk8(St[2 + (c >> 1)], c & 1); O[0] = MF(fa[2 * c], sf, O[0]); O[1] = MF(fa[2 * c + 1], sf, O[1]); }
    SB();
#pragma unroll
    for (int i = 0; i < 8; ++i) fa[i] = *(const LAS bf16x8*)(pk + (2 + (i >> 2)) * 32 * KP + (i & 3) * 32);
#pragma unroll
    for (int kt = 0; kt < 4; ++kt)
#pragma unroll
        for (int g = 0; g < 4; ++g) { const f32x4 dv = *(const LAS f32x4*)(st + G2_D + (32 * kt + 8 * g + 4 * hi) * 4); St[kt][4 * g] *= dv[0]; St[kt][4 * g + 1] *= dv[1]; St[kt][4 * g + 2] *= dv[2]; St[kt][4 * g + 3] *= dv[3]; }
    SB();
#pragma unroll
    for (int i = 0; i < 8; ++i) St[i >> 2] = MF(fb[i], Vf[i & 3], St[i >> 2]);
    SB();
#pragma unroll
    for (int i = 0; i < 8; ++i) St[2 + (i >> 2)] = MF(fa[i], Vf[i & 3], St[2 + (i >> 2)]);
    SB();
    LAS bf16_t* ob = (LAS bf16_t*)(obuf + (4 * hi) * OP) + 32 * w + l31;
#pragma unroll
    for (int tt = 0; tt < 2; ++tt)
#pragma unroll
        for (int r = 0; r < 16; ++r) ob[(32 * tt + (r & 3) + 8 * (r >> 2)) * (OP / 2)] = (bf16_t)f2bf(O[tt][r]);
#undef SB
#undef MF
}
__device__ __forceinline__ void g2_task(Frame& F, int bh, int part) {
    const int b = bh >> 2, h = bh & 3, tid = F.tid, lane = F.lane, w = F.wave, l31 = lane & 31, hi = lane >> 5;
    if (w < G2_CW) {
        f32x16 St[4];
#pragma unroll
        for (int kt = 0; kt < 4; ++kt) St[kt] = f32x16{};
        LDS_BARRIER();
#pragma unroll 1
        for (int n = 0; n < 64; ++n) { g2_compute(St, F.lds + (n & 1) * G2_STAGE, F.lds + G2_OB + (n & 1) * G2_OBSZ, w, l31, hi); LDS_BARRIER(); }
    } else if (w >= G2_CW + 4) {
        for (int n = 0; n < 65; ++n) LDS_BARRIER();
    } else {
        const int lt = tid - G2_CW * 64;
        G2Regs R0, R1, R2;
        G2Offs GO; g2_offs(GO, lt);
        bf16_t* Og = (bf16_t*)(F.ws + WS_XN) + ((size_t)b * S) * D + h * 256 + part * G2_DV;
        constexpr int OPC = G2_DV / 8, ON = 64 * OPC / G2_LT;
#define G2_OSTORE(n_, buf_) do { const LAS unsigned char* ob_ = F.lds + G2_OB + (buf_) * G2_OBSZ; _Pragma("unroll") for (int i_ = 0; i_ < ON; ++i_) { const int p_ = lt + i_ * G2_LT, tok_ = p_ / OPC, c_ = p_ % OPC; \
            *(u32x4*)(Og + (size_t)((n_) * 64 + tok_) * D + c_ * 8) = *(const LAS u32x4*)(ob_ + tok_ * OP + c_ * 16); } } while (0)
#define G2_WAIT(N) do { asm volatile("s_waitcnt vmcnt(%0)" :: "n"(N) : "memory"); __builtin_amdgcn_sched_barrier(0); } while (0)
        g2_load(R0, GO, F.ws, b, h, part, 0); G2_WAIT(0); g2_store(R0, F.lds, lt);
        g2_load(R1, GO, F.ws, b, h, part, 1); g2_load(R2, GO, F.ws, b, h, part, 2); g2_load(R0, GO, F.ws, b, h, part, 3);
        G2_WAIT(2 * G2_NLD);
        LDS_BARRIER();
        constexpr int WAITN = 2 * G2_NLD + ON;
#define G2_HS(n_, SET, STG) do { G2_WAIT(WAITN); g2_store(SET, F.lds + (STG) * G2_STAGE, lt); G2_OSTORE((n_) > 0 ? (n_) - 1 : 0, ((n_) + 1) & 1); \
            g2_load(SET, GO, F.ws, b, h, part, (n_) + 4); LDS_BARRIER(); } while (0)
#define G2_HT(n_, SET, STG, W) do { G2_WAIT(W); g2_store(SET, F.lds + (STG) * G2_STAGE, lt); G2_OSTORE((n_) - 1, ((n_) + 1) & 1); LDS_BARRIER(); } while (0)
#pragma unroll 1
        for (int n = 0; n < 60; n += 6) { G2_HS(n, R1, 1); G2_HS(n + 1, R2, 0); G2_HS(n + 2, R0, 1); G2_HS(n + 3, R1, 0); G2_HS(n + 4, R2, 1); G2_HS(n + 5, R0, 0); }
        G2_HT(60, R1, 1, WAITN);
        G2_HT(61, R2, 0, G2_NLD + ON);
        G2_HT(62, R0, 1, 0);
        G2_OSTORE(62, 0); LDS_BARRIER();
        G2_OSTORE(63, 1);
#undef G2_HT
#undef G2_HS
#undef G2_WAIT
#undef G2_OSTORE
    }
    __syncthreads();
}
__device__ __forceinline__ void ph_g2(Frame& F) {
    constexpr int NB = B * GH * NSP;
    if (F.bid < NB) { g2_task(F, (F.bid / (8 * NSP)) * 8 + (F.bid & 7), (F.bid >> 3) % NSP); return; }
    LAS float* scr = (LAS float*)(F.lds + F.wave * 16640);
    const int gw = (F.bid - NB) * NWAVES + F.wave, NGW = (F.G - NB) * NWAVES;
    auto dec = [&](int it) -> ConvItem { return moe_item(F, 1, it); };
    conv_run(F, dec, gw, NGW, NE * 384, scr);
}

__device__ __forceinline__ void ph_g3(Frame& F) {
    const int lane = F.lane, gwv = F.bid * NWAVES + F.wave, NGW = F.G * NWAVES;
    const bf16_t* O = (const bf16_t*)(F.ws + WS_XN); const bf16_t* P = (const bf16_t*)(F.ws + WS_PROJ); bf16_t* Y = (bf16_t*)(F.ws + WS_YMIX);
    const f32x4 gn = *(const f32x4*)(INP(I_OGAIN) + 4 * lane);
    constexpr int RB = 2;
#pragma unroll 1
    for (int t0 = gwv * RB; t0 < T; t0 += NGW * RB) {
        u32x2 ov[RB][4], rv[RB][4];
#pragma unroll
        for (int r = 0; r < RB; ++r)
#pragma unroll
            for (int j = 0; j < 4; ++j) { ov[r][j] = *(const u32x2*)(O + (size_t)(t0 + r) * D + 256 * j + 4 * lane); rv[r][j] = *(const u32x2*)(P + (size_t)(t0 + r) * P1W + 2048 + 256 * j + 4 * lane); }
#pragma unroll
        for (int r = 0; r < RB; ++r)
#pragma unroll
            for (int j = 0; j < 4; ++j) {
                f32x4 o; o[0] = __uint_as_float(ov[r][j].x << 16); o[1] = __uint_as_float(ov[r][j].x & 0xffff0000u); o[2] = __uint_as_float(ov[r][j].y << 16); o[3] = __uint_as_float(ov[r][j].y & 0xffff0000u);
                f32x4 g; g[0] = __uint_as_float(rv[r][j].x << 16); g[1] = __uint_as_float(rv[r][j].x & 0xffff0000u); g[2] = __uint_as_float(rv[r][j].y << 16); g[3] = __uint_as_float(rv[r][j].y & 0xffff0000u);
                const float rstd = rsqrtf(wave_sum((o[0] * o[0] + o[1] * o[1]) + (o[2] * o[2] + o[3] * o[3])) * (1.f / 256.f) + EPS);
                u32x2 w; w.x = pk2(o[0] * rstd * gn[0] * g[0] * fsigmoid(g[0]), o[1] * rstd * gn[1] * g[1] * fsigmoid(g[1])); w.y = pk2(o[2] * rstd * gn[2] * g[2] * fsigmoid(g[2]), o[3] * rstd * gn[3] * g[3] * fsigmoid(g[3]));
                *(u32x2*)(Y + (size_t)(t0 + r) * D + 256 * j + 4 * lane) = w;
            }
    }
}
}

template <int NV> __device__ __forceinline__ void xreduce(float (&v)[NV], int lane) {
    if constexpr (NV >= 32) { const bool up = lane & 32;
#pragma unroll
        for (int i = 0; i < 16; ++i) { const float keep = up ? v[16 + i] : v[i], send = up ? v[i] : v[16 + i]; v[i] = keep + __shfl_xor(send, 32); } }
    if constexpr (NV >= 16) { const bool up = lane & (NV >= 32 ? 16 : 32); const int o = (NV >= 32 ? 16 : 32);
#pragma unroll
        for (int i = 0; i < 8; ++i) { const float keep = up ? v[8 + i] : v[i], send = up ? v[i] : v[8 + i]; v[i] = keep + __shfl_xor(send, o); } }
    if constexpr (NV >= 8) { const int o = (NV >= 32 ? 8 : NV >= 16 ? 16 : 32); const bool up = lane & o;
#pragma unroll
        for (int i = 0; i < 4; ++i) { const float keep = up ? v[4 + i] : v[i], send = up ? v[i] : v[4 + i]; v[i] = keep + __shfl_xor(send, o); } }
    { const int o = (NV >= 32 ? 4 : NV >= 16 ? 8 : 16); const bool up = lane & o;
#pragma unroll
        for (int i = 0; i < 2; ++i) { const float keep = up ? v[2 + i] : v[i], send = up ? v[i] : v[2 + i]; v[i] = keep + __shfl_xor(send, o); } }
    { const int o = (NV >= 32 ? 2 : NV >= 16 ? 4 : 8); const bool up = lane & o;
        const float keep = up ? v[1] : v[0], send = up ? v[0] : v[1]; v[0] = keep + __shfl_xor(send, o); }
    if constexpr (NV >= 32) { v[0] += __shfl_xor(v[0], 1); }
    else if constexpr (NV >= 16) { v[0] += __shfl_xor(v[0], 2); v[0] += __shfl_xor(v[0], 1); }
    else { v[0] += __shfl_xor(v[0], 4); v[0] += __shfl_xor(v[0], 2); v[0] += __shfl_xor(v[0], 1); }
}
struct RowRegs { f32x4 x[2][4]; unsigned y[2][2][4]; float g[2][2]; };
template <int MODE> __device__ __forceinline__ void row_load(RowRegs& R, const float* xin, const bf16_t* ybuf, const float* gwp, int t0, int lane) {
#pragma unroll
    for (int r = 0; r < 2; ++r) {
#pragma unroll
        for (int j = 0; j < 4; ++j) {
            if (MODE == 0) R.x[r][j] = *(const f32x4*)(xin + (size_t)(t0 + r) * D + 4 * lane + 256 * j);
            else { const u32x2 xv = *(const u32x2*)((const bf16_t*)xin + (size_t)(t0 + r) * D + 4 * lane + 256 * j);
                R.x[r][j][0] = __uint_as_float(xv.x << 16); R.x[r][j][1] = __uint_as_float(xv.x & 0xffff0000u); R.x[r][j][2] = __uint_as_float(xv.y << 16); R.x[r][j][3] = __uint_as_float(xv.y & 0xffff0000u); } }
        if (MODE == 2 || MODE == 3) { R.g[r][0] = gwp[(t0 + r) * 2]; R.g[r][1] = gwp[(t0 + r) * 2 + 1];
#pragma unroll
            for (int k = 0; k < 2; ++k)
#pragma unroll
                for (int j = 0; j < 4; ++j) R.y[r][k][j] = *(const unsigned*)((const unsigned char*)ybuf + ((size_t)(t0 + r) * 2 + k) * D + 4 * lane + 256 * j); }
    }
}
template <int MODE> __device__ __forceinline__ void ph_rowpass(Frame& F, int layer) {
    const int lane = F.lane;
    const float* modl = (const float*)(F.ws + WS_MOD) + (size_t)layer * B * 6 * D;
    LAS float* wl = (LAS float*)F.lds;
    constexpr int RWS = 1028;
    LAS int* r_e = (LAS int*)(F.lds + 32 * RWS * 4);
    LAS int* r_rank = r_e + 256;
    LAS int* r_cnt = r_rank + 256;
    LAS int* r_base = r_cnt + 32;
    if (MODE == 0) { const float* w = INP(I_EWIN); for (int i = F.tid; i < 8 * D; i += NTHREADS) { const int col = i >> 3, hh = i & 7; wl[hh * D + col] = w[(size_t)col * EVEN_PROJ + 2560 + hh]; } }
    if (MODE == 2) { const float* w = INP(I_OWIN); for (int i = F.tid; i < 16 * D; i += NTHREADS) { const int col = i >> 4, j = i & 15; wl[j * D + col] = w[(size_t)col * ODD_PROJ + 3072 + j]; } }
    if (MODE == 1) { const float* w = INP(I_RW); for (int i = F.tid; i < 32 * D; i += NTHREADS) { const int col = i >> 5, e = i & 31; wl[e * RWS + col] = w[i]; } }
    __syncthreads();
    const float* xin = (MODE == 0) ? INP(I_X) : (const float*)(F.ws + (MODE == 2 ? WS_RESA : WS_RESB));
    bf16_t* xn = (bf16_t*)(F.ws + WS_XN);
    const bf16_t* ybuf = (const bf16_t*)(F.ws + WS_YBUF);
    const float* gwp = (const float*)(F.ws + WS_GW);
    const float* gain = (MODE == 1 ? INP(I_NFFN) : INP(I_NMIX)) + layer * D;
    const float* rbias = INP(I_RB); const float* fbias = INP(I_EFB);
#pragma unroll 1
    for (int bc = F.bid; bc < T / 128; bc += F.G) {
        const int row0 = bc * 128 + F.wave * 16, b = row0 / S;
        LAS float* abl = (LAS float*)(F.lds + 32 * RWS * 4 + 4096);
        { const int bb = (bc * 128) / S; const int sho = (MODE == 1) ? 3 * D : 0, sco = (MODE == 1) ? 4 * D : D;
          const float* mp = (MODE == 2) ? (const float*)(F.ws + WS_MOD) : modl;
          __syncthreads();
          for (int c = F.tid; c < D; c += NTHREADS) {
              if (MODE != 3) { abl[c] = gain[c] * (1.f + modl[(size_t)bb * 6 * D + sco + c]); abl[D + c] = modl[(size_t)bb * 6 * D + sho + c]; }
              if (MODE == 2 || MODE == 3) abl[2 * D + c] = mp[(size_t)bb * 6 * D + 5 * D + c]; }
          __syncthreads(); }
        if (MODE == 1) { if (F.tid < 32) r_cnt[F.tid] = 0; }
        RowRegs cur, nxt;
        row_load<MODE>(cur, xin, ybuf, gwp, row0, lane);
#pragma unroll 1
        for (int pr = 0; pr < 8; ++pr) {
            const int t0 = row0 + 2 * pr;
            if (pr + 1 < 8) row_load<MODE>(nxt, xin, ybuf, gwp, t0 + 2, lane);
            int lo4 = 4 * lane; asm volatile("" : "+v"(lo4));
            if (MODE == 2 || MODE == 3) {
#pragma unroll
                for (int r = 0; r < 2; ++r) { const float g0 = cur.g[r][0], g1 = cur.g[r][1];
#pragma unroll
                    for (int j = 0; j < 4; ++j) { typedef float f32x2_ __attribute__((ext_vector_type(2)));
                        const f32x2_ a0 = __builtin_amdgcn_cvt_pk_f32_fp8((int)cur.y[r][0][j], false), a1 = __builtin_amdgcn_cvt_pk_f32_fp8((int)cur.y[r][0][j], true);
                        const f32x2_ c0 = __builtin_amdgcn_cvt_pk_f32_fp8((int)cur.y[r][1][j], false), c1 = __builtin_amdgcn_cvt_pk_f32_fp8((int)cur.y[r][1][j], true);
                        f32x4 y; y[0] = g0 * a0[0] + g1 * c0[0]; y[1] = g0 * a0[1] + g1 * c0[1]; y[2] = g0 * a1[0] + g1 * c1[0]; y[3] = g0 * a1[1] + g1 * c1[1];
                        cur.x[r][j] = cur.x[r][j] + *(const LAS f32x4*)(abl + 2 * D + lo4 + 256 * j) * y;
                        if (MODE == 3) *(f32x4*)(F.out + (size_t)(t0 + r) * D + 4 * lane + 256 * j) = cur.x[r][j];
                        else { u32x2 w; w.x = pk2(cur.x[r][j][0], cur.x[r][j][1]); w.y = pk2(cur.x[r][j][2], cur.x[r][j][3]); *(u32x2*)((bf16_t*)(F.ws + WS_RESB) + (size_t)(t0 + r) * D + 4 * lane + 256 * j) = w; } } }
            }
            if (MODE != 3) {
                float ss0 = 0.f, ss1 = 0.f;
#pragma unroll
                for (int j = 0; j < 4; ++j) { const f32x4 a = cur.x[0][j], c = cur.x[1][j]; ss0 += (a[0] * a[0] + a[1] * a[1]) + (a[2] * a[2] + a[3] * a[3]); ss1 += (c[0] * c[0] + c[1] * c[1]) + (c[2] * c[2] + c[3] * c[3]); }
#pragma unroll
                for (int o = 1; o < 64; o <<= 1) { ss0 += __shfl_xor(ss0, o); ss1 += __shfl_xor(ss1, o); }
                const float rs[2] = {rsqrtf(ss0 * (1.f / D) + EPS), rsqrtf(ss1 * (1.f / D) + EPS)};
                f32x4 h[2][4];
#pragma unroll
                for (int r = 0; r < 2; ++r)
#pragma unroll
                    for (int j = 0; j < 4; ++j) { const f32x4 Aj = *(const LAS f32x4*)(abl + lo4 + 256 * j), Bj = *(const LAS f32x4*)(abl + D + lo4 + 256 * j);
                        h[r][j] = cur.x[r][j] * rs[r] * Aj + Bj;
                        if (MODE == 2) *(unsigned*)((unsigned char*)xn + (size_t)(t0 + r) * D + 4 * lane + 256 * j) = pk4_fp8(h[r][j][0], h[r][j][1], h[r][j][2], h[r][j][3]);
                        else { u32x2 w; w.x = pk2(h[r][j][0], h[r][j][1]); w.y = pk2(h[r][j][2], h[r][j][3]); *(u32x2*)(xn + (size_t)(t0 + r) * D + 4 * lane + 256 * j) = w; } }
                constexpr int NQ = (MODE == 0) ? 8 : (MODE == 2) ? 16 : 32;
                constexpr int WS_ = (MODE == 1) ? RWS : D;
                float a0[NQ], a1[NQ];
#pragma unroll
                for (int q = 0; q < NQ; ++q) { a0[q] = 0.f; a1[q] = 0.f;
#pragma unroll
                    for (int j = 0; j < 4; ++j) { const f32x4 w = *(const LAS f32x4*)(wl + q * WS_ + lo4 + 256 * j);
                        a0[q] += (h[0][j][0] * w[0] + h[0][j][1] * w[1]) + (h[0][j][2] * w[2] + h[0][j][3] * w[3]); a1[q] += (h[1][j][0] * w[0] + h[1][j][1] * w[1]) + (h[1][j][2] * w[2] + h[1][j][3] * w[3]); } }
                xreduce<NQ>(a0, lane); xreduce<NQ>(a1, lane);
                if (MODE == 0) { if ((lane & 7) == 0) { const int q = lane >> 3; float* lf = (float*)(F.ws + WS_LOGF); const float fb = fbias[q]; lf[(size_t)t0 * 8 + q] = logsigmoidf_(a0[0] + fb); lf[(size_t)(t0 + 1) * 8 + q] = logsigmoidf_(a1[0] + fb); } }
                if (MODE == 2) { if ((lane & 3) == 0) { float* gl = (float*)(F.ws + WS_GLOW); gl[(size_t)t0 * 16 + (lane >> 2)] = a0[0]; gl[(size_t)(t0 + 1) * 16 + (lane >> 2)] = a1[0]; } }
                if (MODE == 1) {
                    const int e = lane >> 1; const float rbe = rbias[e];
#pragma unroll
                    for (int r = 0; r < 2; ++r) {
                        const float sc = sigmoidf_(r ? a1[0] : a0[0]); const float sel = sc + rbe;
                        float m1 = sel, s1 = sc; int e1 = e;
#pragma unroll
                        for (int o = 2; o <= 8; o <<= 1) { const float ov = __shfl_xor(m1, o), os = __shfl_xor(s1, o); const int oe = __shfl_xor(e1, o); if (ov > m1 || (ov == m1 && oe < e1)) { m1 = ov; s1 = os; e1 = oe; } }
                        float m2 = (e == e1) ? -INFINITY : sel, s2 = sc; int e2 = e;
#pragma unroll
                        for (int o = 2; o <= 8; o <<= 1) { const float ov = __shfl_xor(m2, o), os = __shfl_xor(s2, o); const int oe = __shfl_xor(e2, o); if (ov > m2 || (ov == m2 && oe < e2)) { m2 = ov; s2 = os; e2 = oe; } }
                        float gs = m1 + m2; int g = e >> 3;
#pragma unroll
                        for (int o = 16; o <= 32; o <<= 1) { const float ogs = __shfl_xor(gs, o); const int og = __shfl_xor(g, o); const float os1 = __shfl_xor(s1, o), os2 = __shfl_xor(s2, o); const int oe1 = __shfl_xor(e1, o), oe2 = __shfl_xor(e2, o);
                            if (ogs > gs || (ogs == gs && og < g)) { gs = ogs; g = og; s1 = os1; s2 = os2; e1 = oe1; e2 = oe2; } }
                        if (lane == 0) { const int t = t0 + r; const float inv = 1.f / (s1 + s2);
                            ((float*)(F.ws + WS_GW))[t * 2] = s1 * inv; ((float*)(F.ws + WS_GW))[t * 2 + 1] = s2 * inv;
                            const int lr = (t - bc * 128) * 2; r_e[lr] = e1; r_e[lr + 1] = e2; }
                    }
                }
            }
            if (pr + 1 < 8) cur = nxt;
        }
        if (MODE == 1) {
            __syncthreads();
            unsigned* cnt = (unsigned*)(F.ws + WS_CTL) + CW_CNT + 32 * layer; int* list = (int*)(F.ws + WS_LIST);
            if (F.tid < 256) r_rank[F.tid] = atomicAdd((int*)&r_cnt[r_e[F.tid]], 1);
            __syncthreads();
            if (F.tid < 32) r_base[F.tid] = (int)atomicAdd(&cnt[F.tid], (unsigned)r_cnt[F.tid]);
            __syncthreads();
            if (F.tid < 256) { const int e = r_e[F.tid]; list[e * LCAP + r_base[e] + r_rank[F.tid]] = (bc * 128) * 2 + F.tid; }
            __syncthreads();
        }
    }
}


__device__ __forceinline__ void ph_router(Frame& F, int layer) {
    typedef short bf16x8 __attribute__((ext_vector_type(8)));
    const int lane = F.lane, w = F.wave, tid = F.tid;
    const float* modl = (const float*)(F.ws + WS_MOD) + (size_t)layer * B * 6 * D;
    constexpr int HP = 2064;
    LAS unsigned char* hth = F.lds;
    LAS unsigned char* htl = F.lds + 16 * HP;
    LAS float* PL = (LAS float*)(F.lds + 32 * HP);
    LAS float* abl = (LAS float*)(F.lds + 32 * HP + 16384);
    LAS int* r_e = (LAS int*)(F.lds + 32 * HP + 16384 + 8192);
    LAS int* r_rank = r_e + 256; LAS int* r_cnt = r_rank + 256; LAS int* r_base = r_cnt + 32;
    bf16x8 Bh[4][2], Bl[4][2];
    { const float* rw = INP(I_RW);
#pragma unroll
      for (int ks = 0; ks < 4; ++ks)
#pragma unroll
          for (int nt = 0; nt < 2; ++nt) { union { bf16x8 v; unsigned u[4]; } hh, ll; float hv[8], lv[8];
#pragma unroll
              for (int j = 0; j < 8; ++j) { const float v = rw[(size_t)(128 * w + 32 * ks + 8 * (lane >> 4) + j) * NE + 16 * nt + (lane & 15)]; const float hf = __uint_as_float(f2bf(v) << 16); hv[j] = hf; lv[j] = v - hf; }
#pragma unroll
              for (int q = 0; q < 4; ++q) { hh.u[q] = pk2(hv[2 * q], hv[2 * q + 1]); ll.u[q] = pk2(lv[2 * q], lv[2 * q + 1]); }
              Bh[ks][nt] = hh.v; Bl[ks][nt] = ll.v; } }
    const float* xin = (const float*)(F.ws + (layer ? WS_RESB : WS_RESA));
    bf16_t* xn = (bf16_t*)(F.ws + WS_XN);
    const float* gain = INP(I_NFFN) + layer * D; const float* rbias = INP(I_RB);
#pragma unroll 1
    for (int bc = F.bid; bc < T / 128; bc += F.G) {
        { const int bb = (bc * 128) / S;
          __syncthreads();
          for (int c = tid; c < D; c += NTHREADS) { abl[c] = gain[c] * (1.f + modl[(size_t)bb * 6 * D + 4 * D + c]); abl[D + c] = modl[(size_t)bb * 6 * D + 3 * D + c]; }
          if (tid < 32) r_cnt[tid] = 0;
          __syncthreads(); }
        RowRegs cur, nxt;
        row_load<1>(cur, xin, nullptr, nullptr, bc * 128 + 2 * w, lane);
#pragma unroll 1
        for (int g = 0; g < 8; ++g) {
            const int t0 = bc * 128 + 16 * g + 2 * w;
            row_load<1>(nxt, xin, nullptr, nullptr, g + 1 < 8 ? t0 + 16 : t0, lane);
            int lo4 = 4 * lane; asm volatile("" : "+v"(lo4));
            float ss0 = 0.f, ss1 = 0.f;
#pragma unroll
            for (int j = 0; j < 4; ++j) { const f32x4 a = cur.x[0][j], c = cur.x[1][j]; ss0 += (a[0] * a[0] + a[1] * a[1]) + (a[2] * a[2] + a[3] * a[3]); ss1 += (c[0] * c[0] + c[1] * c[1]) + (c[2] * c[2] + c[3] * c[3]); }
#pragma unroll
            for (int o = 1; o < 64; o <<= 1) { ss0 += __shfl_xor(ss0, o); ss1 += __shfl_xor(ss1, o); }
            const float rs[2] = {rsqrtf(ss0 * (1.f / D) + EPS), rsqrtf(ss1 * (1.f / D) + EPS)};
#pragma unroll
            for (int r = 0; r < 2; ++r)
#pragma unroll
                for (int j = 0; j < 4; ++j) { const f32x4 Aj = *(const LAS f32x4*)(abl + lo4 + 256 * j), Bj = *(const LAS f32x4*)(abl + D + lo4 + 256 * j);
                    const f32x4 h = cur.x[r][j] * rs[r] * Aj + Bj;
                    u32x2 wh; wh.x = pk2(h[0], h[1]); wh.y = pk2(h[2], h[3]);
                    *(unsigned*)((unsigned char*)xn + (size_t)(t0 + r) * D + 4 * lane + 256 * j) = pk4_fp8(h[0], h[1], h[2], h[3]);
                    u32x2 wl; wl.x = pk2(h[0] - __uint_as_float(wh.x << 16), h[1] - __uint_as_float(wh.x & 0xffff0000u)); wl.y = pk2(h[2] - __uint_as_float(wh.y << 16), h[3] - __uint_as_float(wh.y & 0xffff0000u));
                    *(LAS u32x2*)(hth + (2 * w + r) * HP + (lo4 + 256 * j) * 2) = wh; *(LAS u32x2*)(htl + (2 * w + r) * HP + (lo4 + 256 * j) * 2) = wl; }
            LDS_BARRIER();
            f32x4 acc[2] = {(f32x4){0.f, 0.f, 0.f, 0.f}, (f32x4){0.f, 0.f, 0.f, 0.f}};
#pragma unroll
            for (int ks = 0; ks < 4; ++ks) { const int ao = (lane & 15) * HP + (128 * w + 32 * ks + 8 * (lane >> 4)) * 2;
                const bf16x8 ah = *(const LAS bf16x8*)(hth + ao), al = *(const LAS bf16x8*)(htl + ao);
#pragma unroll
                for (int nt = 0; nt < 2; ++nt) { acc[nt] = __builtin_amdgcn_mfma_f32_16x16x32_bf16(ah, Bh[ks][nt], acc[nt], 0, 0, 0); acc[nt] = __builtin_amdgcn_mfma_f32_16x16x32_bf16(al, Bh[ks][nt], acc[nt], 0, 0, 0);
                    acc[nt] = __builtin_amdgcn_mfma_f32_16x16x32_bf16(ah, Bl[ks][nt], acc[nt], 0, 0, 0); } }
#pragma unroll
            for (int nt = 0; nt < 2; ++nt)
#pragma unroll
                for (int q = 0; q < 4; ++q) PL[(w * 16 + (lane >> 4) * 4 + q) * 32 + 16 * nt + (lane & 15)] = acc[nt][q];
            LDS_BARRIER();
            const int e = lane >> 1; const float rbe = rbias[e];
#pragma unroll
            for (int r = 0; r < 2; ++r) {
                float lg = 0.f;
#pragma unroll
                for (int ww = 0; ww < 8; ++ww) lg += PL[(ww * 16 + 2 * w + r) * 32 + e];
                const float sc = sigmoidf_(lg); const float sel = sc + rbe;
                float m1 = sel, s1 = sc; int e1 = e;
#pragma unroll
                for (int o = 2; o <= 8; o <<= 1) { const float ov = __shfl_xor(m1, o), os = __shfl_xor(s1, o); const int oe = __shfl_xor(e1, o); if (ov > m1 || (ov == m1 && oe < e1)) { m1 = ov; s1 = os; e1 = oe; } }
                float m2 = (e == e1) ? -INFINITY : sel, s2 = sc; int e2 = e;
#pragma unroll
                for (int o = 2; o <= 8; o <<= 1) { const float ov = __shfl_xor(m2, o), os = __shfl_xor(s2, o); const int oe = __shfl_xor(e2, o); if (ov > m2 || (ov == m2 && oe < e2)) { m2 = ov; s2 = os; e2 = oe; } }
                float gs = m1 + m2; int gg = e >> 3;
#pragma unroll
                for (int o = 16; o <= 32; o <<= 1) { const float ogs = __shfl_xor(gs, o); const int og = __shfl_xor(gg, o); const float os1 = __shfl_xor(s1, o), os2 = __shfl_xor(s2, o); const int oe1 = __shfl_xor(e1, o), oe2 = __shfl_xor(e2, o);
                    if (ogs > gs || (ogs == gs && og < gg)) { gs = ogs; gg = og; s1 = os1; s2 = os2; e1 = oe1; e2 = oe2; } }
                if (lane == 0) { const int t = t0 + r; const float inv = 1.f / (s1 + s2);
                    ((float*)(F.ws + WS_GW))[t * 2] = s1 * inv; ((float*)(F.ws + WS_GW))[t * 2 + 1] = s2 * inv;
                    const int lr = (t - bc * 128) * 2; r_e[lr] = e1; r_e[lr + 1] = e2; }
            }
            cur = nxt;
        }
        __syncthreads();
        unsigned* cnt = (unsigned*)(F.ws + WS_CTL) + CW_CNT + 32 * layer; int* list = (int*)(F.ws + WS_LIST);
        if (tid < 256) r_rank[tid] = atomicAdd((int*)&r_cnt[r_e[tid]], 1);
        __syncthreads();
        if (tid < 32) r_base[tid] = (int)atomicAdd(&cnt[tid], (unsigned)r_cnt[tid]);
        __syncthreads();
        if (tid < 256) { const int ee = r_e[tid]; list[ee * LCAP + r_base[ee] + r_rank[tid]] = (bc * 128) * 2 + tid; }
        __syncthreads();
    }
}

__global__ void __launch_bounds__(NTHREADS, 2) mk_fwd(Args args) {
    extern __shared__ __attribute__((aligned(16))) unsigned char lds_raw[];
    Frame F;
    F.lds = (LAS unsigned char*)lds_raw; F.tid = threadIdx.x; F.lane = F.tid & 63; F.wave = __builtin_amdgcn_readfirstlane(F.tid >> 6); F.G = gridDim.x; F.bid = blockIdx.x;
    if (F.tid == 0) {
#pragma unroll
        for (int i = 0; i < 28; ++i) *(LAS unsigned long long*)(F.lds + LDS_PTRS + 8 * i) = (unsigned long long)args.in[i];
    }
    F.out = args.out; F.ws = args.ws;
    const int lo = args.ph_lo, hi = args.ph_hi;
#define IN(k) (lo <= (k) && (k) < hi)
    volatile LAS unsigned* MISC = (volatile LAS unsigned*)(F.lds + LDS_BYTES - 256);
    if (F.tid < 64) MISC[F.tid] = 0u;
    __syncthreads();
    XcdBarrier bar = xcd_barrier_post((unsigned*)(F.ws + WS_CTL) + CW_BAR, MISC);
    unsigned long long t_mark = 0ull; float t_delta = 0.f;
    if (TIMED_PHASE == 0) t_mark = __builtin_amdgcn_s_memrealtime();
#define SEAM(k) do { if (TIMED_PHASE >= 0 && TIMED_LOCAL && (k) == TIMED_PHASE) t_delta = (float)(__builtin_amdgcn_s_memrealtime() - t_mark) * 0.01f * TIME_SCALE; if (IN(k) && IN((k) + 1)) xcd_barrier(bar); frame_refresh(F); \
        if (TIMED_PHASE >= 0) { const unsigned long long tn_ = __builtin_amdgcn_s_memrealtime(); if ((k) == TIMED_PHASE && !TIMED_LOCAL) t_delta = (float)(tn_ - t_mark) * 0.01f * TIME_SCALE; if ((k) + 1 == TIMED_PHASE) t_mark = tn_; } } while (0)
    LAS int* tpre = (LAS int*)(F.lds + pg8::STAGE_BYTES);
    if (IN(0)) REPEAT(0) ph_prologue(F);
    SEAM(0);
    if (IN(1)) REPEAT(1) ph_rowpass<0>(F, 0);
    SEAM(1);
    if (IN(2)) REPEAT(2) {
        fb_cumsum(F);
        pg8::DenseSched Sd; Sd.init(T, P0W, D, F.ws + WS_WIN0T, F.G, F.bid);
        pg8::EpiProj0 E{(bf16_t*)(F.ws + WS_PROJ), INP(I_EQG), INP(I_EKG)};
        pg8::gemm_phase<pg8::EpiProj0, pg8::DenseSched, true>(F.lds, (const char*)(F.ws + WS_XN), D, Sd, E);
        conv_tail_w13(F);
    }
    SEAM(2);
    if (IN(3)) REPEAT(3) ph_mixer0(F, lds_raw, rep_);
    SEAM(3);
    {
        if (IN(4)) _Pragma("unroll 1") for (int rep_ = 0; rep_ < REP[4]; ++rep_, __syncthreads()) {
            pg8::DenseSched Sd; Sd.init(T, D, D, F.ws + (WS_WOUT0T), F.G, F.bid);
            pg8::EpiResid E{INP(I_X), nullptr, (bf16_t*)(F.ws + WS_RESA), (const float*)(F.ws + WS_MOD) + (size_t)0 * B * 6 * D + 2 * D};
            pg8::gemm_phase<pg8::EpiResid, pg8::DenseSched, true>(F.lds, (const char*)(F.ws + WS_YMIX), D, Sd, E);
        }
        SEAM(4);
        if (IN(5)) ph_router(F, 0);
        SEAM(5);
        if (IN(6)) REPEAT(6) {
            pg8::MoeSched<true> Sm; Sm.init((const unsigned*)(F.ws + WS_CTL) + CW_CNT + 0, (const int*)(F.ws + WS_LIST), F.ws + WS_W13T + (size_t)0 * 64 * MiB, (size_t)1024 * 1024, D / 2, F.G, F.bid, tpre);
            pg8::EpiMoe1 E{F.ws + WS_HID};
            pg8::gemm_phase<pg8::EpiMoe1, pg8::MoeSched<true>, true, true, 121>(F.lds, (const char*)(F.ws + WS_XN), D / 2, Sm, E);
            conv_tail_w2(F);
        }
        SEAM(6);
        if (IN(7)) REPEAT(7) {
            pg8::MoeSched<false> Sm; Sm.init((const unsigned*)(F.ws + WS_CTL) + CW_CNT + 0, (const int*)(F.ws + WS_LIST), F.ws + WS_W2T + (size_t)0 * 32 * MiB, (size_t)1024 * 512, DE / 2, F.G, F.bid, tpre);
            pg8::EpiMoe2 E{(bf16_t*)(F.ws + WS_YBUF), (const int*)(F.ws + WS_LIST), tpre};
            pg8::gemm_phase<pg8::EpiMoe2, pg8::MoeSched<false>, true, true, 121>(F.lds, (const char*)(F.ws + WS_HID), DE / 2, Sm, E);
            conv_tail_l1(F);
        }
        SEAM(7);
    }
    {
            if (IN(8)) ph_rowpass<2>(F, 1);
            SEAM(8);
            if (IN(9)) REPEAT(9) {
                pg8::DenseSched Sd; Sd.init(T, P1W, D / 2, F.ws + WS_WIN1T, F.G, F.bid);
                pg8::EpiBf16 E{(bf16_t*)(F.ws + WS_PROJ), P1W};
                pg8::gemm_phase<pg8::EpiBf16, pg8::DenseSched, true, true, 121>(F.lds, (const char*)(F.ws + WS_XN), D / 2, Sd, E);
            }
            SEAM(9);
            if (IN(10)) REPEAT(10) gla::ph_g1(F);
            SEAM(10);
            if (IN(11)) REPEAT(11) gla::ph_g2(F);
            SEAM(11);
            if (IN(12)) REPEAT(12) gla::ph_g3(F);
            SEAM(12);
    }
    {
        if (IN(13)) _Pragma("unroll 1") for (int rep_ = 0; rep_ < 1; ++rep_, __syncthreads()) {
            pg8::DenseSched Sd; Sd.init(T, D, D, F.ws + (WS_WOUT1T), F.G, F.bid);
            pg8::EpiResid E{nullptr, (const bf16_t*)(F.ws + WS_RESB), (bf16_t*)(F.ws + WS_RESB), (const float*)(F.ws + WS_MOD) + (size_t)1 * B * 6 * D + 2 * D};
            pg8::gemm_phase<pg8::EpiResid, pg8::DenseSched, true>(F.lds, (const char*)(F.ws + WS_YMIX), D, Sd, E);
        }
        SEAM(13);
        if (IN(14)) ph_router(F, 1);
        SEAM(14);
        if (IN(15)) REPEAT(6) {
            pg8::MoeSched<true> Sm; Sm.init((const unsigned*)(F.ws + WS_CTL) + CW_CNT + 32, (const int*)(F.ws + WS_LIST), F.ws + WS_W13T + (size_t)1 * 64 * MiB, (size_t)1024 * 1024, D / 2, F.G, F.bid, tpre);
            pg8::EpiMoe1 E{F.ws + WS_HID};
            pg8::gemm_phase<pg8::EpiMoe1, pg8::MoeSched<true>, true, true, 121>(F.lds, (const char*)(F.ws + WS_XN), D / 2, Sm, E);
        }
        SEAM(15);
        if (IN(16)) REPEAT(7) {
            pg8::MoeSched<false> Sm; Sm.init((const unsigned*)(F.ws + WS_CTL) + CW_CNT + 32, (const int*)(F.ws + WS_LIST), F.ws + WS_W2T + (size_t)1 * 32 * MiB, (size_t)1024 * 512, DE / 2, F.G, F.bid, tpre);
            pg8::EpiMoe2 E{(bf16_t*)(F.ws + WS_YBUF), (const int*)(F.ws + WS_LIST), tpre};
            pg8::gemm_phase<pg8::EpiMoe2, pg8::MoeSched<false>, true, true, 121>(F.lds, (const char*)(F.ws + WS_HID), DE / 2, Sm, E);
        }
        SEAM(16);
    }
    if (IN(17)) ph_rowpass<3>(F, 1);
    if (TIMED_PHASE >= 0 && F.bid == TIMED_BLOCK && F.tid == 0) { if (TIMED_PHASE == 17) t_delta = (float)(__builtin_amdgcn_s_memrealtime() - t_mark) * 0.01f * TIME_SCALE; F.out[(size_t)TIMED_BLOCK * 128 * D] += t_delta; }
#undef SEAM
#undef IN
}

extern "C" void kernel_launch(void* const* d_in, const int* in_sizes, int n_in, void* d_out, int out_size, void* d_ws, size_t ws_size, hipStream_t stream) {
    static int grid = 0;
    if (grid == 0) {
        if (n_in != 28 || out_size != T * D || ws_size < WS_END) { fprintf(stderr, "kernel_launch: unexpected shapes (n_in %d out %d ws %zu)\n", n_in, out_size, ws_size); grid = -1; return; }
        int dev = 0, cus = 0, per_cu = 0;
        (void)hipGetDevice(&dev); (void)hipDeviceGetAttribute(&cus, hipDeviceAttributeMultiprocessorCount, dev);
        (void)hipFuncSetAttribute((const void*)mk_fwd, hipFuncAttributeMaxDynamicSharedMemorySize, LDS_BYTES);
        if (hipOccupancyMaxActiveBlocksPerMultiprocessor(&per_cu, (const void*)mk_fwd, NTHREADS, LDS_BYTES) != hipSuccess || per_cu < 1) { fprintf(stderr, "occupancy query failed (%d)\n", per_cu); per_cu = 1; }
        (void)hipGetLastError();
        grid = cus * 1;
        if (per_cu < 1) grid = -1;
    }
    if (grid < 0) return;
    const float* in[28]; for (int i = 0; i < 28; ++i) in[i] = (const float*)d_in[i];
    unsigned char* ws = (unsigned char*)d_ws; float* out = (float*)d_out;
    float* mod = (float*)(ws + WS_MOD); int* eidx = (int*)(ws + WS_EIDX); float* gw = (float*)(ws + WS_GW); float* logf = (float*)(ws + WS_LOGF); float* fb = (float*)(ws + WS_FB);
    float* glow = (float*)(ws + WS_GLOW); int* list = (int*)(ws + WS_LIST); unsigned* ctl = (unsigned*)(ws + WS_CTL);
    bf16_t* win0t = (bf16_t*)(ws + WS_WIN0T); bf16_t* wout0t = (bf16_t*)(ws + WS_WOUT0T); bf16_t* win1t = (bf16_t*)(ws + WS_WIN1T); bf16_t* wout1t = (bf16_t*)(ws + WS_WOUT1T);
    bf16_t* w13t = (bf16_t*)(ws + WS_W13T); bf16_t* w2t = (bf16_t*)(ws + WS_W2T); bf16_t* xn = (bf16_t*)(ws + WS_XN); bf16_t* ymix = (bf16_t*)(ws + WS_YMIX);
    bf16_t* proj = (bf16_t*)(ws + WS_PROJ); bf16_t* hid = (bf16_t*)(ws + WS_HID); bf16_t* ybuf = (bf16_t*)(ws + WS_YBUF); bf16_t* obuf = (bf16_t*)(ws + WS_XN);
    auto mk = [&](int lo, int hi) { Args a{}; for (int i = 0; i < 28; ++i) a.in[i] = in[i]; a.out = out; a.ws = ws; a.ph_lo = lo; a.ph_hi = hi;
        hipLaunchKernelGGL(mk_fwd, dim3(grid), dim3(NTHREADS), LDS_BYTES, stream, a); };
    (void)hipMemsetAsync(ws + WS_CTL, 0, CTL_ZERO_BYTES, stream);
    mk(0, 18);
}
```

```cpp
#include <hip/hip_runtime.h>
#include <cstdio>
#include <cstdint>
#include <type_traits>

#define LAS __attribute__((address_space(3)))
typedef unsigned short bf16_t;
typedef float f32x4 __attribute__((ext_vector_type(4)));
typedef unsigned u32x4 __attribute__((ext_vector_type(4)));
typedef unsigned u32x2 __attribute__((ext_vector_type(2)));

namespace cfg {
constexpr int D = 1024, B = 8, S = 4096, T = B * S;
constexpr int D_RNN = 512, FH = 8, EVEN_PROJ = 2568, P0W = 2560;
constexpr int GH = 4, GDK = 512, HDK = 128, HDV = 256, ODD_PROJ = 3088, P1W = 3072;
constexpr int NE = 32, DE = 512, LCAP = 32768;
constexpr float EPS = 1e-6f, LOG2E = 1.4426950408889634f, C2 = 0.125f * LOG2E;
constexpr size_t MiB = 1u << 20;
constexpr size_t WS_CTL = 0;
constexpr size_t WS_MOD = 1 * MiB;
constexpr size_t WS_EIDX = 2 * MiB;
constexpr size_t WS_GW = 2 * MiB + 512 * 1024;
constexpr size_t WS_LOGF = 3 * MiB;
constexpr size_t WS_FB = 4 * MiB;
constexpr size_t WS_GLOW = 5 * MiB;
constexpr size_t WS_DECAY = 7 * MiB;
constexpr size_t WS_LIST = 8 * MiB;
constexpr size_t WS_WIN0T = 12 * MiB;
constexpr size_t WS_WOUT0T = 17 * MiB;
constexpr size_t WS_WIN1T = 19 * MiB;
constexpr size_t WS_WOUT1T = 25 * MiB;
constexpr size_t WS_W13T = 28 * MiB;
constexpr size_t WS_W2T = 156 * MiB;
constexpr size_t WS_RESA = WS_W13T + 64 * MiB, WS_RESB = WS_W13T;
constexpr size_t WS_XN = 220 * MiB;
constexpr size_t WS_YMIX = 284 * MiB;
constexpr size_t WS_AMAT = 348 * MiB;
constexpr size_t WS_PROJ = 364 * MiB;
constexpr size_t WS_HID = 364 * MiB;
constexpr size_t WS_YBUF = 436 * MiB;
constexpr size_t WS_END = 564 * MiB;
constexpr int CW_CNT = 0;
constexpr int CW_QUEUE = 64;
constexpr int CW_BAR = 4096;
constexpr size_t CTL_ZERO_BYTES = 64 * 1024;
}
using namespace cfg;

__device__ __forceinline__ float bf2f(bf16_t v) { return __uint_as_float((unsigned)v << 16); }
__device__ __forceinline__ unsigned f2bf(float f) { unsigned u = __float_as_uint(f); return (u + 0x7fffu + ((u >> 16) & 1u)) >> 16; }
__device__ __forceinline__ unsigned pk2(float lo, float hi) { return f2bf(lo) | (f2bf(hi) << 16); }
__device__ __forceinline__ float sigmoidf_(float x) { return 1.f / (1.f + __expf(-x)); }
__device__ __forceinline__ float siluf_(float x) { return x * sigmoidf_(x); }
__device__ __forceinline__ float softplusf_(float x) { return fmaxf(x, 0.f) + log1pf(__expf(-fabsf(x))); }
__device__ __forceinline__ float logsigmoidf_(float x) { return -softplusf_(-x); }
__device__ __forceinline__ float geluf_(float x) { return 0.5f * x * (1.f + tanhf(0.7978845608028654f * (x + 0.044715f * x * x * x))); }
#define LDS_BARRIER() asm volatile("s_waitcnt lgkmcnt(0)\n\ts_barrier" ::: "memory")
__device__ __forceinline__ unsigned pk4_fp8(float a, float b, float c, float d) { int p = 0; p = __builtin_amdgcn_cvt_pk_fp8_f32(a, b, p, false); p = __builtin_amdgcn_cvt_pk_fp8_f32(c, d, p, true); return (unsigned)p; }
__device__ __forceinline__ float fsigmoid(float x) { return __builtin_amdgcn_rcpf(1.f + __builtin_amdgcn_exp2f(-LOG2E * x)); }
__device__ __forceinline__ float fgelu(float g) { const float z = 0.7978845608028654f * (g + 0.044715f * g * g * g); return g - g * __builtin_amdgcn_rcpf(1.f + __builtin_amdgcn_exp2f(2.f * LOG2E * z)); }
__device__ __forceinline__ float wave_sum(float v) {
#pragma unroll
    for (int o = 1; o < 64; o <<= 1) v += __shfl_xor(v, o);
    return v;
}


#define XB_TMO      128
#define XB_XCNT(j)  (256  + 64 * (j))
#define XB_XSUB(j)  (1280 + 64 * (j))
#define XB_XGEN(j)  (2304 + 64 * (j))
#define XB_TOP      3328
#define XB_TOPGEN   3392
#define XCD_BAR_WORDS 3456
#define XB_SPIN_CAP (1u << 18)

__device__ __forceinline__ unsigned xb_ld(unsigned* p)              { return __hip_atomic_load(p, __ATOMIC_RELAXED, __HIP_MEMORY_SCOPE_AGENT); }
__device__ __forceinline__ unsigned xb_add(unsigned* p, unsigned v) { return __hip_atomic_fetch_add(p, v, __ATOMIC_RELAXED, __HIP_MEMORY_SCOPE_AGENT); }
__device__ __forceinline__ unsigned xb_xcc_id() { return (unsigned)__builtin_amdgcn_s_getreg((3 << 11) | 20) & 0xFu; }
#define XB_SPIN(cond, bar) do { unsigned _sp = 0; while (cond) { __builtin_amdgcn_s_sleep(1); \
    if ((++_sp & 255u) == 0u) { if (xb_ld(&(bar)[XB_TMO])) break; if (_sp > XB_SPIN_CAP) { atomicAdd(&(bar)[XB_TMO], 1u); break; } } } } while (0)

struct XcdBarrier {
    unsigned* bar; unsigned x;
    volatile LAS unsigned* st;
};

__device__ __forceinline__ XcdBarrier xcd_barrier_post(unsigned* bar, volatile LAS unsigned* st) {
    XcdBarrier b; b.bar = bar; b.x = xb_xcc_id(); b.st = st;
    if (threadIdx.x == 0) (void)xb_add(&bar[XB_XCNT(b.x)], 1u);
    return b;
}
__device__ __forceinline__ void xcd_barrier_complete(unsigned* bar, unsigned x, unsigned& nloc, unsigned& nx) {
    const unsigned G = gridDim.x * gridDim.y * gridDim.z;
    unsigned sum, cnt, mine, sp = 0u;
    for (;;) {
        sum = 0u; cnt = 0u; mine = 0u;
#pragma unroll 1
        for (unsigned j = 0; j < 16; ++j) { const unsigned c = xb_ld(&bar[XB_XCNT(j)]); sum += c; cnt += (c > 0u) ? 1u : 0u; mine = (j == x) ? c : mine; }
        if (sum == G) break;
        __builtin_amdgcn_s_sleep(1);
        if ((++sp & 255u) == 0u) { if (xb_ld(&bar[XB_TMO])) break; if (sp > XB_SPIN_CAP) { atomicAdd(&bar[XB_TMO], 1u); break; } }
    }
    nloc = mine > 0u ? mine : 1u; nx = cnt > 0u ? cnt : 1u;
}

__device__ __forceinline__ void xcd_barrier(const XcdBarrier& b) {
    asm volatile("s_waitcnt vmcnt(0)" ::: "memory");
    __syncthreads();
    if (threadIdx.x == 0) {
        unsigned* bar = b.bar; asm volatile("" : "+s"(bar));
        __builtin_amdgcn_s_waitcnt(0);
        unsigned nloc = b.st[0], nx = b.st[1];
        if (nloc == 0u) { xcd_barrier_complete(bar, b.x, nloc, nx); b.st[0] = nloc; b.st[1] = nx; }
        const unsigned old = xb_add(&bar[XB_XSUB(b.x)], 1u);
        const unsigned gen = old / nloc;
        if (old + 1u == (gen + 1u) * nloc) {
            __builtin_amdgcn_fence(__ATOMIC_RELEASE, "agent");
            asm volatile("s_waitcnt vmcnt(0)" ::: "memory");
            const unsigned og = xb_add(&bar[XB_TOP], 1u);
            const unsigned tg = og / nx;
            if (og + 1u == (tg + 1u) * nx) xb_add(&bar[XB_TOPGEN], 1u);
            else XB_SPIN(xb_ld(&bar[XB_TOPGEN]) == tg, bar);
            __builtin_amdgcn_fence(__ATOMIC_ACQUIRE, "agent");
            xb_add(&bar[XB_XGEN(b.x)], 1u);
            asm volatile("s_waitcnt vmcnt(0)" ::: "memory");
        } else {
            XB_SPIN(xb_ld(&bar[XB_XGEN(b.x)]) == gen, bar);
            __builtin_amdgcn_fence(__ATOMIC_ACQUIRE, "agent");
            asm volatile("s_waitcnt vmcnt(0)" ::: "memory");
        }
    }
    __syncthreads();
}


namespace nk {
__host__ __device__ __forceinline__ int win0_row(int n) { const int lc = n & 255, wc = lc >> 6, bj = (lc >> 5) & 1, j = lc & 31; return (n & ~255) + 128 * bj + 32 * wc + j; }
}


namespace pg8 {
typedef short bf16x8 __attribute__((ext_vector_type(8)));
constexpr int BM = 256, BK = 64, HALF = 128, HTB = HALF * BK * 2, STAGE_BYTES = 8 * HTB, NXCD = 8;
__host__ __device__ __forceinline__ int lds_byte(int r, int c) { const int st = (r >> 4) * 2 + (c >> 5), rr = r & 15, cc = c & 31, ob = rr * 64 + cc * 2; return st * 1024 + (ob ^ (((ob >> 9) & 1) << 5)); }
__host__ __device__ __forceinline__ void stage_rc(int b, int& R, int& C) { const int st = b / 1024, sb = b % 1024, swz = sb ^ (((sb >> 9) & 1) << 5); R = (st >> 1) * 16 + swz / 64; C = (st & 1) * 32 + (swz % 64) / 2; }
__host__ __device__ __forceinline__ int perm32(int rho) { const int n = rho >> 4, i = rho & 15; return 8 * (i >> 2) + 4 * n + (i & 3); }
__device__ __forceinline__ unsigned cvt_pk_bf16(float lo, float hi) { unsigned r; asm volatile("v_cvt_pk_bf16_f32 %0, %1, %2" : "=v"(r) : "v"(lo), "v"(hi)); return r; }
__device__ __forceinline__ int xcd_remap(int L, int nwg) { const int q = nwg / NXCD, r = nwg % NXCD, xcd = L % NXCD, off = L / NXCD; return (xcd < r ? xcd * (q + 1) : r * (q + 1) + (xcd - r) * q) + off; }

struct Unit { int pm, pn, e, nrow; };
template <class E, class = void> struct EpiHasPre : std::false_type {};
template <class E> struct EpiHasPre<E, std::void_t<typename E::Pre>> : std::true_type {};
template <class E, bool H> struct EpiPreOf { struct type {}; };
template <class E> struct EpiPreOf<E, true> { typedef typename E::Pre type; };

template <class Epi, class Sched, bool ALIGN_EPI, bool FP8 = false, int SCALE_W = 127>
__device__ __forceinline__ void gemm_phase(LAS unsigned char* lds, const char* Abase, const int K, const Sched& S, const Epi& E) {
    int tid = threadIdx.x; asm volatile("" : "+v"(tid));
    const int wid = __builtin_amdgcn_readfirstlane(tid >> 6), lane = tid & 63, wr = wid >> 2, wc = wid & 3, fr = lane & 15, fq = lane >> 4;
    const int nt = K / BK;
    int RA[2], CA[2]; unsigned voffB[2];
#pragma unroll
    for (int i = 0; i < 2; ++i) { int R, C; stage_rc(tid * 16 + i * 8192, R, C); const int Rb = Epi::PERM ? ((R & ~31) + perm32(R & 31)) : R; RA[i] = R; CA[i] = C; voffB[i] = (unsigned)(Rb * K + C) * 2u; }
    const size_t kstep = (size_t)(BK * 2);
    const size_t hstep = (size_t)HALF * K * 2;
    const unsigned ldsw = (unsigned)wid * 1024u;
    const int aoff = lds_byte(wr * 64 + fr, FP8 ? fq * 16 : fq * 8), boff = lds_byte(wc * 32 + fr, FP8 ? fq * 16 : fq * 8);
    constexpr int KCH = FP8 ? 16 : 1024;
#define PG8_SA(b, h) (((b) * 2 + (h)) * HTB)
#define PG8_SB(b, h) ((4 + (b) * 2 + (h)) * HTB)
#define PG8_STAGE(bufoff, gbase, voff) do { _Pragma("unroll") for (int _i = 0; _i < 2; ++_i) \
        __builtin_amdgcn_global_load_lds((const unsigned*)((const char*)(gbase) + (voff)[_i]), (LAS unsigned*)(lds + (bufoff) + ldsw + _i * 8192), 16, 0, 0); } while (0)
#define PG8_LDA(dst, b, h) do { _Pragma("unroll") for (int m = 0; m < 4; ++m) _Pragma("unroll") for (int k = 0; k < 2; ++k) dst[m][k] = *(const LAS bf16x8*)(lds + PG8_SA(b, h) + aoff + m * 2048 + k * KCH); } while (0)
#define PG8_LDB(dst, b, h) do { _Pragma("unroll") for (int n = 0; n < 2; ++n) _Pragma("unroll") for (int k = 0; k < 2; ++k) dst[n][k] = *(const LAS bf16x8*)(lds + PG8_SB(b, h) + boff + n * 2048 + k * KCH); } while (0)
#define PG8_LD8(p) __builtin_shufflevector(*(const LAS v4i_*)(p), *(const LAS v4i_*)((p) + 16), 0, 1, 2, 3, 4, 5, 6, 7)
#define PG8_LDA8(dst, b, h) do { _Pragma("unroll") for (int m = 0; m < 4; ++m) dst[m] = PG8_LD8(lds + PG8_SA(b, h) + aoff + m * 2048); } while (0)
#define PG8_LDB8(dst, b, h) do { _Pragma("unroll") for (int n = 0; n < 2; ++n) dst[n] = PG8_LD8(lds + PG8_SB(b, h) + boff + n * 2048); } while (0)
#define PG8_MMA8(ai, bj, A8, B8) do { __builtin_amdgcn_s_setprio(1); _Pragma("unroll") for (int m = 0; m < 4; ++m) _Pragma("unroll") for (int n = 0; n < 2; ++n) \
        asm volatile("s_nop 1\n\tv_mfma_scale_f32_16x16x128_f8f6f4 %0, %1, %2, %0, %3, %4 op_sel_hi:[0,0,0]" : "+v"(acc[ai][bj][m][n]) : "v"(B8[n]), "v"(A8[m]), "v"(sclW), "v"(sclA)); \
        __builtin_amdgcn_s_setprio(0); } while (0)
#define PG8_MMA(ai, bj, At, Bt) do { __builtin_amdgcn_s_setprio(1); _Pragma("unroll") for (int m = 0; m < 4; ++m) _Pragma("unroll") for (int n = 0; n < 2; ++n) _Pragma("unroll") for (int k = 0; k < 2; ++k) \
        acc[ai][bj][m][n] = __builtin_amdgcn_mfma_f32_16x16x32_bf16(Bt[n][k], At[m][k], acc[ai][bj][m][n], 0, 0, 0); __builtin_amdgcn_s_setprio(0); } while (0)
#define PG8_WAIT_V(n) asm volatile("s_waitcnt vmcnt(" #n ")" ::: "memory")
#define PG8_WAIT_L(n) asm volatile("s_waitcnt lgkmcnt(" #n ")" ::: "memory")
#define PG8_BAR __builtin_amdgcn_s_barrier()
#define PG8_SCHED __builtin_amdgcn_sched_barrier(0)
    Unit cur, nxt; int ui = 0;
    if (!S.next(0, cur)) return;
    f32x4 acc[2][2][4][2];
#pragma unroll
    for (int a = 0; a < 2; ++a)
#pragma unroll
        for (int b = 0; b < 2; ++b)
#pragma unroll
            for (int m = 0; m < 4; ++m)
#pragma unroll
                for (int n = 0; n < 2; ++n) acc[a][b][m][n] = (f32x4){0.f, 0.f, 0.f, 0.f};
    typedef int v4i_ __attribute__((ext_vector_type(4))); typedef int v8i_ __attribute__((ext_vector_type(8)));
    bf16x8 At[4][2], B0[2][2], B1[2][2];
    v8i_ A8[4], B08[2], B18[2];
    int sclW = SCALE_W * 0x01010101, sclA = 0x7f7f7f7f; asm volatile("" : "+v"(sclW), "+v"(sclA));
    unsigned cvo[2][2], nvo[2][2];
    S.a_offs(cur, RA, CA, cvo);
    const char* cB = S.b_base(cur);
    PG8_STAGE(PG8_SB(0, 0), cB, voffB); PG8_STAGE(PG8_SB(0, 1), cB + hstep, voffB); PG8_STAGE(PG8_SA(0, 0), Abase, cvo[0]); PG8_STAGE(PG8_SA(0, 1), Abase, cvo[1]);
    if (wr == 1) PG8_BAR;
    PG8_WAIT_V(2); PG8_BAR;
    PG8_STAGE(PG8_SB(1, 0), cB + kstep, voffB); PG8_STAGE(PG8_SA(1, 0), Abase + kstep, cvo[0]); PG8_STAGE(PG8_SB(1, 1), cB + hstep + kstep, voffB);
    PG8_WAIT_V(6); PG8_BAR;
    constexpr bool HAS_PRE = EpiHasPre<Epi>::value;
    typename EpiPreOf<Epi, HAS_PRE>::type epre;
    for (;;) {
        if constexpr (HAS_PRE) E.pre(cur, wr, fr, epre);
        const bool has_next = S.next(ui + 1, nxt);
        if (has_next) S.a_offs(nxt, RA, CA, nvo); else { nvo[0][0] = cvo[0][0]; nvo[0][1] = cvo[0][1]; nvo[1][0] = cvo[1][0]; nvo[1][1] = cvo[1][1]; }
        const char* nB = has_next ? S.b_base(nxt) : cB;
        for (int t = 0; t < nt; t += 2) {
            const bool last = (t == nt - 2);
            const char* a1 = Abase + (size_t)(t + 1) * kstep;
            const char* a2 = last ? Abase : Abase + (size_t)(t + 2) * kstep; const char* b2 = last ? nB : cB + (size_t)(t + 2) * kstep;
            const char* a3 = a2 + kstep; const char* b3 = b2 + kstep;
            unsigned vo2[2][2];
            vo2[0][0] = last ? nvo[0][0] : cvo[0][0]; vo2[0][1] = last ? nvo[0][1] : cvo[0][1]; vo2[1][0] = last ? nvo[1][0] : cvo[1][0]; vo2[1][1] = last ? nvo[1][1] : cvo[1][1];
#define PG8_RDB(b) do { if constexpr (FP8) { PG8_LDB8(B08, b, 0); PG8_LDB8(B18, b, 1); } else { PG8_LDB(B0, b, 0); PG8_LDB(B1, b, 1); } } while (0)
#define PG8_RDA(b, h) do { if constexpr (FP8) PG8_LDA8(A8, b, h); else PG8_LDA(At, b, h); } while (0)
#define PG8_MM2(ai) do { if constexpr (FP8) { PG8_SCHED; PG8_MMA8(ai, 0, A8, B08); PG8_MMA8(ai, 1, A8, B18); PG8_SCHED; } else { PG8_MMA(ai, 0, At, B0); PG8_MMA(ai, 1, At, B1); } } while (0)
            PG8_RDB(0); PG8_SCHED; PG8_RDA(0, 0); PG8_STAGE(PG8_SA(1, 1), a1, cvo[1]);
            PG8_WAIT_V(8); PG8_WAIT_L(0); PG8_BAR; PG8_MM2(0); PG8_BAR; PG8_SCHED;
            PG8_RDA(0, 1); PG8_STAGE(PG8_SB(0, 0), b2, voffB); PG8_STAGE(PG8_SB(0, 1), b2 + hstep, voffB); PG8_STAGE(PG8_SA(0, 0), a2, vo2[0]);
            PG8_WAIT_V(8); PG8_WAIT_L(0); PG8_BAR; PG8_MM2(1); PG8_BAR; PG8_SCHED;
            PG8_RDB(1); PG8_SCHED; PG8_RDA(1, 0); PG8_STAGE(PG8_SA(0, 1), a2, vo2[1]);
            PG8_WAIT_V(8); PG8_WAIT_L(0); PG8_BAR; PG8_MM2(0); PG8_BAR; PG8_SCHED;
            PG8_RDA(1, 1); PG8_STAGE(PG8_SB(1, 0), b3, voffB); PG8_STAGE(PG8_SB(1, 1), b3 + hstep, voffB); PG8_STAGE(PG8_SA(1, 0), a3, vo2[0]);
            PG8_WAIT_V(8); PG8_WAIT_L(0); PG8_BAR; PG8_MM2(1); PG8_BAR; PG8_SCHED;
#undef PG8_RDB
#undef PG8_RDA
#undef PG8_MM2
        }
        if constexpr (ALIGN_EPI) { if (wr == 0) PG8_BAR; }
        if constexpr (FP8) asm volatile("s_nop 15\n\ts_nop 15" ::: "memory");
        if constexpr (HAS_PRE) E(acc, cur, wr, wc, fr, fq, epre); else E(acc, cur, wr, wc, fr, fq);
        if (!has_next) break;
#pragma unroll
        for (int a = 0; a < 2; ++a)
#pragma unroll
            for (int b = 0; b < 2; ++b)
#pragma unroll
                for (int m = 0; m < 4; ++m)
#pragma unroll
                    for (int n = 0; n < 2; ++n) acc[a][b][m][n] = (f32x4){0.f, 0.f, 0.f, 0.f};
        cur = nxt; cB = nB; ++ui;
        cvo[0][0] = nvo[0][0]; cvo[0][1] = nvo[0][1]; cvo[1][0] = nvo[1][0]; cvo[1][1] = nvo[1][1];
        if constexpr (ALIGN_EPI) { if (wr == 1) PG8_BAR; }
    }
    PG8_WAIT_V(0);
    if constexpr (!ALIGN_EPI) { if (wr == 0) PG8_BAR; }
    PG8_BAR;
#undef PG8_SA
#undef PG8_SB
#undef PG8_STAGE
#undef PG8_LDA
#undef PG8_LDB
#undef PG8_LD8
#undef PG8_LDA8
#undef PG8_LDB8
#undef PG8_MMA8
#undef PG8_MMA
#undef PG8_WAIT_V
#undef PG8_WAIT_L
#undef PG8_BAR
#undef PG8_SCHED
}

struct DenseSched {
    int nM, nN, nwg, G, c, K; const char* Bt;
    __device__ __forceinline__ void init(int M, int N, int K_, const void* Bt_, int G_, int c_) { nM = M / BM; nN = N / BM; nwg = nM * nN; G = G_; c = c_; K = K_; Bt = (const char*)Bt_; }
    __device__ __forceinline__ bool next(int i, Unit& u) const {
        const long L = (long)i * G + c; if (L >= nwg) return false;
        const int wgid = xcd_remap((int)L, nwg);
        const int nig = 8 * nN, gid = wgid / nig, fm = gid * 8, gsz = (nM - fm) < 8 ? (nM - fm) : 8;
        u.pm = fm + ((wgid % nig) % gsz); u.pn = (wgid % nig) / gsz; u.e = 0; u.nrow = 256; return true;
    }
    __device__ __forceinline__ void a_offs(const Unit& u, const int (&RA)[2], const int (&CA)[2], unsigned (&vo)[2][2]) const {
#pragma unroll
        for (int h = 0; h < 2; ++h)
#pragma unroll
            for (int i = 0; i < 2; ++i) vo[h][i] = (unsigned)((u.pm * BM + h * HALF + RA[i]) * K + CA[i]) * 2u;
    }
    __device__ __forceinline__ const char* b_base(const Unit& u) const { return Bt + (size_t)u.pn * BM * K * 2; }
};
template <bool GATHER> struct MoeSched {
    const unsigned* cnt; const int* list; const char* Bt; size_t bstride; int K, G, c, ntile, nwg;
    LAS const int* tpre;
    __device__ __forceinline__ void init(const unsigned* cnt_, const int* list_, const void* Bt_, size_t bstride_, int K_, int G_, int c_, LAS int* tp) {
        cnt = cnt_; list = list_; Bt = (const char*)Bt_; bstride = bstride_; K = K_; G = G_; c = c_; tpre = tp;
        if (threadIdx.x == 0) { int p = 0; for (int e = 0; e < NE; ++e) { tp[e] = p; p += ((int)cnt_[e] + 255) >> 8; } tp[NE] = p; }
        __syncthreads();
        ntile = tp[NE]; nwg = ntile * 4;
    }
    __device__ __forceinline__ bool next(int i, Unit& u) const {
        const long L = (long)i * G + c; if (L >= nwg) return false;
        const int wgid = xcd_remap((int)L, nwg);
        u.pm = wgid >> 2; u.pn = wgid & 3;
        int e = 0;
#pragma unroll 1
        for (int j = 1; j < NE; ++j) if (tpre[j] <= u.pm) e = j;
        u.e = e; const int rt = u.pm - tpre[e]; const int left = (int)cnt[e] - rt * 256; u.nrow = left < 256 ? left : 256; return true;
    }
    __device__ __forceinline__ void a_offs(const Unit& u, const int (&RA)[2], const int (&CA)[2], unsigned (&vo)[2][2]) const {
        const int rt = u.pm - tpre[u.e];
#pragma unroll
        for (int h = 0; h < 2; ++h)
#pragma unroll
            for (int i = 0; i < 2; ++i) {
                const int r = h * HALF + RA[i];
                if (GATHER) { const int rr = r < u.nrow ? r : 0; const int ent = list[u.e * LCAP + rt * 256 + rr]; vo[h][i] = (unsigned)((ent >> 1) * K + CA[i]) * 2u; }
                else vo[h][i] = (unsigned)((u.pm * BM + r) * K + CA[i]) * 2u;
            }
    }
    __device__ __forceinline__ const char* b_base(const Unit& u) const { return Bt + (size_t)u.e * bstride + (size_t)u.pn * BM * K * 2; }
};

struct EpiProj0 {
    static constexpr bool PERM = true;
    bf16_t* O; const float* qg; const float* kg;
    __device__ __forceinline__ void operator()(const f32x4 (&acc)[2][2][4][2], const Unit& u, int wr, int wc, int fr, int fq) const {
        const int seg = u.pn >> 1;
        float gsc[2][2][4];
        const bool nrm = (seg == 2 || seg == 3);
        if (nrm) { const float* gp = (seg == 2) ? qg : kg; const float s = (seg == 2) ? C2 : 1.f;
#pragma unroll
            for (int bj = 0; bj < 2; ++bj)
#pragma unroll
                for (int n = 0; n < 2; ++n) { const f32x4 gv = *(const f32x4*)(gp + 32 * bj + 8 * fq + 4 * n); gsc[bj][n][0] = gv[0] * s; gsc[bj][n][1] = gv[1] * s; gsc[bj][n][2] = gv[2] * s; gsc[bj][n][3] = gv[3] * s; } }
        const int col0 = u.pn * BM + 64 * wc + 8 * fq;
#pragma unroll
        for (int ai = 0; ai < 2; ++ai)
#pragma unroll
            for (int m = 0; m < 4; ++m) {
                bf16_t* rowp = O + (size_t)(u.pm * BM + ai * HALF + wr * 64 + m * 16 + fr) * P0W + col0;
                float rs = 1.f;
                if (nrm) { float ss = 0.f;
#pragma unroll
                    for (int bj = 0; bj < 2; ++bj)
#pragma unroll
                        for (int n = 0; n < 2; ++n) { const f32x4 v = acc[ai][bj][m][n]; ss += (v[0] * v[0] + v[1] * v[1]) + (v[2] * v[2] + v[3] * v[3]); }
                    ss += __shfl_xor(ss, 16); ss += __shfl_xor(ss, 32); rs = rsqrtf(ss * (1.f / 64.f) + EPS); }
#pragma unroll
                for (int bj = 0; bj < 2; ++bj) { f32x4 v0 = acc[ai][bj][m][0], v1 = acc[ai][bj][m][1];
                    if (nrm) {
#pragma unroll
                        for (int q = 0; q < 4; ++q) { v0[q] = v0[q] * rs * gsc[bj][0][q]; v1[q] = v1[q] * rs * gsc[bj][1][q]; } }
                    u32x4 w; w.x = cvt_pk_bf16(v0[0], v0[1]); w.y = cvt_pk_bf16(v0[2], v0[3]); w.z = cvt_pk_bf16(v1[0], v1[1]); w.w = cvt_pk_bf16(v1[2], v1[3]);
                    *(u32x4*)(rowp + 32 * bj) = w; }
            }
    }
};
struct EpiBf16 {
    static constexpr bool PERM = true;
    bf16_t* O; int ldc;
    __device__ __forceinline__ void operator()(const f32x4 (&acc)[2][2][4][2], const Unit& u, int wr, int wc, int fr, int fq) const {
        const int col0 = u.pn * BM + wc * 32 + 8 * fq;
#pragma unroll
        for (int ai = 0; ai < 2; ++ai)
#pragma unroll
            for (int m = 0; m < 4; ++m) { bf16_t* rowp = O + (size_t)(u.pm * BM + ai * HALF + wr * 64 + m * 16 + fr) * ldc + col0;
#pragma unroll
                for (int bj = 0; bj < 2; ++bj) { const f32x4 v0 = acc[ai][bj][m][0], v1 = acc[ai][bj][m][1];
                    u32x4 w; w.x = cvt_pk_bf16(v0[0], v0[1]); w.y = cvt_pk_bf16(v0[2], v0[3]); w.z = cvt_pk_bf16(v1[0], v1[1]); w.w = cvt_pk_bf16(v1[2], v1[3]);
                    *(u32x4*)(rowp + bj * HALF) = w; } }
    }
};
struct EpiResid {
    static constexpr bool PERM = true;
    const float* XF; const bf16_t* XB; bf16_t* O; const float* g;
    __device__ __forceinline__ void operator()(const f32x4 (&acc)[2][2][4][2], const Unit& u, int wr, int wc, int fr, int fq) const {
        const int col0 = u.pn * BM + wc * 32 + 8 * fq; const int b = (u.pm * BM) / S;
        f32x4 gv[2][2];
#pragma unroll
        for (int bj = 0; bj < 2; ++bj)
#pragma unroll
            for (int n = 0; n < 2; ++n) gv[bj][n] = *(const f32x4*)(g + (size_t)b * 6 * D + col0 + bj * HALF + n * 4);
#pragma unroll
        for (int ai = 0; ai < 2; ++ai)
#pragma unroll
            for (int m = 0; m < 4; ++m) { const size_t off = (size_t)(u.pm * BM + ai * HALF + wr * 64 + m * 16 + fr) * D + col0;
#pragma unroll
                for (int bj = 0; bj < 2; ++bj) { f32x4 x0, x1;
                    if (XF) { x0 = *(const f32x4*)(XF + off + bj * HALF); x1 = *(const f32x4*)(XF + off + bj * HALF + 4); }
                    else { const u32x4 xv = *(const u32x4*)(XB + off + bj * HALF);
                        x0[0] = __uint_as_float(xv.x << 16); x0[1] = __uint_as_float(xv.x & 0xffff0000u); x0[2] = __uint_as_float(xv.y << 16); x0[3] = __uint_as_float(xv.y & 0xffff0000u);
                        x1[0] = __uint_as_float(xv.z << 16); x1[1] = __uint_as_float(xv.z & 0xffff0000u); x1[2] = __uint_as_float(xv.w << 16); x1[3] = __uint_as_float(xv.w & 0xffff0000u); }
                    const f32x4 v0 = x0 + gv[bj][0] * acc[ai][bj][m][0], v1 = x1 + gv[bj][1] * acc[ai][bj][m][1];
                    u32x4 w; w.x = cvt_pk_bf16(v0[0], v0[1]); w.y = cvt_pk_bf16(v0[2], v0[3]); w.z = cvt_pk_bf16(v1[0], v1[1]); w.w = cvt_pk_bf16(v1[2], v1[3]);
                    *(u32x4*)(O + off + bj * HALF) = w; } }
    }
};
struct EpiMoe1 {
    static constexpr bool PERM = true;
    unsigned char* H;
    __device__ __forceinline__ void operator()(const f32x4 (&acc)[2][2][4][2], const Unit& u, int wr, int wc, int fr, int fq) const {
        const int col0 = u.pn * 128 + wc * 32 + 8 * fq;
#pragma unroll
        for (int ai = 0; ai < 2; ++ai)
#pragma unroll
            for (int m = 0; m < 4; ++m) { unsigned char* rowp = H + (size_t)(u.pm * BM + ai * HALF + wr * 64 + m * 16 + fr) * DE + col0;
                float h[8];
#pragma unroll
                for (int n = 0; n < 2; ++n)
#pragma unroll
                    for (int q = 0; q < 4; ++q) { const float a = acc[ai][0][m][n][q], b3 = acc[ai][1][m][n][q]; h[n * 4 + q] = a * b3 * __builtin_amdgcn_rcpf(1.f + __builtin_amdgcn_exp2f(-LOG2E * a)); }
                u32x2 w; w.x = pk4_fp8(h[0], h[1], h[2], h[3]); w.y = pk4_fp8(h[4], h[5], h[6], h[7]);
                *(u32x2*)rowp = w; }
    }
};
struct EpiMoe2 {
    static constexpr bool PERM = true;
    bf16_t* Y; const int* list; LAS const int* tpre;
    struct Pre { int ent[8]; };
    __device__ __forceinline__ void pre(const Unit& u, int wr, int fr, Pre& P) const {
        const int rt = u.pm - tpre[u.e];
#pragma unroll
        for (int i = 0; i < 8; ++i) { const int r = (i >> 2) * HALF + wr * 64 + (i & 3) * 16 + fr; P.ent[i] = list[u.e * LCAP + rt * 256 + (r < u.nrow ? r : 0)]; }
    }
    __device__ __forceinline__ void operator()(const f32x4 (&acc)[2][2][4][2], const Unit& u, int wr, int wc, int fr, int fq, const Pre& P) const {
        const int col0 = u.pn * BM + wc * 32 + 8 * fq;
#pragma unroll
        for (int ai = 0; ai < 2; ++ai)
#pragma unroll
            for (int m = 0; m < 4; ++m) { const int r = ai * HALF + wr * 64 + m * 16 + fr;
                if (r < u.nrow) { unsigned char* rowp = (unsigned char*)Y + (size_t)P.ent[ai * 4 + m] * D + col0;
#pragma unroll
                    for (int bj = 0; bj < 2; ++bj) { const f32x4 v0 = acc[ai][bj][m][0], v1 = acc[ai][bj][m][1];
                        u32x2 w; w.x = pk4_fp8(v0[0], v0[1], v0[2], v0[3]); w.y = pk4_fp8(v1[0], v1[1], v1[2], v1[3]);
                        *(u32x2*)(rowp + bj * HALF) = w; } } }
    }
};
}

constexpr int NWAVES = 8, NTHREADS = 512, LDS_BYTES = 163840;
constexpr int REP[18] = {1, 1, 1, 1, 1, 1, 1, 1, 1, 1, 1, 1, 1, 1, 1, 1, 1, 1};
constexpr int TIMED_PHASE = -1; constexpr float TIME_SCALE = 0.1f; constexpr bool TIMED_LOCAL = false; constexpr int TIMED_BLOCK = 0;
#define REPEAT(k) _Pragma("unroll 1") for (int rep_ = 0; rep_ < REP[k]; ++rep_, __syncthreads())
struct Args { const float* in[28]; float* out; unsigned char* ws; int ph_lo, ph_hi; };
struct Frame {
    LAS unsigned char* lds; int tid, lane, wave, G, bid;
    float* out; unsigned char* ws;
};
constexpr int LDS_PTRS = LDS_BYTES - 512;
__device__ __forceinline__ const float* in_ptr(const Frame& F, int i) {
    const unsigned long long v = *(const volatile LAS unsigned long long*)(F.lds + LDS_PTRS + 8 * i);
    const unsigned lo = __builtin_amdgcn_readfirstlane((unsigned)v), hi = __builtin_amdgcn_readfirstlane((unsigned)(v >> 32));
    return (const float*)(const __attribute__((address_space(1))) float*)(((unsigned long long)hi << 32) | lo);
}
#define INP(i) in_ptr(F, (i))
__device__ __forceinline__ void frame_refresh(Frame& F) {
    int t = threadIdx.x; asm volatile("" : "+v"(t)); F.tid = t; F.lane = t & 63; F.wave = __builtin_amdgcn_readfirstlane(t >> 6);
}
enum { I_X = 0, I_C, I_RW, I_RB, I_ADAW, I_ADAB, I_NMIX, I_NFFN, I_EWIN, I_ECW, I_ECB, I_ERW, I_ERB, I_EIW, I_EIB, I_ELAM, I_EFB, I_EQG, I_EKG, I_EWOUT,
       I_OWIN, I_OGW2, I_OGB, I_OGAIN, I_OWOUT, I_W1, I_W3, I_W2 };

struct TileRegs { f32x4 v[16]; };
__device__ __forceinline__ void tile_load(TileRegs& R, const float* W, int ldw, int k0, int n0, int lane) {
    const int r4 = lane >> 4, c4 = lane & 15;
#pragma unroll
    for (int i = 0; i < 16; ++i) R.v[i] = __builtin_nontemporal_load((const f32x4*)(W + (size_t)(k0 + r4 + 4 * i) * ldw + n0 + 4 * c4));
}
template <bool SPLIT> __device__ __forceinline__ void transpose_fin(const TileRegs& R, int k0, bf16_t* WT, int ldt, int drow0, LAS float* scr, int lane) {
    const int r4 = lane >> 4, c4 = lane & 15;
    const f32x4 (&v)[16] = R.v;
#pragma unroll
    for (int i = 0; i < 16; ++i) { LAS float* p = scr + (r4 + 4 * i) * 65 + 4 * c4; p[0] = v[i][0]; p[1] = v[i][1]; p[2] = v[i][2]; p[3] = v[i][3]; }
    asm volatile("s_waitcnt lgkmcnt(0)" ::: "memory");
    const int c = lane & 7;
#pragma unroll
    for (int j = 0; j < 8; ++j) { const int n = (lane >> 3) + 8 * j; const LAS float* s = scr + (8 * c) * 65 + n;
        u32x4 o; o.x = pk2(s[0 * 65], s[1 * 65]); o.y = pk2(s[2 * 65], s[3 * 65]); o.z = pk2(s[4 * 65], s[5 * 65]); o.w = pk2(s[6 * 65], s[7 * 65]);
        const int drow = drow0 + (SPLIT ? (n & 31) + 128 * (n >> 5) : n);
        *(u32x4*)(WT + (size_t)drow * ldt + k0 + 8 * c) = o; }
    asm volatile("s_waitcnt lgkmcnt(0)" ::: "memory");
}
template <bool SPLIT> __device__ __forceinline__ void transpose_fin8(const TileRegs& R, int k0, unsigned char* WT, int ldt, int drow0, LAS float* scr, int lane) {
    const int r4 = lane >> 4, c4 = lane & 15;
    const f32x4 (&v)[16] = R.v;
#pragma unroll
    for (int i = 0; i < 16; ++i) { LAS float* p = scr + (r4 + 4 * i) * 65 + 4 * c4; p[0] = v[i][0]; p[1] = v[i][1]; p[2] = v[i][2]; p[3] = v[i][3]; }
    asm volatile("s_waitcnt lgkmcnt(0)" ::: "memory");
    const int c = lane & 3;
#pragma unroll
    for (int j = 0; j < 4; ++j) { const int n = (lane >> 2) + 16 * j; const LAS float* s = scr + (16 * c) * 65 + n;
        u32x4 o;
        o.x = pk4_fp8(64.f * s[0 * 65], 64.f * s[1 * 65], 64.f * s[2 * 65], 64.f * s[3 * 65]); o.y = pk4_fp8(64.f * s[4 * 65], 64.f * s[5 * 65], 64.f * s[6 * 65], 64.f * s[7 * 65]);
        o.z = pk4_fp8(64.f * s[8 * 65], 64.f * s[9 * 65], 64.f * s[10 * 65], 64.f * s[11 * 65]); o.w = pk4_fp8(64.f * s[12 * 65], 64.f * s[13 * 65], 64.f * s[14 * 65], 64.f * s[15 * 65]);
        *(u32x4*)(WT + (size_t)(drow0 + (SPLIT ? (n & 31) + 128 * (n >> 5) : n)) * ldt + k0 + 16 * c) = o; }
    asm volatile("s_waitcnt lgkmcnt(0)" ::: "memory");
}
struct ConvItem { const float* W; unsigned char* WT; int ldw, k0, n0, ldt, drow0, kind; };
__device__ __forceinline__ ConvItem moe_item(Frame& F, int l, int it) {
    const int e = it / 384, r = it % 384, which = r >> 7, q = r & 127, le = l * NE + e; ConvItem c;
    if (which < 2) { const int kb = q >> 3, nb = q & 7, n0 = nb * 64;
        c.W = (which ? INP(I_W3) : INP(I_W1)) + (size_t)le * D * DE; c.ldw = DE; c.k0 = kb * 64; c.n0 = n0; c.WT = F.ws + WS_W13T + (size_t)l * 64 * MiB + (size_t)e * 1024 * 1024; c.ldt = D; c.drow0 = 256 * (n0 >> 7) + (n0 & 127) + 128 * which; }
    else { const int kb = q >> 4, nb = q & 15;
        c.W = INP(I_W2) + (size_t)le * DE * D; c.ldw = D; c.k0 = kb * 64; c.n0 = nb * 64; c.WT = F.ws + WS_W2T + (size_t)l * 32 * MiB + (size_t)e * 1024 * 512; c.ldt = DE; c.drow0 = nb * 64; }
    c.kind = 2; return c;
}
__device__ __forceinline__ void conv_finish(const ConvItem& c, const TileRegs& R, LAS float* scr, int lane) {
    if (c.kind == 2) transpose_fin8<false>(R, c.k0, c.WT, c.ldt, c.drow0, scr, lane);
    else if (c.kind == 3) transpose_fin8<true>(R, c.k0, c.WT, c.ldt, c.drow0, scr, lane);
    else if (c.kind == 1) transpose_fin<true>(R, c.k0, (bf16_t*)c.WT, c.ldt, c.drow0, scr, lane);
    else transpose_fin<false>(R, c.k0, (bf16_t*)c.WT, c.ldt, c.drow0, scr, lane);
}
template <class Dec> __device__ __forceinline__ void conv_run(Frame& F, const Dec& dec, int first, int stride, int n, LAS float* scr) {
    if (first >= n) return;
    TileRegs R; ConvItem cur = dec(first); tile_load(R, cur.W, cur.ldw, cur.k0, cur.n0, F.lane);
#pragma unroll 1
    for (int it = first; it < n; it += stride) {
        const int nx = it + stride < n ? it + stride : it;
        const ConvItem nxt = dec(nx);
        TileRegs Rn; tile_load(Rn, nxt.W, nxt.ldw, nxt.k0, nxt.n0, F.lane);
        conv_finish(cur, R, scr, F.lane);
        cur = nxt; R = Rn;
    }
}
constexpr int ND13 = 12 * 256;
__device__ __forceinline__ ConvItem moe_item13(Frame& F, int l, int j) { return moe_item(F, l, (j >> 8) * 384 + (j & 255)); }
__device__ __forceinline__ ConvItem moe_item2(Frame& F, int l, int j) { return moe_item(F, l, (j >> 7) * 384 + 256 + (j & 127)); }
template <class Dec> __device__ __forceinline__ void conv_tail(Frame& F, const Dec& dec, int qi, int n) {
    LAS volatile int* dflag = (LAS volatile int*)(F.lds + 160 * 1024 - 64);
    if (F.tid == 0) dflag[0] = 0;
    __syncthreads();
    LAS float* scr = (LAS float*)(F.lds + F.wave * 16640);
    const int sh = F.bid & 7, ns = (n - sh + 7) >> 3;
    unsigned* qhead = (unsigned*)(F.ws + WS_CTL) + CW_QUEUE + 64 * (8 * qi + sh);
    auto fetch = [&]() -> int {
        int v = ns;
        if (dflag[0] == 0) { if (F.lane == 0) v = (int)atomicAdd(qhead, 1u); v = __builtin_amdgcn_readfirstlane(v); if (v >= ns && F.lane == 0) dflag[0] = 1; }
        return v; };
    int it = fetch(); if (it >= ns) return;
    ConvItem cur = dec(sh + 8 * it); TileRegs R; tile_load(R, cur.W, cur.ldw, cur.k0, cur.n0, F.lane);
#pragma unroll 1
    for (;;) {
        const int nx = fetch(); const bool more = nx < ns;
        const ConvItem nxt = dec(sh + 8 * (more ? nx : it));
        TileRegs Rn; tile_load(Rn, nxt.W, nxt.ldw, nxt.k0, nxt.n0, F.lane);
        conv_finish(cur, R, scr, F.lane);
        if (!more) break;
        cur = nxt; R = Rn; it = nx;
    }
}
__device__ __forceinline__ void ph_prologue(Frame& F) {
    if (F.bid < 192) {
        LAS float* sc = (LAS float*)F.lds;
        LAS float* red = (LAS float*)(F.lds + 32768);
        { const float* cc = INP(I_C); for (int i = F.tid; i < B * D; i += NTHREADS) sc[(i & (D - 1)) * 8 + (i >> 10)] = siluf_(cc[i]); }
        __syncthreads();
        const int l = F.bid / 96, cb = F.bid % 96, kr = F.lane >> 4, c4 = F.lane & 15;
        const float* w = INP(I_ADAW) + (size_t)l * D * 6 * D + cb * 64 + 4 * c4;
        f32x4 acc[8];
#pragma unroll
        for (int b = 0; b < 8; ++b) acc[b] = (f32x4){0.f, 0.f, 0.f, 0.f};
#pragma unroll 1
        for (int k0 = F.wave * 128; k0 < F.wave * 128 + 128; k0 += 32) {
            f32x4 wv[8];
#pragma unroll
            for (int i = 0; i < 8; ++i) wv[i] = *(const f32x4*)(w + (size_t)(k0 + 4 * i + kr) * 6 * D);
#pragma unroll
            for (int i = 0; i < 8; ++i) { const f32x4 s0 = *(const LAS f32x4*)(sc + (k0 + 4 * i + kr) * 8), s1 = *(const LAS f32x4*)(sc + (k0 + 4 * i + kr) * 8 + 4);
                acc[0] += wv[i] * s0[0]; acc[1] += wv[i] * s0[1]; acc[2] += wv[i] * s0[2]; acc[3] += wv[i] * s0[3]; acc[4] += wv[i] * s1[0]; acc[5] += wv[i] * s1[1]; acc[6] += wv[i] * s1[2]; acc[7] += wv[i] * s1[3]; }
        }
#pragma unroll
        for (int b = 0; b < 8; ++b) {
#pragma unroll
            for (int q = 0; q < 4; ++q) { float v = acc[b][q]; v += __shfl_xor(v, 16); v += __shfl_xor(v, 32); acc[b][q] = v; }
            if (kr == 0) *(LAS f32x4*)(red + (F.wave * 8 + b) * 64 + 4 * c4) = acc[b]; }
        __syncthreads();
        { const int b = F.tid >> 6, c = F.tid & 63; float s = INP(I_ADAB)[l * 6 * D + cb * 64 + c];
          for (int wv = 0; wv < 8; ++wv) s += red[(wv * 8 + b) * 64 + c];
          ((float*)(F.ws + WS_MOD))[((size_t)l * B + b) * 6 * D + cb * 64 + c] = s; }
        __syncthreads();
    }
    constexpr int I0 = 16 * 40, I1 = 16 * 16, IMP = NE * 256 - ND13;
    auto dec = [&](int it) -> ConvItem {
        int r = it; ConvItem c;
        if (r < IMP) return moe_item13(F, 0, ND13 + r);
        r -= IMP; c.kind = 0;
        if (r < I0) { const int kb = r / 40, nb = r % 40, n0 = nb * 64; c.W = INP(I_EWIN); c.ldw = EVEN_PROJ; c.k0 = kb * 64; c.n0 = n0; c.WT = F.ws + WS_WIN0T; c.ldt = D; c.drow0 = nk::win0_row(n0); c.kind = 1; return c; } r -= I0;
        { const int kb = r / 16, nb = r % 16; c.W = INP(I_EWOUT); c.ldw = D; c.k0 = kb * 64; c.n0 = nb * 64; c.WT = F.ws + WS_WOUT0T; c.ldt = D; c.drow0 = nb * 64; return c; }
    };
    conv_tail(F, dec, 4, IMP + I0 + I1);
}
__device__ __forceinline__ void conv_tail_w13(Frame& F) { auto dec = [&](int it) -> ConvItem { return moe_item13(F, 0, it); }; conv_tail(F, dec, 1, ND13); }
__device__ __forceinline__ void conv_tail_w2(Frame& F) { auto dec = [&](int it) -> ConvItem { return moe_item2(F, 0, it); }; conv_tail(F, dec, 2, NE * 128); }
__device__ __forceinline__ void conv_tail_l1(Frame& F) {
    constexpr int I2 = 16 * 48, I3 = 16 * 16;
    auto dec = [&](int it) -> ConvItem {
        int r = it; ConvItem c; c.kind = 0;
        if (r < I2) { const int kb = r / 48, nb = r % 48; c.W = INP(I_OWIN); c.ldw = ODD_PROJ; c.k0 = kb * 64; c.n0 = nb * 64; c.WT = F.ws + WS_WIN1T; c.ldt = D; c.drow0 = nb * 64; c.kind = 2; return c; } r -= I2;
        { const int kb = r / 16, nb = r % 16; c.W = INP(I_OWOUT); c.ldw = D; c.k0 = kb * 64; c.n0 = nb * 64; c.WT = F.ws + WS_WOUT1T; c.ldt = D; c.drow0 = nb * 64; return c; }
    };
    conv_tail(F, dec, 3, I2 + I3);
}

namespace attn_body {
using bf16=unsigned short;
using bf16x8=__attribute__((ext_vector_type(8)))short;
using f32x4v=__attribute__((ext_vector_type(4)))float;
using s16x4=__attribute__((ext_vector_type(4)))short;
using f32x16=__attribute__((ext_vector_type(16)))float;
using u32x4=__attribute__((ext_vector_type(4)))unsigned;
constexpr int BATCH=8,NHEAD=8,SEQ=4096,D=64,DM=2560,DMO=1024;
constexpr int NW=8,QBLK=32,QB=QBLK*NW,KVBLK=64,NQB=SEQ/QB;
constexpr int ATTN_PITCH=DM, ATTN_UNIT_ROWS=QB;
__device__ __forceinline__ int crow(int r,int hi){return (r&3)+8*(r>>2)+4*hi;}
#define SBAR() __builtin_amdgcn_sched_barrier(0)
__device__ __forceinline__ void cmask(f32x16&p0,f32x16&p1,int jb,int qrel,int hi){
  const float NEG=-INFINITY; int kb=64*jb+4*hi;
  #pragma unroll
  for(int r=0;r<16;++r){int kv=kb+(r&3)+8*(r>>2); if(kv>qrel)p0[r]=NEG; if(kv+32>qrel)p1[r]=NEG;}
}

constexpr int NSLOT=3, SLOTB=8192;
constexpr int LDS_K=0, LDS_V=NSLOT*SLOTB, LDS_WS=2*NSLOT*SLOTB, LDS_OST=LDS_WS+NW*64*4, LDS_FB=LDS_OST+NW*4096, LDS_BYTES=LDS_FB+SEQ*4;
constexpr float C2=0.125f*1.4426950408889634f;
__device__ __forceinline__ void glds16(const void*gsrc,unsigned lds_dst){unsigned keep;
  asm volatile("s_mov_b32 %0, m0\n\ts_mov_b32 m0, %2\n\ts_nop 0\n\tglobal_load_lds_dwordx4 %1, off\n\ts_mov_b32 m0, %0":"=&s"(keep):"v"(gsrc),"s"(lds_dst):"memory");}
__device__ __forceinline__ float max3f(float a,float b,float c){float r;asm("v_max3_f32 %0, %1, %2, %3":"=v"(r):"v"(a),"v"(b),"v"(c));return r;}
__device__ __forceinline__ float max2f(float a,float b){float r;asm("v_max_f32_e32 %0, %1, %2":"=v"(r):"v"(a),"v"(b));return r;}
__device__ __forceinline__ float fadd_s(float a,float b){float r;asm("v_add_f32_e32 %0, %1, %2":"=v"(r):"v"(a),"v"(b));return r;}
__device__ __forceinline__ float fsub_s(float a,float b){float r;asm("v_sub_f32_e32 %0, %1, %2":"=v"(r):"v"(a),"v"(b));return r;}
typedef float f32x2_t __attribute__((ext_vector_type(2))); typedef __bf16 bf16x2_t __attribute__((ext_vector_type(2)));
__device__ __forceinline__ unsigned cvtpk_s(float lo,float hi){f32x2_t v={lo,hi};bf16x2_t b=__builtin_convertvector(v,bf16x2_t);return __builtin_bit_cast(unsigned,b);}
#define WAIT_BAR(N) asm volatile("s_waitcnt vmcnt(" #N ") lgkmcnt(0)\n\ts_barrier":::"memory")

__device__ __forceinline__ void qkt(f32x16&p0,f32x16&p1,const char*Kslot,const bf16x8*qr,const f32x16&negm,int r32,int hi){
  const char*kb=Kslot+hi*1024+r32*16;
  #pragma unroll
  for(int d0=0;d0<4;++d0){
    const bf16x8 b0=*reinterpret_cast<const bf16x8*>(kb+d0*2048);
    const bf16x8 b1=*reinterpret_cast<const bf16x8*>(kb+d0*2048+512);
    if(d0==0){p0=__builtin_amdgcn_mfma_f32_32x32x16_bf16(b0,qr[0],negm,0,0,0);p1=__builtin_amdgcn_mfma_f32_32x32x16_bf16(b1,qr[0],negm,0,0,0);}
    else{p0=__builtin_amdgcn_mfma_f32_32x32x16_bf16(b0,qr[d0],p0,0,0,0);p1=__builtin_amdgcn_mfma_f32_32x32x16_bf16(b1,qr[d0],p1,0,0,0);}}
}
typedef __attribute__((address_space(3))) const char* lds_cptr;
typedef short v4i16_t __attribute__((ext_vector_type(4)));
__device__ __forceinline__ void kload8(bf16x8*kf,lds_cptr kp){
  kf[0]=*(const __attribute__((address_space(3))) bf16x8*)(kp);      kf[1]=*(const __attribute__((address_space(3))) bf16x8*)(kp+512);
  kf[2]=*(const __attribute__((address_space(3))) bf16x8*)(kp+2048); kf[3]=*(const __attribute__((address_space(3))) bf16x8*)(kp+2560);
  kf[4]=*(const __attribute__((address_space(3))) bf16x8*)(kp+4096); kf[5]=*(const __attribute__((address_space(3))) bf16x8*)(kp+4608);
  kf[6]=*(const __attribute__((address_space(3))) bf16x8*)(kp+6144); kf[7]=*(const __attribute__((address_space(3))) bf16x8*)(kp+6656);
}
__device__ __forceinline__ void kload2(bf16x8*kf,lds_cptr kp,int j){ kf[2*j]=*(const __attribute__((address_space(3))) bf16x8*)(kp+j*2048); kf[2*j+1]=*(const __attribute__((address_space(3))) bf16x8*)(kp+j*2048+512); }
__device__ __forceinline__ s16x4 vtr(lds_cptr p){ return __builtin_bit_cast(s16x4,__builtin_amdgcn_ds_read_tr16_b64_v4i16((__attribute__((address_space(3))) v4i16_t*)p)); }
__device__ __forceinline__ float rowmax(const f32x16&p0,const f32x16&p1){
  float a=max3f(p0[0],p0[1],p1[0]),b=max3f(p0[2],p0[3],p1[1]);a=max3f(a,p1[2],p1[3]);
  #pragma unroll
  for(int r=4;r<16;r+=4){a=max3f(a,p0[r],p0[r+1]);b=max3f(b,p0[r+2],p0[r+3]);a=max3f(a,p1[r],p1[r+1]);b=max3f(b,p1[r+2],p1[r+3]);}
  const float m=max2f(a,b);
  auto rr=__builtin_amdgcn_permlane32_swap(__float_as_uint(m),__float_as_uint(m),false,false);
  return max2f(__uint_as_float(rr[0]),__uint_as_float(rr[1]));
}
__device__ __forceinline__ void pv(f32x16*o,int vb,bf16x8 pa0,bf16x8 pa1,bf16x8 pa2,bf16x8 pa3){
  #pragma unroll
  for(int d0=0;d0<2;++d0){s16x4 lo[4],hi[4];
    #pragma unroll
    for(int ks=0;ks<4;++ks){
      asm volatile("ds_read_b64_tr_b16 %0,%1 offset:%c2":"=&v"(lo[ks]):"v"(vb),"i"(d0*4096+ks*1024):"memory");
      asm volatile("ds_read_b64_tr_b16 %0,%1 offset:%c2":"=&v"(hi[ks]):"v"(vb),"i"(d0*4096+ks*1024+512):"memory");}
    asm volatile("s_waitcnt lgkmcnt(0)":::"memory");SBAR();
    #define PK(k) (bf16x8){lo[k][0],lo[k][1],lo[k][2],lo[k][3],hi[k][0],hi[k][1],hi[k][2],hi[k][3]}
    o[d0]=__builtin_amdgcn_mfma_f32_32x32x16_bf16(pa0,PK(0),o[d0],0,0,0);
    o[d0]=__builtin_amdgcn_mfma_f32_32x32x16_bf16(pa1,PK(1),o[d0],0,0,0);
    o[d0]=__builtin_amdgcn_mfma_f32_32x32x16_bf16(pa2,PK(2),o[d0],0,0,0);
    o[d0]=__builtin_amdgcn_mfma_f32_32x32x16_bf16(pa3,PK(3),o[d0],0,0,0);
    #undef PK
  }
}

#ifndef ATTN_STORE16
#define ATTN_STORE16(p,v) (*(u32x4*)(p)=(v))
#endif
template<int THRL> __device__ __forceinline__ void attn_unit(int b,int h,int qb,const bf16*Q,const bf16*__restrict__ K,const bf16*__restrict__ V,bf16*O,char*shm,const float*FBg){
  int tid=threadIdx.x; asm volatile("":"+v"(tid)); const int lane=tid&63,r32=lane&31,hi=lane>>5; const int wid=__builtin_amdgcn_readfirstlane(tid>>6);
  const long rowbase=(long)b*SEQ; const int q0=qb*QB;
  const bf16*Qw=Q+(rowbase+q0+wid*QBLK)*DM+h*D;
  const bf16*Kh=K+rowbase*DM+h*D,*Vh=V+rowbase*DM+h*D;
  const unsigned lds0=(unsigned)(uintptr_t)shm;
  float*wsf=(float*)(shm+LDS_WS)+wid*64;
  const bf16*ksrc=Kh+(long)lane*DM+wid*8;
  const bf16*vsrc=Vh+(long)(16*(wid&3)+(lane>>2))*DM+(wid>>2)*32+(lane&3)*8;
  const unsigned kdst=lds0+LDS_K+wid*1024, vdst=lds0+LDS_V+wid*1024;
  #define DMA_K(t,slot) glds16(ksrc+(long)(j0+(t))*KVBLK*DM,(unsigned)__builtin_amdgcn_readfirstlane(kdst+(slot)))
  #define DMA_V(t,slot) glds16(vsrc+(long)(j0+(t))*KVBLK*DM,(unsigned)__builtin_amdgcn_readfirstlane(vdst+(slot)))
  const int vb0=(int)(lds0+LDS_V)+((lane>>4)&1)*32+(lane&3)*8+(4*hi+((lane&15)>>2))*64;
  const char*Kbase=shm+LDS_K; bf16x8 kf[8];
  const lds_cptr shm3=(lds_cptr)shm; const lds_cptr kp0=shm3+LDS_K+hi*1024+r32*16; const lds_cptr vp0=shm3+LDS_V+((lane>>4)&1)*32+(lane&3)*8+(4*hi+((lane&15)>>2))*64;
  const int NT0=(q0+QB)/KVBLK;
  typedef __attribute__((address_space(3))) const f32x4v* lds_f4p;
  { float*fbl=(float*)(shm+LDS_FB); const float*src=FBg+((long)b*NHEAD+h)*SEQ; for(int i=tid*4;i<q0+QB;i+=2048)*(f32x4v*)(fbl+i)=*(const f32x4v*)(src+i); }
  asm volatile("s_waitcnt vmcnt(0) lgkmcnt(0)\n\ts_barrier":::"memory");
  int j0; { const __attribute__((address_space(3))) float*fl=(const __attribute__((address_space(3))) float*)((__attribute__((address_space(3))) char*)shm+LDS_FB);
    const bool far_=(lane<NT0)&&(fl[q0]-fl[64*lane+63]>69.25f); j0=(int)__builtin_popcountll(__ballot(far_))&~1; if(j0>NT0-4)j0=NT0-4; j0=__builtin_amdgcn_readfirstlane(j0); }
  const int NT=NT0-j0;
  const lds_f4p fbp=(lds_f4p)((__attribute__((address_space(3))) const char*)shm+LDS_FB+hi*16)+j0*16;
  #define BIN(Pn,g,idx,tn) do{ const f32x4v b_=(fbp+(tn)*16)[idx]; Pn[4*(g)]=b_[0]-mhat; Pn[4*(g)+1]=b_[1]-mhat; Pn[4*(g)+2]=b_[2]-mhat; Pn[4*(g)+3]=b_[3]-mhat; }while(0)
  #define ADDB(P0,P1,t) do{ const lds_f4p fp_=fbp+(t)*16; _Pragma("unroll") for(int g_=0;g_<4;++g_){ const f32x4v b0_=fp_[2*g_], b1_=fp_[2*g_+8]; \
      P0[4*g_]+=b0_[0];P0[4*g_+1]+=b0_[1];P0[4*g_+2]+=b0_[2];P0[4*g_+3]+=b0_[3]; P1[4*g_]+=b1_[0];P1[4*g_+1]+=b1_[1];P1[4*g_+2]+=b1_[2];P1[4*g_+3]+=b1_[3]; } }while(0)
  DMA_K(0,0);DMA_V(0,0);DMA_K(1,SLOTB);
  bf16x8 qr[4];
  #pragma unroll
  for(int d0=0;d0<4;++d0)qr[d0]=*reinterpret_cast<const bf16x8*>(&Qw[(long)r32*DM+d0*16+hi*8]);
  float mhat=0.f,l_reg=0.f;f32x16 o[2];o[0]=f32x16{};o[1]=f32x16{};
  const int qrel=wid*QBLK+r32;
  #define CMASK(P0,P1,t) do{int jb_=(t)-(NT-4); if(jb_>=0)cmask(P0,P1,jb_,qrel,hi);}while(0)
  bool resc=false;
  #define START(P0,P1) do{ const float rm=rowmax(P0,P1); resc=false; \
    { const float dl=rm; mhat=fadd_s(mhat,dl); \
      _Pragma("unroll") for(int r=0;r<16;++r){P0[r]=fsub_s(P0[r],dl);P1[r]=fsub_s(P1[r],dl);} } \
    _Pragma("unroll") for(int r=0;r<16;++r)P0[r]=__builtin_amdgcn_exp2f(P0[r]); }while(0)
  #define RESC() do{ if(resc){ asm volatile("s_waitcnt lgkmcnt(0)":::"memory"); \
      _Pragma("unroll") for(int d_=0;d_<2;++d_) _Pragma("unroll") for(int r=0;r<16;++r)o[d_][r]*=wsf[crow(r,hi)]; } }while(0)
  f32x16 pA0,pA1,pB0,pB1;
  int sl_prev=0,sl_cur=0,sl_next=SLOTB;
  #define ROT() do{sl_prev=sl_cur;sl_cur=sl_next;sl_next=(sl_next==(NSLOT-1)*SLOTB)?0:sl_next+SLOTB;}while(0)
  DMA_K(2,2*SLOTB);
  WAIT_BAR(3);
  qkt(pA0,pA1,Kbase,qr,f32x16{},r32,hi);asm volatile("s_nop 15\n\ts_nop 7":"+v"(pA0),"+v"(pA1));ADDB(pA0,pA1,0);CMASK(pA0,pA1,0);
  START(pA0,pA1);
  _Pragma("unroll") for(int r=0;r<16;++r)pA1[r]=__builtin_amdgcn_exp2f(pA1[r]);
  { _Pragma("unroll") for(int g_=0;g_<4;++g_){ BIN(pB0,g_,2*g_,1); BIN(pB1,g_,2*g_+8,1); } }
  WAIT_BAR(0);
  DMA_K(3,0);DMA_V(1,SLOTB);
  ROT();
  kload8(kf,kp0+sl_cur);
  WAIT_BAR(2);
  s16x4 vlo[8],vhi[8]; u32x4 pw0,pw1,pw2,pw3;
  #define PKW(P,B) cvtpk_s(P[B],P[B+1])
  #define PAF(k) __builtin_bit_cast(bf16x8,pw##k)
  #define VFR(i) (bf16x8){vlo[i][0],vlo[i][1],vlo[i][2],vlo[i][3],vhi[i][0],vhi[i][1],vhi[i][2],vhi[i][3]}
  #define PIN(x) asm volatile("":"+v"(x))
  #define MX3(a,b,c) __builtin_fmaxf(__builtin_fmaxf((a),(b)),(c))
  #define GAPA(MF,A0,A1,A2,A3,W0,W1,PW) do{ MF; sacc+=A0; sacc+=A1; sacc+=A2; sacc+=A3; PIN(sacc); W0; W1; PIN(PW); SBAR(); }while(0)
  #define EX(v) __builtin_amdgcn_exp2f(v)
  #define GAPB(MF,X,B,TAIL) do{ MF; X[B]=EX(X[B]); X[B+1]=EX(X[B+1]); X[B+2]=EX(X[B+2]); X[B+3]=EX(X[B+3]); PIN(X); TAIL; SBAR(); }while(0)
  #define VRD(i) do{ vlo[i]=vtr(vp_+(((i)>>2)*4096+((i)&3)*1024)); vhi[i]=vtr(vp_+(((i)>>2)*4096+((i)&3)*1024+512)); }while(0)
  #define KRD(G,j) do{ if(G){ kload2(kf,kp0+sl_next,j); SBAR(); } }while(0)
  #define STEP(C0,C1,P0,P1,t,GK,GV,GL) do{ SBAR(); \
    const lds_cptr vp_=vp0+sl_prev; \
    VRD(0); SBAR(); float sacc=(P0[0]+P0[1]); \
    GAPA(C0=__builtin_amdgcn_mfma_f32_32x32x16_bf16(kf[0],qr[0],C0,0,0,0), P0[2],P0[3],P0[4],P0[5],     pw0[0]=PKW(P0,0), pw0[1]=PKW(P0,2), pw0); \
    VRD(4); SBAR(); GAPA(C1=__builtin_amdgcn_mfma_f32_32x32x16_bf16(kf[1],qr[0],C1,0,0,0), P0[6],P0[7],P0[8],P0[9],     pw0[2]=PKW(P0,4), pw0[3]=PKW(P0,6), pw0); \
    VRD(1); SBAR(); GAPA(C0=__builtin_amdgcn_mfma_f32_32x32x16_bf16(kf[2],qr[1],C0,0,0,0),   P0[10],P0[11],P0[12],P0[13], pw1[0]=PKW(P0,8), pw1[1]=PKW(P0,10), pw1); \
    VRD(5); SBAR(); GAPA(C1=__builtin_amdgcn_mfma_f32_32x32x16_bf16(kf[3],qr[1],C1,0,0,0),   P0[14],P0[15],P1[0],P1[1],   pw1[2]=PKW(P0,12),pw1[3]=PKW(P0,14), pw1); \
    VRD(2); SBAR(); GAPA(C0=__builtin_amdgcn_mfma_f32_32x32x16_bf16(kf[4],qr[2],C0,0,0,0),   P1[2],P1[3],P1[4],P1[5],     pw2[0]=PKW(P1,0), pw2[1]=PKW(P1,2), pw2); \
    VRD(6); SBAR(); GAPA(C1=__builtin_amdgcn_mfma_f32_32x32x16_bf16(kf[5],qr[2],C1,0,0,0),   P1[6],P1[7],P1[8],P1[9],     pw2[2]=PKW(P1,4), pw2[3]=PKW(P1,6), pw2); \
    VRD(3); SBAR(); GAPA(C0=__builtin_amdgcn_mfma_f32_32x32x16_bf16(kf[6],qr[3],C0,0,0,0),   P1[10],P1[11],P1[12],P1[13], pw3[0]=PKW(P1,8), pw3[1]=PKW(P1,10), pw3); \
    VRD(7); SBAR(); GAPA(C1=__builtin_amdgcn_mfma_f32_32x32x16_bf16(kf[7],qr[3],C1,0,0,0),   P1[14],P1[15],0.f,0.f,       pw3[2]=PKW(P1,12),pw3[3]=PKW(P1,14), pw3); \
    l_reg+=sacc; \
    if(GK){DMA_K((t)+3,sl_cur);} if(GV){DMA_V((t)+1,sl_next);} \
    CMASK(C0,C1,t); \
    { float a=MX3(C0[0],C0[1],C1[0]),b=MX3(C0[2],C0[3],C1[1]); a=MX3(a,C1[2],C1[3]); \
      _Pragma("unroll") for(int r=4;r<16;r+=4){a=MX3(a,C0[r],C0[r+1]);b=MX3(b,C0[r+2],C0[r+3]);a=MX3(a,C1[r],C1[r+1]);b=MX3(b,C1[r+2],C1[r+3]);} \
      float rm=__builtin_fmaxf(a,b); { auto rr=__builtin_amdgcn_permlane32_swap(__float_as_uint(rm),__float_as_uint(rm),false,false); rm=__builtin_fmaxf(__uint_as_float(rr[0]),__uint_as_float(rr[1])); } \
      resc=false; \
      if(__builtin_expect(__any(rm>(float)THRL),0)){ const float dl=__builtin_fmaxf(rm,0.f); mhat+=dl; \
        _Pragma("unroll") for(int r=0;r<16;++r){C0[r]-=dl;C1[r]-=dl;} \
        const float f=__builtin_amdgcn_exp2f(-dl); l_reg*=f; if(hi==0)wsf[r32]=f; resc=true; } } \
    SBAR(); \
    GAPB(o[0]=__builtin_amdgcn_mfma_f32_32x32x16_bf16(PAF(0),VFR(0),o[0],0,0,0), C0,0,  if(GL){BIN(P0,0,0,(t)+1);}); \
    GAPB(o[1]=__builtin_amdgcn_mfma_f32_32x32x16_bf16(PAF(0),VFR(4),o[1],0,0,0), C0,4,  if(GL){BIN(P1,0,8,(t)+1);}); \
    KRD(GL,0); GAPB(o[0]=__builtin_amdgcn_mfma_f32_32x32x16_bf16(PAF(1),VFR(1),o[0],0,0,0), C0,8,  if(GL){BIN(P0,1,2,(t)+1);}); \
    KRD(GL,1); GAPB(o[1]=__builtin_amdgcn_mfma_f32_32x32x16_bf16(PAF(1),VFR(5),o[1],0,0,0), C0,12, if(GL){BIN(P1,1,10,(t)+1);}); \
    KRD(GL,2); GAPB(o[0]=__builtin_amdgcn_mfma_f32_32x32x16_bf16(PAF(2),VFR(2),o[0],0,0,0), C1,0,  if(GL){BIN(P0,2,4,(t)+1);}); \
    KRD(GL,3); GAPB(o[1]=__builtin_amdgcn_mfma_f32_32x32x16_bf16(PAF(2),VFR(6),o[1],0,0,0), C1,4,  if(GL){BIN(P1,2,12,(t)+1);}); \
    GAPB(o[0]=__builtin_amdgcn_mfma_f32_32x32x16_bf16(PAF(3),VFR(3),o[0],0,0,0), C1,8,  if(GL){BIN(P0,3,6,(t)+1);}); \
    GAPB(o[1]=__builtin_amdgcn_mfma_f32_32x32x16_bf16(PAF(3),VFR(7),o[1],0,0,0), C1,12, if(GL){BIN(P1,3,14,(t)+1);}); \
    }while(0)
  int t=1;
  #undef CMASK
  #define CMASK(P0,P1,t) do{}while(0)
  for(;t+5<NT;t+=2){
    STEP(pB0,pB1,pA0,pA1,t,true,true,true);     WAIT_BAR(2); RESC(); ROT();
    STEP(pA0,pA1,pB0,pB1,t+1,true,true,true);   WAIT_BAR(2); RESC(); ROT();
  }
  #undef CMASK
  #define CMASK(P0,P1,t) do{int jb_=(t)-(NT-4); if(jb_>=0)cmask(P0,P1,jb_,qrel,hi);}while(0)
  #define ENDW(tt) do{ if((tt)+3<NT){WAIT_BAR(2);} else if((tt)+2<NT){WAIT_BAR(1);} else {WAIT_BAR(0);} }while(0)
  for(;t+1<NT;t+=2){
    STEP(pB0,pB1,pA0,pA1,t,(t+3<NT),(t+1<NT),(t+1<NT));       ENDW(t);   RESC(); ROT();
    STEP(pA0,pA1,pB0,pB1,t+1,(t+4<NT),(t+2<NT),(t+2<NT));     ENDW(t+1); RESC(); ROT();
  }
  STEP(pB0,pB1,pA0,pA1,NT-1,false,false,false); RESC();
  { float sacc=pB0[0]+pB0[1]; _Pragma("unroll") for(int r=2;r<16;++r)sacc+=pB0[r]; _Pragma("unroll") for(int r=0;r<16;++r)sacc+=pB1[r]; l_reg+=sacc;
    pw0=(u32x4){PKW(pB0,0),PKW(pB0,2),PKW(pB0,4),PKW(pB0,6)};pw1=(u32x4){PKW(pB0,8),PKW(pB0,10),PKW(pB0,12),PKW(pB0,14)};pw2=(u32x4){PKW(pB1,0),PKW(pB1,2),PKW(pB1,4),PKW(pB1,6)};pw3=(u32x4){PKW(pB1,8),PKW(pB1,10),PKW(pB1,12),PKW(pB1,14)};
    SBAR(); pv(o,vb0+sl_cur,PAF(0),PAF(1),PAF(2),PAF(3)); }
  #undef PKW
  #undef PAF
  #undef VFR
  #undef PIN
  #undef MX3
  #undef GAPA
  #undef GAPB
  #undef EX
  #undef VRD
  #undef KRD
  #undef STEP
  #undef ENDW
  {auto rr=__builtin_amdgcn_permlane32_swap(__float_as_uint(l_reg),__float_as_uint(l_reg),false,false);l_reg=__uint_as_float(rr[0])+__uint_as_float(rr[1]);}
  if(hi==0)wsf[32+r32]=l_reg;asm volatile("s_waitcnt lgkmcnt(0)":::"memory");
  float rli[16];
  #pragma unroll
  for(int r=0;r<16;++r)rli[r]=__builtin_amdgcn_rcpf(wsf[32+crow(r,hi)]);
  bf16*Ow=O+(rowbase+q0+wid*QBLK)*DMO+h*D;
  { bf16*stg=(bf16*)(shm+LDS_OST)+wid*2048;
    #pragma unroll
    for(int r=0;r<16;++r){const int orow=crow(r,hi);
      #pragma unroll
      for(int d0=0;d0<2;++d0)stg[orow*64+d0*32+r32]=(bf16)f2bf(o[d0][r]*rli[r]);}
    asm volatile("s_waitcnt lgkmcnt(0)":::"memory");
    #pragma unroll
    for(int i=0;i<4;++i){const int row=i*8+(lane>>3),ch=lane&7; const u32x4 v=*(const u32x4*)(stg+row*64+ch*8); ATTN_STORE16(Ow+(long)row*DMO+ch*8,v);} }
  asm volatile("s_waitcnt lgkmcnt(0)\n\ts_barrier":::"memory");
  #undef DMA_K
  #undef DMA_V
  #undef ADDB
  #undef BIN
  #undef CMASK
  #undef START
  #undef RESC
  #undef ROT
}
constexpr int ATTN_LDS_BYTES=LDS_BYTES;
#undef SBAR
#undef WAIT_BAR
}

__device__ __forceinline__ void fb_cumsum(Frame& F) {
    const int gwv = F.bid * NWAVES + F.wave; if (gwv >= 64) return;
    const float* lf = (const float*)(F.ws + WS_LOGF) + ((size_t)(gwv >> 3) * S) * 8 + (gwv & 7);
    float* fb = (float*)(F.ws + WS_FB) + (size_t)gwv * S;
    float carry = 0.f;
#pragma unroll 1
    for (int i0 = 0; i0 < 64; i0 += 8) {
        float v[8];
#pragma unroll
        for (int k = 0; k < 8; ++k) v[k] = lf[(size_t)((i0 + k) * 64 + F.lane) * 8];
#pragma unroll
        for (int k = 0; k < 8; ++k) { float x = v[k];
#pragma unroll
            for (int o = 1; o < 64; o <<= 1) { const float n = __shfl_up(x, o); if (F.lane >= o) x += n; }
            x += carry; fb[(i0 + k) * 64 + F.lane] = -LOG2E * x; carry = __shfl(x, 63); }
    }
}
__device__ __forceinline__ void rnn_task(Frame& F, int b, int n, int half) {
    typedef short bf16x8 __attribute__((ext_vector_type(8)));
    constexpr int O_XR = 0, O_GR = 16896, O_XB = 25088, O_AA = 43520, O_UU = 59904, O_SEG = 76288, O_CAR = 80384, O_WT = 80640;
    LAS float* seg = (LAS float*)(F.lds + O_SEG);
    LAS float* carry = (LAS float*)(F.lds + O_CAR);
    LAS bf16_t* wT = (LAS bf16_t*)(F.lds + O_WT);
    const int tid = F.tid, lane = F.lane, wave = F.wave;
    { const float* erw = INP(I_ERW); const float* eiw = INP(I_EIW);
      for (int idx = tid; idx < 4096; idx += NTHREADS) { const int g = idx >> 11, d = (idx >> 5) & 63, e = idx & 31; wT[(g * 32 + e) * 72 + d] = (bf16_t)f2bf((g ? eiw : erw)[(n * 64 + d) * 64 + 32 * half + e]); } }
    if (tid < 64) carry[tid] = 0.f;
    __syncthreads();
    const int l15 = lane & 15, kg = lane >> 4;
    bf16x8 Br[2][2], Bi[2][2];
#pragma unroll
    for (int ks = 0; ks < 2; ++ks)
#pragma unroll
        for (int nt = 0; nt < 2; ++nt) { Br[ks][nt] = *(const LAS bf16x8*)(wT + (16 * nt + l15) * 72 + 32 * ks + 8 * kg); Bi[ks][nt] = *(const LAS bf16x8*)(wT + (32 + 16 * nt + l15) * 72 + 32 * ks + 8 * kg); }
    float rbe[2], ibe[2], la[2], e0[2], e1[2], e2[2], e3[2], ebias[2];
    { const float* erb = INP(I_ERB); const float* eib = INP(I_EIB); const float* elam = INP(I_ELAM); const float* ecw = INP(I_ECW); const float* ecb = INP(I_ECB);
#pragma unroll
      for (int nt = 0; nt < 2; ++nt) { const int chg = n * 64 + 32 * half + 16 * nt + l15;
          rbe[nt] = erb[chg]; ibe[nt] = eib[chg]; la[nt] = -8.0f * softplusf_(-elam[chg]); e0[nt] = ecw[chg]; e1[nt] = ecw[D_RNN + chg]; e2[nt] = ecw[2 * D_RNN + chg]; e3[nt] = ecw[3 * D_RNN + chg]; ebias[nt] = ecb[chg]; } }
    const int ch = tid & 63, tq = tid >> 6, cch = n * 64 + ch;
    float c0, c1, c2, c3, cbias;
    { const float* ecw = INP(I_ECW); c0 = ecw[cch]; c1 = ecw[D_RNN + cch]; c2 = ecw[2 * D_RNN + cch]; c3 = ecw[3 * D_RNN + cch]; cbias = INP(I_ECB)[cch]; }
    const int sch = tid & 31, sg = tid >> 5;
    const int srow = tid >> 3, spc = tid & 7, grow = tid >> 2, gpc = tid & 3;
    const bf16_t* px = (const bf16_t*)(F.ws + WS_PROJ) + (size_t)b * S * P0W + n * 64 + spc * 8;
    const bf16_t* pgt = (const bf16_t*)(F.ws + WS_PROJ) + (size_t)b * S * P0W + D_RNN + n * 64 + 32 * half + gpc * 8;
    bf16_t* py = (bf16_t*)(F.ws + WS_YMIX) + (size_t)b * S * D + n * 64 + 32 * half + sch;
    u32x4 xr0, xr1, xh, gr0;
#define RNN_LOAD(t0) do { const bf16_t* p_ = px + (size_t)((t0) + srow) * P0W; xr0 = *(const u32x4*)p_; xr1 = *(const u32x4*)(p_ + (size_t)64 * P0W); gr0 = *(const u32x4*)(pgt + (size_t)((t0) + grow) * P0W); \
        xh = (u32x4){0u, 0u, 0u, 0u}; if (tid < 24 && (t0) > 0) xh = *(const u32x4*)(px + (size_t)((t0) - 3 + srow) * P0W); } while (0)
    RNN_LOAD(0);
    int o_st = (srow * 64 + spc * 8) * 2;
    int o_gs = (grow * 32 + gpc * 8) * 2;
    int o_cv = (tq * 16 * 64 + ch) * 2;
    int o_xb = (tq * 16 * 72 + ch) * 2;
    int o_af = ((16 * wave + l15) * 72 + 8 * kg) * 2;
    int o_e2 = ((16 * wave + 4 * kg) * 64 + 32 * half + l15) * 2;
    int o_e4 = ((16 * wave + 4 * kg) * 32 + l15) * 4;
    int o_sc = (sg * 8 * 32 + sch) * 4;
    int o_gg = (sg * 8 * 32 + sch) * 2;
    LAS unsigned char* L = F.lds;
#pragma unroll 1
    for (int c = 0; c < S / 128; ++c) {
        const int t0 = c * 128;
        asm volatile("" : "+v"(o_st), "+v"(o_gs), "+v"(o_cv), "+v"(o_xb), "+v"(o_af), "+v"(o_e2), "+v"(o_e4), "+v"(o_sc), "+v"(o_gg));
        *(LAS u32x4*)(L + O_XR + o_st + 3 * 128) = xr0; *(LAS u32x4*)(L + O_XR + o_st + 67 * 128) = xr1;
        *(LAS u32x4*)(L + O_GR + o_gs) = gr0;
        if (tid < 24) *(LAS u32x4*)(L + O_XR + o_st) = xh;
        LDS_BARRIER();
        if (c + 1 < S / 128) RNN_LOAD(t0 + 128);
        { float w0 = bf2f(*(LAS bf16_t*)(L + O_XR + o_cv)), w1 = bf2f(*(LAS bf16_t*)(L + O_XR + o_cv + 128)), w2 = bf2f(*(LAS bf16_t*)(L + O_XR + o_cv + 256));
#pragma unroll
          for (int i = 0; i < 16; ++i) { const float w3 = bf2f(*(LAS bf16_t*)(L + O_XR + o_cv + (i + 3) * 128)); *(LAS bf16_t*)(L + O_XB + o_xb + i * 144) = (bf16_t)f2bf(cbias + c0 * w0 + c1 * w1 + c2 * w2 + c3 * w3); w0 = w1; w1 = w2; w2 = w3; } }
        LDS_BARRIER();
        { f32x4 R[2] = {(f32x4){0.f, 0.f, 0.f, 0.f}, (f32x4){0.f, 0.f, 0.f, 0.f}}, I[2] = {(f32x4){0.f, 0.f, 0.f, 0.f}, (f32x4){0.f, 0.f, 0.f, 0.f}};
#pragma unroll
          for (int ks = 0; ks < 2; ++ks) { const bf16x8 af = *(const LAS bf16x8*)(L + O_XB + o_af + ks * 64);
#pragma unroll
              for (int nt = 0; nt < 2; ++nt) { R[nt] = __builtin_amdgcn_mfma_f32_16x16x32_bf16(af, Br[ks][nt], R[nt], 0, 0, 0); I[nt] = __builtin_amdgcn_mfma_f32_16x16x32_bf16(af, Bi[ks][nt], I[nt], 0, 0, 0); } }
#pragma unroll
          for (int nt = 0; nt < 2; ++nt)
#pragma unroll
              for (int r = 0; r < 4; ++r) {
                  const float xc = ebias[nt] + e0[nt] * bf2f(*(LAS bf16_t*)(L + O_XR + o_e2 + nt * 32 + r * 128)) + e1[nt] * bf2f(*(LAS bf16_t*)(L + O_XR + o_e2 + nt * 32 + (r + 1) * 128))
                                 + e2[nt] * bf2f(*(LAS bf16_t*)(L + O_XR + o_e2 + nt * 32 + (r + 2) * 128)) + e3[nt] * bf2f(*(LAS bf16_t*)(L + O_XR + o_e2 + nt * 32 + (r + 3) * 128));
                  const float rr = fsigmoid(R[nt][r] + rbe[nt]), gi = fsigmoid(I[nt][r] + ibe[nt]), av = __builtin_amdgcn_exp2f(LOG2E * la[nt] * rr);
                  *(LAS float*)(L + O_AA + o_e4 + nt * 64 + r * 128) = av; *(LAS float*)(L + O_UU + o_e4 + nt * 64 + r * 128) = __builtin_amdgcn_sqrtf(fmaxf((1.f - av) * (1.f + av), 0.f)) * (gi * xc); } }
        LDS_BARRIER();
        { float A = 1.f, U = 0.f;
#pragma unroll
          for (int i = 0; i < 8; ++i) { const float a = *(LAS float*)(L + O_AA + o_sc + i * 128), u = *(LAS float*)(L + O_UU + o_sc + i * 128); U = a * U + u; A = a * A; }
          seg[sg * 32 + sch] = A; seg[512 + sg * 32 + sch] = U; }
        LDS_BARRIER();
        { float h = carry[(c & 1) * 32 + sch];
          { float sa[15], su[15];
#pragma unroll
            for (int s = 0; s < 15; ++s) { sa[s] = seg[s * 32 + sch]; su[s] = seg[512 + s * 32 + sch]; }
#pragma unroll
            for (int s = 0; s < 15; ++s) if (s < sg) h = sa[s] * h + su[s]; }
          bf16_t* pyc = py + (size_t)(t0 + sg * 8) * D;
#pragma unroll
          for (int i = 0; i < 8; ++i) { h = *(LAS float*)(L + O_AA + o_sc + i * 128) * h + *(LAS float*)(L + O_UU + o_sc + i * 128); pyc[(size_t)i * D] = (bf16_t)f2bf(h * fgelu(bf2f(*(LAS bf16_t*)(L + O_GR + o_gg + i * 64)))); }
          if (sg == 15) carry[((c + 1) & 1) * 32 + sch] = h; }
        LDS_BARRIER();
    }
#undef RNN_LOAD
}
__device__ __forceinline__ void ph_mixer0(Frame& F, unsigned char* lds_generic, int qi) {
    LAS volatile int* qslot = (LAS volatile int*)(F.lds + 160 * 1024 - 64);
    unsigned* qhead = (unsigned*)(F.ws + WS_CTL) + CW_QUEUE + 64 * qi;
    const bf16_t* P = (const bf16_t*)(F.ws + WS_PROJ);
#define MIX_FETCH(item) do { if (F.tid == 0) qslot[0] = (int)atomicAdd(qhead, 1u); __syncthreads(); item = qslot[0]; __syncthreads(); } while (0)
    int item; MIX_FETCH(item);
#pragma unroll 1
    while (item < 128) {
#ifndef MK_NO_RNN
        rnn_task(F, item >> 4, (item >> 1) & 7, item & 1);
#endif
        MIX_FETCH(item); }
#pragma unroll 1
    while (item < 128 + 1024) { const int u = item - 128, qb = 15 - (u >> 6), bh = u & 63;
#ifndef MK_NO_ATTN
        attn_body::attn_unit<8>(bh >> 3, bh & 7, qb, P + 1024, P + 1536, P + 2048, (bf16_t*)(F.ws + WS_YMIX) + D_RNN, (char*)lds_generic, (const float*)(F.ws + WS_FB));
#endif
        MIX_FETCH(item); }
#undef MIX_FETCH
}


namespace gla {
typedef short bf16x8 __attribute__((ext_vector_type(8)));
typedef float f32x16 __attribute__((ext_vector_type(16)));
constexpr int QTP = 136;
__device__ __forceinline__ int dkperm(int c) { return (c & ~12) | ((c & 4) << 1) | ((c & 8) >> 1); }

struct G1Regs { u32x4 q[2], k[2]; f32x4 g; };
__device__ __forceinline__ void g1_load(G1Regs& R, const unsigned char* ws, int cidx, int tid) {
    const int n = cidx & 63, h = (cidx >> 6) & 3, b = cidx >> 8; const size_t row0 = (size_t)b * S + n * 64;
    const bf16_t* P = (const bf16_t*)(ws + WS_PROJ);
#pragma unroll
    for (int i = 0; i < 2; ++i) { const int p = tid + i * 512, tok = p >> 4, c = p & 15; R.q[i] = *(const u32x4*)(P + (row0 + tok) * P1W + h * 128 + c * 8); R.k[i] = *(const u32x4*)(P + (row0 + tok) * P1W + 512 + h * 128 + c * 8); }
    R.g = *(const f32x4*)((const float*)(ws + WS_GLOW) + row0 * 16 + (tid & 255) * 4);
}
__device__ __forceinline__ float flogsig(float z) { return fminf(z, 0.f) - 0.6931471805599453f * __builtin_amdgcn_logf(1.f + __builtin_amdgcn_exp2f(-LOG2E * fabsf(z))); }
__device__ __forceinline__ void ph_g1(Frame& F) {
    const int tid = F.tid, lane = F.lane, wave = F.wave;
    LAS float* glw = (LAS float*)(F.lds);
    LAS float* segt = (LAS float*)(F.lds + 4096);
    LAS bf16_t* qst = (LAS bf16_t*)(F.lds + 8192);
    LAS bf16_t* kst = (LAS bf16_t*)(F.lds + 8192 + 16384);
    LAS bf16_t* qtl = (LAS bf16_t*)(F.lds + 40960);
    LAS bf16_t* ktl = (LAS bf16_t*)(F.lds + 40960 + 64 * QTP * 2);
    LAS bf16_t* ket = (LAS bf16_t*)(F.lds + 40960 + 128 * QTP * 2);
    LAS bf16_t* aml = (LAS bf16_t*)(F.lds + 40960 + 128 * QTP * 2 + 128 * 72 * 2);
    const int col = tid & 127, tg4 = tid >> 7;
    G1Regs R;
    int cidx = F.bid;
    if (cidx < B * GH * 64) g1_load(R, F.ws, cidx, tid);
#pragma unroll 1
    for (; cidx < B * GH * 64; cidx += F.G) {
        const int n = cidx & 63, h = (cidx >> 6) & 3, b = cidx >> 8, dk = h * 128 + col;
        const size_t row0 = (size_t)b * S + n * 64;
        if (tid < 256) *(LAS f32x4*)(glw + tid * 4) = R.g;
#pragma unroll
        for (int i = 0; i < 2; ++i) { const int p = tid + i * 512, tok = p >> 4, c = p & 15; *(LAS u32x4*)(qst + tok * 128 + c * 8) = R.q[i]; *(LAS u32x4*)(kst + tok * 128 + c * 8) = R.k[i]; }
        float w2[16];
        { const float* gw2 = INP(I_OGW2);
#pragma unroll
          for (int j = 0; j < 16; ++j) w2[j] = gw2[j * GDK + dk]; }
        const float gb = INP(I_OGB)[dk];
        LDS_BARRIER();
        { const int nx = cidx + F.G < B * GH * 64 ? cidx + F.G : cidx; g1_load(R, F.ws, nx, tid); }
        float cl[16]; float run = 0.f;
#pragma unroll
        for (int i = 0; i < 16; ++i) { const int tok = tg4 * 16 + i; float z = gb;
#pragma unroll
            for (int j4 = 0; j4 < 4; ++j4) { const f32x4 g = *(const LAS f32x4*)(glw + tok * 16 + j4 * 4); z += g[0] * w2[j4 * 4] + g[1] * w2[j4 * 4 + 1] + g[2] * w2[j4 * 4 + 2] + g[3] * w2[j4 * 4 + 3]; }
            run += flogsig(z) * (1.f / 16.f); cl[i] = run; }
        segt[tg4 * 128 + col] = run;
        LDS_BARRIER();
        float base = 0.f, last = 0.f;
#pragma unroll
        for (int g = 0; g < 4; ++g) { const float s = segt[g * 128 + col]; if (g < tg4) base += s; last += s; }
        unsigned kw[8];
#pragma unroll
        for (int i = 0; i < 16; ++i) { const int tok = tg4 * 16 + i; const float cum = base + cl[i];
            const float q = bf2f(qst[tok * 128 + col]) * 0.08838834764831845f, k = bf2f(kst[tok * 128 + col]);
            const float ec = __builtin_amdgcn_exp2f(LOG2E * cum), qt = q * ec, kt = k * __builtin_amdgcn_rcpf(ec), ke = k * __builtin_amdgcn_exp2f(LOG2E * (last - cum));
            qtl[tok * QTP + col] = (bf16_t)f2bf(qt); ktl[tok * QTP + col] = (bf16_t)f2bf(kt);
            if (i & 1) kw[i >> 1] |= f2bf(ke) << 16; else kw[i >> 1] = f2bf(ke); }
        *(LAS u32x4*)(ket + col * 72 + tg4 * 16) = (u32x4){kw[0], kw[1], kw[2], kw[3]}; *(LAS u32x4*)(ket + col * 72 + tg4 * 16 + 8) = (u32x4){kw[4], kw[5], kw[6], kw[7]};
        if (tg4 == 0) ((float*)(F.ws + WS_DECAY))[(size_t)cidx * 128 + col] = __builtin_amdgcn_exp2f(LOG2E * last);
        LDS_BARRIER();
        if (wave < 4) {
            const int tt = wave & 1, st = wave >> 1, l31 = lane & 31, hi = lane >> 5;
            f32x16 acc = {};
            if (!(tt == 0 && st == 1)) {
#pragma unroll
                for (int ks = 0; ks < 8; ++ks) { const bf16x8 af = *(const LAS bf16x8*)(qtl + (32 * tt + l31) * QTP + 16 * ks + 8 * hi), bfr = *(const LAS bf16x8*)(ktl + (32 * st + l31) * QTP + 16 * ks + 8 * hi);
                    acc = __builtin_amdgcn_mfma_f32_32x32x16_bf16(af, bfr, acc, 0, 0, 0); } }
            const int s = 32 * st + l31;
#pragma unroll
            for (int r = 0; r < 16; ++r) { const int t = 32 * tt + (r & 3) + 8 * (r >> 2) + 4 * hi; aml[t * 72 + s] = (bf16_t)f2bf(s <= t ? acc[r] : 0.f); }
        }
#pragma unroll
        for (int i = 0; i < 2; ++i) { const int p = tid + i * 512, tok = p >> 4, c = p & 15; const LAS bf16_t* s0 = qtl + tok * QTP + 16 * (c >> 1) + 4 * (c & 1);
            const u32x2 lo = *(const LAS u32x2*)s0, hi2 = *(const LAS u32x2*)(s0 + 8);
            *(u32x4*)((bf16_t*)(F.ws + WS_YMIX) + (row0 + tok) * GDK + h * 128 + c * 8) = (u32x4){lo.x, lo.y, hi2.x, hi2.y}; }
#pragma unroll
        for (int i = 0; i < 2; ++i) { const int p = tid + i * 512, d = p >> 3, c = p & 7;
            *(u32x4*)((bf16_t*)(F.ws + WS_YMIX + (size_t)T * GDK * 2) + ((size_t)cidx * 128 + d) * 64 + c * 8) = *(const LAS u32x4*)(ket + d * 72 + c * 8); }
        LDS_BARRIER();
        { const int t = tid >> 3, c = tid & 7; *(u32x4*)((bf16_t*)(F.ws + WS_AMAT) + (size_t)cidx * 4096 + t * 64 + c * 8) = *(const LAS u32x4*)(aml + t * 72 + c * 8); }
        LDS_BARRIER();
    }
    __syncthreads();
}

constexpr int NSP = 4, G2_CW = 8 / NSP, G2_DV = 256 / NSP;
constexpr int QP = 272, KP = 144, AP = 144, VP = G2_DV * 2 + 8;
constexpr int G2_Q = 0, G2_K = G2_Q + 64 * QP, G2_A = G2_K + 128 * KP, G2_V = G2_A + 64 * AP, G2_D = G2_V + 64 * VP, G2_STAGE = G2_D + 512;
constexpr int G2_LT = 256;
constexpr int G2_VPC = G2_DV / 8, G2_QN = 1024 / G2_LT, G2_AN = 512 / G2_LT, G2_VN = 64 * G2_VPC / G2_LT;
struct G2Regs { u32x4 q[G2_QN], k[G2_QN], a[G2_AN], v[G2_VN]; f32x4 d; };
struct G2Offs { unsigned q[G2_QN], k[G2_QN], a[G2_AN], v[G2_VN], d; };
__device__ __forceinline__ void g2_offs(G2Offs& O, int lt) {
#pragma unroll
    for (int i = 0; i < G2_QN; ++i) { const int p = lt + i * G2_LT; O.q[i] = (unsigned)((p >> 4) * GDK + (p & 15) * 8) * 2u; O.k[i] = (unsigned)p * 16u; }
#pragma unroll
    for (int i = 0; i < G2_AN; ++i) O.a[i] = (unsigned)(lt + i * G2_LT) * 16u;
#pragma unroll
    for (int i = 0; i < G2_VN; ++i) { const int p = lt + i * G2_LT; O.v[i] = (unsigned)((p / G2_VPC) * P1W + (p % G2_VPC) * 8) * 2u; }
    O.d = (unsigned)(lt & 31) * 16u;
}
#define G2_GLD(dst, voff) asm volatile("global_load_dwordx4 %0, %1, %2" : "=v"(dst) : "v"(voff), "s"(ws) : "memory")
__device__ __forceinline__ void g2_load(G2Regs& R, const G2Offs& O, const unsigned char* ws, int b, int h, int part, int n) {
    const unsigned cidx = (unsigned)((b * 4 + h) * 64 + n), row0 = (unsigned)(b * S + n * 64);
    const unsigned oq = (unsigned)WS_YMIX + (row0 * GDK + h * 128) * 2u, ok = (unsigned)(WS_YMIX + (size_t)T * GDK * 2) + cidx * 16384u;
    const unsigned oa = (unsigned)WS_AMAT + cidx * 8192u, ov = (unsigned)WS_PROJ + (row0 * P1W + 1024 + h * 256 + part * G2_DV) * 2u, od = (unsigned)WS_DECAY + cidx * 512u;
#pragma unroll
    for (int i = 0; i < G2_QN; ++i) { const unsigned a0 = oq + O.q[i], a1 = ok + O.k[i]; G2_GLD(R.q[i], a0); G2_GLD(R.k[i], a1); }
#pragma unroll
    for (int i = 0; i < G2_AN; ++i) { const unsigned a0 = oa + O.a[i]; G2_GLD(R.a[i], a0); }
#pragma unroll
    for (int i = 0; i < G2_VN; ++i) { const unsigned a0 = ov + O.v[i]; G2_GLD(R.v[i], a0); }
    { const unsigned a0 = od + O.d; u32x4 t; G2_GLD(t, a0); R.d = __builtin_bit_cast(f32x4, t); }
}
constexpr int G2_NLD = 2 * G2_QN + G2_AN + G2_VN + 1;
__device__ __forceinline__ void g2_store(const G2Regs& R, LAS unsigned char* st, int lt) {
#pragma unroll
    for (int i = 0; i < G2_QN; ++i) { const int p = lt + i * G2_LT; *(LAS u32x4*)(st + G2_Q + (p >> 4) * QP + (p & 15) * 16) = R.q[i]; *(LAS u32x4*)(st + G2_K + (p >> 3) * KP + (p & 7) * 16) = R.k[i]; }
#pragma unroll
    for (int i = 0; i < G2_AN; ++i) { const int p = lt + i * G2_LT; *(LAS u32x4*)(st + G2_A + (p >> 3) * AP + (p & 7) * 16) = R.a[i]; }
#pragma unroll
    for (int i = 0; i < G2_VN; ++i) { const int p = lt + i * G2_LT; *(LAS u32x4*)(st + G2_V + (p / G2_VPC) * VP + (p % G2_VPC) * 16) = R.v[i]; }
    *(LAS f32x4*)(st + G2_D + (lt & 31) * 16) = R.d;
}
constexpr int OP = G2_DV * 2 + 16, G2_OB = 2 * G2_STAGE, G2_OBSZ = 64 * OP;
static_assert(G2_OB + 2 * G2_OBSZ <= LDS_BYTES - 512, "G2 LDS map");
__device__ __forceinline__ bf16x8 pk8(const f32x16& X, int s) {
    typedef float f32x2_t __attribute__((ext_vector_type(2))); typedef __bf16 bf16x2_t __attribute__((ext_vector_type(2)));
    union { bf16x8 v; unsigned u[4]; } r;
#pragma unroll
    for (int q = 0; q < 4; ++q) { f32x2_t p = {X[8 * s + 2 * q], X[8 * s + 2 * q + 1]}; r.u[q] = __builtin_bit_cast(unsigned, __builtin_convertvector(p, bf16x2_t)); }
    return r.v;
}
__device__ __forceinline__ void g2_compute(f32x16 (&St)[4], const LAS unsigned char* st, LAS unsigned char* obuf, int w, int l31, int hi) {
#define SB() __builtin_amdgcn_sched_barrier(0)
#define MF(a, b, c) __builtin_amdgcn_mfma_f32_32x32x16_bf16(a, b, c, 0, 0, 0)
    const LAS unsigned char* pa = st + G2_A + l31 * AP + hi * 16;
    const LAS unsigned char* pq = st + G2_Q + l31 * QP + hi * 16;
    const LAS unsigned char* pk = st + G2_K + l31 * KP + hi * 16;
    bf16x8 fa[8], fb[8], Vf[4];
#pragma unroll
    for (int ks = 0; ks < 4; ++ks) { const LAS unsigned char* vp = st + G2_V + (16 * ks + 8 * hi) * VP + (32 * w + l31) * 2;
#pragma unroll
        for (int j = 0; j < 8; ++j) Vf[ks][j] = (short)*(const LAS bf16_t*)(vp + j * VP); }
#pragma unroll
    for (int i = 0; i < 8; ++i) fa[i] = *(const LAS bf16x8*)(pa + (i >> 2) * 32 * AP + (i & 3) * 32);
    SB();
#pragma unroll
    for (int i = 0; i < 8; ++i) fb[i] = *(const LAS bf16x8*)(pq + (i & 1) * 32 * QP + (i >> 1) * 32);
    SB();
    f32x16 O[2] = {f32x16{}, f32x16{}};
#pragma unroll
    for (int i = 0; i < 8; ++i) O[i >> 2] = MF(fa[i], Vf[i & 3], O[i >> 2]);
    SB();
#pragma unroll
    for (int i = 0; i < 8; ++i) fa[i] = *(const LAS bf16x8*)(pq + (i & 1) * 32 * QP + (4 + (i >> 1)) * 32);
    SB();
#pragma unroll
    for (int c = 0; c < 4; ++c) { const bf16x8 sf = pk8(St[c >> 1], c & 1); O[0] = MF(fb[2 * c], sf, O[0]); O[1] = MF(fb[2 * c + 1], sf, O[1]); }
    SB();
#pragma unroll
    for (int i = 0; i < 8; ++i) fb[i] = *(const LAS bf16x8*)(pk + (i >> 2) * 32 * KP + (i & 3) * 32);
    SB();
#pragma unroll
    for (int c = 0; c < 4; ++c) { const bf16x8 sf = pk8(St[2 + (c >> 1)], c & 1); O[0] = MF(fa[2 * c], sf, O[0]); O[1] = MF(fa[2 * c + 1], sf, O[1]); }
    SB();
#pragma unroll
    for (int i = 0; i < 8; ++i) fa[i] = *(const LAS bf16x8*)(pk + (2 + (i >> 2)) * 32 * KP + (i & 3) * 32);
#pragma unroll
    for (int kt = 0; kt < 4; ++kt)
#pragma unroll
        for (int g = 0; g < 4; ++g) { const f32x4 dv = *(const LAS f32x4*)(st + G2_D + (32 * kt + 8 * g + 4 * hi) * 4); St[kt][4 * g] *= dv[0]; St[kt][4 * g + 1] *= dv[1]; St[kt][4 * g + 2] *= dv[2]; St[kt][4 * g + 3] *= dv[3]; }
    SB();
#pragma unroll
    for (int i = 0; i < 8; ++i) St[i >> 2] = MF(fb[i], Vf[i & 3], St[i >> 2]);
    SB();
#pragma unroll
    for (int i = 0; i < 8; ++i) St[2 + (i >> 2)] = MF(fa[i], Vf[i & 3], St[2 + (i >> 2)]);
    SB();
    LAS bf16_t* ob = (LAS bf16_t*)(obuf + (4 * hi) * OP) + 32 * w + l31;
#pragma unroll
    for (int tt = 0; tt < 2; ++tt)
#pragma unroll
        for (int r = 0; r < 16; ++r) ob[(32 * tt + (r & 3) + 8 * (r >> 2)) * (OP / 2)] = (bf16_t)f2bf(O[tt][r]);
#undef SB
#undef MF
}
__device__ __forceinline__ void g2_task(Frame& F, int bh, int part) {
    const int b = bh >> 2, h = bh & 3, tid = F.tid, lane = F.lane, w = F.wave, l31 = lane & 31, hi = lane >> 5;
    if (w < G2_CW) {
        f32x16 St[4];
#pragma unroll
        for (int kt = 0; kt < 4; ++kt) St[kt] = f32x16{};
        LDS_BARRIER();
#pragma unroll 1
        for (int n = 0; n < 64; ++n) { g2_compute(St, F.lds + (n & 1) * G2_STAGE, F.lds + G2_OB + (n & 1) * G2_OBSZ, w, l31, hi); LDS_BARRIER(); }
    } else if (w >= G2_CW + 4) {
        for (int n = 0; n < 65; ++n) LDS_BARRIER();
    } else {
        const int lt = tid - G2_CW * 64;
        G2Regs R0, R1, R2;
        G2Offs GO; g2_offs(GO, lt);
        bf16_t* Og = (bf16_t*)(F.ws + WS_XN) + ((size_t)b * S) * D + h * 256 + part * G2_DV;
        constexpr int OPC = G2_DV / 8, ON = 64 * OPC / G2_LT;
#define G2_OSTORE(n_, buf_) do { const LAS unsigned char* ob_ = F.lds + G2_OB + (buf_) * G2_OBSZ; _Pragma("unroll") for (int i_ = 0; i_ < ON; ++i_) { const int p_ = lt + i_ * G2_LT, tok_ = p_ / OPC, c_ = p_ % OPC; \
            *(u32x4*)(Og + (size_t)((n_) * 64 + tok_) * D + c_ * 8) = *(const LAS u32x4*)(ob_ + tok_ * OP + c_ * 16); } } while (0)
#define G2_WAIT(N) do { asm volatile("s_waitcnt vmcnt(%0)" :: "n"(N) : "memory"); __builtin_amdgcn_sched_barrier(0); } while (0)
        g2_load(R0, GO, F.ws, b, h, part, 0); G2_WAIT(0); g2_store(R0, F.lds, lt);
        g2_load(R1, GO, F.ws, b, h, part, 1); g2_load(R2, GO, F.ws, b, h, part, 2); g2_load(R0, GO, F.ws, b, h, part, 3);
        G2_WAIT(2 * G2_NLD);
        LDS_BARRIER();
        constexpr int WAITN = 2 * G2_NLD + ON;
#define G2_HS(n_, SET, STG) do { G2_WAIT(WAITN); g2_store(SET, F.lds + (STG) * G2_STAGE, lt); G2_OSTORE((n_) > 0 ? (n_) - 1 : 0, ((n_) + 1) & 1); \
            g2_load(SET, GO, F.ws, b, h, part, (n_) + 4); LDS_BARRIER(); } while (0)
#define G2_HT(n_, SET, STG, W) do { G2_WAIT(W); g2_store(SET, F.lds + (STG) * G2_STAGE, lt); G2_OSTORE((n_) - 1, ((n_) + 1) & 1); LDS_BARRIER(); } while (0)
#pragma unroll 1
        for (int n = 0; n < 60; n += 6) { G2_HS(n, R1, 1); G2_HS(n + 1, R2, 0); G2_HS(n + 2, R0, 1); G2_HS(n + 3, R1, 0); G2_HS(n + 4, R2, 1); G2_HS(n + 5, R0, 0); }
        G2_HT(60, R1, 1, WAITN);
        G2_HT(61, R2, 0, G2_NLD + ON);
        G2_HT(62, R0, 1, 0);
        G2_OSTORE(62, 0); LDS_BARRIER();
        G2_OSTORE(63, 1);
#undef G2_HT
#undef G2_HS
#undef G2_WAIT
#undef G2_OSTORE
    }
    __syncthreads();
}
__device__ __forceinline__ void ph_g2(Frame& F) {
    constexpr int NB = B * GH * NSP;
    if (F.bid < NB) { g2_task(F, (F.bid / (8 * NSP)) * 8 + (F.bid & 7), (F.bid >> 3) % NSP); return; }
    LAS float* scr = (LAS float*)(F.lds + F.wave * 16640);
    const int gw = (F.bid - NB) * NWAVES + F.wave, NGW = (F.G - NB) * NWAVES;
    auto dec = [&](int it) -> ConvItem { return moe_item(F, 1, it); };
    conv_run(F, dec, gw, NGW, NE * 384, scr);
}

__device__ __forceinline__ void ph_g3(Frame& F) {
    const int lane = F.lane, gwv = F.bid * NWAVES + F.wave, NGW = F.G * NWAVES;
    const bf16_t* O = (const bf16_t*)(F.ws + WS_XN); const bf16_t* P = (const bf16_t*)(F.ws + WS_PROJ); bf16_t* Y = (bf16_t*)(F.ws + WS_YMIX);
    const f32x4 gn = *(const f32x4*)(INP(I_OGAIN) + 4 * lane);
    constexpr int RB = 2;
#pragma unroll 1
    for (int t0 = gwv * RB; t0 < T; t0 += NGW * RB) {
        u32x2 ov[RB][4], rv[RB][4];
#pragma unroll
        for (int r = 0; r < RB; ++r)
#pragma unroll
            for (int j = 0; j < 4; ++j) { ov[r][j] = *(const u32x2*)(O + (size_t)(t0 + r) * D + 256 * j + 4 * lane); rv[r][j] = *(const u32x2*)(P + (size_t)(t0 + r) * P1W + 2048 + 256 * j + 4 * lane); }
#pragma unroll
        for (int r = 0; r < RB; ++r)
#pragma unroll
            for (int j = 0; j < 4; ++j) {
                f32x4 o; o[0] = __uint_as_float(ov[r][j].x << 16); o[1] = __uint_as_float(ov[r][j].x & 0xffff0000u); o[2] = __uint_as_float(ov[r][j].y << 16); o[3] = __uint_as_float(ov[r][j].y & 0xffff0000u);
                f32x4 g; g[0] = __uint_as_float(rv[r][j].x << 16); g[1] = __uint_as_float(rv[r][j].x & 0xffff0000u); g[2] = __uint_as_float(rv[r][j].y << 16); g[3] = __uint_as_float(rv[r][j].y & 0xffff0000u);
                const float rstd = rsqrtf(wave_sum((o[0] * o[0] + o[1] * o[1]) + (o[2] * o[2] + o[3] * o[3])) * (1.f / 256.f) + EPS);
                u32x2 w; w.x = pk2(o[0] * rstd * gn[0] * g[0] * fsigmoid(g[0]), o[1] * rstd * gn[1] * g[1] * fsigmoid(g[1])); w.y = pk2(o[2] * rstd * gn[2] * g[2] * fsigmoid(g[2]), o[3] * rstd * gn[3] * g[3] * fsigmoid(g[3]));
                *(u32x2*)(Y + (size_t)(t0 + r) * D + 256 * j + 4 * lane) = w;
            }
    }
}
}

template <int NV> __device__ __forceinline__ void xreduce(float (&v)[NV], int lane) {
    if constexpr (NV >= 32) { const bool up = lane & 32;
#pragma unroll
        for (int i = 0; i < 16; ++i) { const float keep = up ? v[16 + i] : v[i], send = up ? v[i] : v[16 + i]; v[i] = keep + __shfl_xor(send, 32); } }
    if constexpr (NV >= 16) { const bool up = lane & (NV >= 32 ? 16 : 32); const int o = (NV >= 32 ? 16 : 32);
#pragma unroll
        for (int i = 0; i < 8; ++i) { const float keep = up ? v[8 + i] : v[i], send = up ? v[i] : v[8 + i]; v[i] = keep + __shfl_xor(send, o); } }
    if constexpr (NV >= 8) { const int o = (NV >= 32 ? 8 : NV >= 16 ? 16 : 32); const bool up = lane & o;
#pragma unroll
        for (int i = 0; i < 4; ++i) { const float keep = up ? v[4 + i] : v[i], send = up ? v[i] : v[4 + i]; v[i] = keep + __shfl_xor(send, o); } }
    { const int o = (NV >= 32 ? 4 : NV >= 16 ? 8 : 16); const bool up = lane & o;
#pragma unroll
        for (int i = 0; i < 2; ++i) { const float keep = up ? v[2 + i] : v[i], send = up ? v[i] : v[2 + i]; v[i] = keep + __shfl_xor(send, o); } }
    { const int o = (NV >= 32 ? 2 : NV >= 16 ? 4 : 8); const bool up = lane & o;
        const float keep = up ? v[1] : v[0], send = up ? v[0] : v[1]; v[0] = keep + __shfl_xor(send, o); }
    if constexpr (NV >= 32) { v[0] += __shfl_xor(v[0], 1); }
    else if constexpr (NV >= 16) { v[0] += __shfl_xor(v[0], 2); v[0] += __shfl_xor(v[0], 1); }
    else { v[0] += __shfl_xor(v[0], 4); v[0] += __shfl_xor(v[0], 2); v[0] += __shfl_xor(v[0], 1); }
}
struct RowRegs { f32x4 x[2][4]; unsigned y[2][2][4]; float g[2][2]; };
template <int MODE> __device__ __forceinline__ void row_load(RowRegs& R, const float* xin, const bf16_t* ybuf, const float* gwp, int t0, int lane) {
#pragma unroll
    for (int r = 0; r < 2; ++r) {
#pragma unroll
        for (int j = 0; j < 4; ++j) {
            if (MODE == 0) R.x[r][j] = *(const f32x4*)(xin + (size_t)(t0 + r) * D + 4 * lane + 256 * j);
            else { const u32x2 xv = *(const u32x2*)((const bf16_t*)xin + (size_t)(t0 + r) * D + 4 * lane + 256 * j);
                R.x[r][j][0] = __uint_as_float(xv.x << 16); R.x[r][j][1] = __uint_as_float(xv.x & 0xffff0000u); R.x[r][j][2] = __uint_as_float(xv.y << 16); R.x[r][j][3] = __uint_as_float(xv.y & 0xffff0000u); } }
        if (MODE == 2 || MODE == 3) { R.g[r][0] = gwp[(t0 + r) * 2]; R.g[r][1] = gwp[(t0 + r) * 2 + 1];
#pragma unroll
            for (int k = 0; k < 2; ++k)
#pragma unroll
                for (int j = 0; j < 4; ++j) R.y[r][k][j] = *(const unsigned*)((const unsigned char*)ybuf + ((size_t)(t0 + r) * 2 + k) * D + 4 * lane + 256 * j); }
    }
}
template <int MODE> __device__ __forceinline__ void ph_rowpass(Frame& F, int layer) {
    const int lane = F.lane;
    const float* modl = (const float*)(F.ws + WS_MOD) + (size_t)layer * B * 6 * D;
    LAS float* wl = (LAS float*)F.lds;
    constexpr int RWS = 1028;
    LAS int* r_e = (LAS int*)(F.lds + 32 * RWS * 4);
    LAS int* r_rank = r_e + 256;
    LAS int* r_cnt = r_rank + 256;
    LAS int* r_base = r_cnt + 32;
    if (MODE == 0) { const float* w = INP(I_EWIN); for (int i = F.tid; i < 8 * D; i += NTHREADS) { const int col = i >> 3, hh = i & 7; wl[hh * D + col] = w[(size_t)col * EVEN_PROJ + 2560 + hh]; } }
    if (MODE == 2) { const float* w = INP(I_OWIN); for (int i = F.tid; i < 16 * D; i += NTHREADS) { const int col = i >> 4, j = i & 15; wl[j * D + col] = w[(size_t)col * ODD_PROJ + 3072 + j]; } }
    if (MODE == 1) { const float* w = INP(I_RW); for (int i = F.tid; i < 32 * D; i += NTHREADS) { const int col = i >> 5, e = i & 31; wl[e * RWS + col] = w[i]; } }
    __syncthreads();
    const float* xin = (MODE == 0) ? INP(I_X) : (const float*)(F.ws + (MODE == 2 ? WS_RESA : WS_RESB));
    bf16_t* xn = (bf16_t*)(F.ws + WS_XN);
    const bf16_t* ybuf = (const bf16_t*)(F.ws + WS_YBUF);
    const float* gwp = (const float*)(F.ws + WS_GW);
    const float* gain = (MODE == 1 ? INP(I_NFFN) : INP(I_NMIX)) + layer * D;
    const float* rbias = INP(I_RB); const float* fbias = INP(I_EFB);
#pragma unroll 1
    for (int bc = F.bid; bc < T / 128; bc += F.G) {
        const int row0 = bc * 128 + F.wave * 16, b = row0 / S;
        LAS float* abl = (LAS float*)(F.lds + 32 * RWS * 4 + 4096);
        { const int bb = (bc * 128) / S; const int sho = (MODE == 1) ? 3 * D : 0, sco = (MODE == 1) ? 4 * D : D;
          const float* mp = (MODE == 2) ? (const float*)(F.ws + WS_MOD) : modl;
          __syncthreads();
          for (int c = F.tid; c < D; c += NTHREADS) {
              if (MODE != 3) { abl[c] = gain[c] * (1.f + modl[(size_t)bb * 6 * D + sco + c]); abl[D + c] = modl[(size_t)bb * 6 * D + sho + c]; }
              if (MODE == 2 || MODE == 3) abl[2 * D + c] = mp[(size_t)bb * 6 * D + 5 * D + c]; }
          __syncthreads(); }
        if (MODE == 1) { if (F.tid < 32) r_cnt[F.tid] = 0; }
        RowRegs cur, nxt;
        row_load<MODE>(cur, xin, ybuf, gwp, row0, lane);
#pragma unroll 1
        for (int pr = 0; pr < 8; ++pr) {
            const int t0 = row0 + 2 * pr;
            if (pr + 1 < 8) row_load<MODE>(nxt, xin, ybuf, gwp, t0 + 2, lane);
            int lo4 = 4 * lane; asm volatile("" : "+v"(lo4));
            if (MODE == 2 || MODE == 3) {
#pragma unroll
                for (int r = 0; r < 2; ++r) { const float g0 = cur.g[r][0], g1 = cur.g[r][1];
#pragma unroll
                    for (int j = 0; j < 4; ++j) { typedef float f32x2_ __attribute__((ext_vector_type(2)));
                        const f32x2_ a0 = __builtin_amdgcn_cvt_pk_f32_fp8((int)cur.y[r][0][j], false), a1 = __builtin_amdgcn_cvt_pk_f32_fp8((int)cur.y[r][0][j], true);
                        const f32x2_ c0 = __builtin_amdgcn_cvt_pk_f32_fp8((int)cur.y[r][1][j], false), c1 = __builtin_amdgcn_cvt_pk_f32_fp8((int)cur.y[r][1][j], true);
                        f32x4 y; y[0] = g0 * a0[0] + g1 * c0[0]; y[1] = g0 * a0[1] + g1 * c0[1]; y[2] = g0 * a1[0] + g1 * c1[0]; y[3] = g0 * a1[1] + g1 * c1[1];
                        cur.x[r][j] = cur.x[r][j] + *(const LAS f32x4*)(abl + 2 * D + lo4 + 256 * j) * y;
                        if (MODE == 3) *(f32x4*)(F.out + (size_t)(t0 + r) * D + 4 * lane + 256 * j) = cur.x[r][j];
                        else { u32x2 w; w.x = pk2(cur.x[r][j][0], cur.x[r][j][1]); w.y = pk2(cur.x[r][j][2], cur.x[r][j][3]); *(u32x2*)((bf16_t*)(F.ws + WS_RESB) + (size_t)(t0 + r) * D + 4 * lane + 256 * j) = w; } } }
            }
            if (MODE != 3) {
                float ss0 = 0.f, ss1 = 0.f;
#pragma unroll
                for (int j = 0; j < 4; ++j) { const f32x4 a = cur.x[0][j], c = cur.x[1][j]; ss0 += (a[0] * a[0] + a[1] * a[1]) + (a[2] * a[2] + a[3] * a[3]); ss1 += (c[0] * c[0] + c[1] * c[1]) + (c[2] * c[2] + c[3] * c[3]); }
#pragma unroll
                for (int o = 1; o < 64; o <<= 1) { ss0 += __shfl_xor(ss0, o); ss1 += __shfl_xor(ss1, o); }
                const float rs[2] = {rsqrtf(ss0 * (1.f / D) + EPS), rsqrtf(ss1 * (1.f / D) + EPS)};
                f32x4 h[2][4];
#pragma unroll
                for (int r = 0; r < 2; ++r)
#pragma unroll
                    for (int j = 0; j < 4; ++j) { const f32x4 Aj = *(const LAS f32x4*)(abl + lo4 + 256 * j), Bj = *(const LAS f32x4*)(abl + D + lo4 + 256 * j);
                        h[r][j] = cur.x[r][j] * rs[r] * Aj + Bj;
                        if (MODE == 2) *(unsigned*)((unsigned char*)xn + (size_t)(t0 + r) * D + 4 * lane + 256 * j) = pk4_fp8(h[r][j][0], h[r][j][1], h[r][j][2], h[r][j][3]);
                        else { u32x2 w; w.x = pk2(h[r][j][0], h[r][j][1]); w.y = pk2(h[r][j][2], h[r][j][3]); *(u32x2*)(xn + (size_t)(t0 + r) * D + 4 * lane + 256 * j) = w; } }
                constexpr int NQ = (MODE == 0) ? 8 : (MODE == 2) ? 16 : 32;
                constexpr int WS_ = (MODE == 1) ? RWS : D;
                float a0[NQ], a1[NQ];
#pragma unroll
                for (int q = 0; q < NQ; ++q) { a0[q] = 0.f; a1[q] = 0.f;
#pragma unroll
                    for (int j = 0; j < 4; ++j) { const f32x4 w = *(const LAS f32x4*)(wl + q * WS_ + lo4 + 256 * j);
                        a0[q] += (h[0][j][0] * w[0] + h[0][j][1] * w[1]) + (h[0][j][2] * w[2] + h[0][j][3] * w[3]); a1[q] += (h[1][j][0] * w[0] + h[1][j][1] * w[1]) + (h[1][j][2] * w[2] + h[1][j][3] * w[3]); } }
                xreduce<NQ>(a0, lane); xreduce<NQ>(a1, lane);
                if (MODE == 0) { if ((lane & 7) == 0) { const int q = lane >> 3; float* lf = (float*)(F.ws + WS_LOGF); const float fb = fbias[q]; lf[(size_t)t0 * 8 + q] = logsigmoidf_(a0[0] + fb); lf[(size_t)(t0 + 1) * 8 + q] = logsigmoidf_(a1[0] + fb); } }
                if (MODE == 2) { if ((lane & 3) == 0) { float* gl = (float*)(F.ws + WS_GLOW); gl[(size_t)t0 * 16 + (lane >> 2)] = a0[0]; gl[(size_t)(t0 + 1) * 16 + (lane >> 2)] = a1[0]; } }
                if (MODE == 1) {
                    const int e = lane >> 1; const float rbe = rbias[e];
#pragma unroll
                    for (int r = 0; r < 2; ++r) {
                        const float sc = sigmoidf_(r ? a1[0] : a0[0]); const float sel = sc + rbe;
                        float m1 = sel, s1 = sc; int e1 = e;
#pragma unroll
                        for (int o = 2; o <= 8; o <<= 1) { const float ov = __shfl_xor(m1, o), os = __shfl_xor(s1, o); const int oe = __shfl_xor(e1, o); if (ov > m1 || (ov == m1 && oe < e1)) { m1 = ov; s1 = os; e1 = oe; } }
                        float m2 = (e == e1) ? -INFINITY : sel, s2 = sc; int e2 = e;
#pragma unroll
                        for (int o = 2; o <= 8; o <<= 1) { const float ov = __shfl_xor(m2, o), os = __shfl_xor(s2, o); const int oe = __shfl_xor(e2, o); if (ov > m2 || (ov == m2 && oe < e2)) { m2 = ov; s2 = os; e2 = oe; } }
                        float gs = m1 + m2; int g = e >> 3;
#pragma unroll
                        for (int o = 16; o <= 32; o <<= 1) { const float ogs = __shfl_xor(gs, o); const int og = __shfl_xor(g, o); const float os1 = __shfl_xor(s1, o), os2 = __shfl_xor(s2, o); const int oe1 = __shfl_xor(e1, o), oe2 = __shfl_xor(e2, o);
                            if (ogs > gs || (ogs == gs && og < g)) { gs = ogs; g = og; s1 = os1; s2 = os2; e1 = oe1; e2 = oe2; } }
                        if (lane == 0) { const int t = t0 + r; const float inv = 1.f / (s1 + s2);
                            ((float*)(F.ws + WS_GW))[t * 2] = s1 * inv; ((float*)(F.ws + WS_GW))[t * 2 + 1] = s2 * inv;
                            const int lr = (t - bc * 128) * 2; r_e[lr] = e1; r_e[lr + 1] = e2; }
                    }
                }
            }
            if (pr + 1 < 8) cur = nxt;
        }
        if (MODE == 1) {
            __syncthreads();
            unsigned* cnt = (unsigned*)(F.ws + WS_CTL) + CW_CNT + 32 * layer; int* list = (int*)(F.ws + WS_LIST);
            if (F.tid < 256) r_rank[F.tid] = atomicAdd((int*)&r_cnt[r_e[F.tid]], 1);
            __syncthreads();
            if (F.tid < 32) r_base[F.tid] = (int)atomicAdd(&cnt[F.tid], (unsigned)r_cnt[F.tid]);
            __syncthreads();
            if (F.tid < 256) { const int e = r_e[F.tid]; list[e * LCAP + r_base[e] + r_rank[F.tid]] = (bc * 128) * 2 + F.tid; }
            __syncthreads();
        }
    }
}


__device__ __forceinline__ void ph_router(Frame& F, int layer) {
    typedef short bf16x8 __attribute__((ext_vector_type(8)));
    const int lane = F.lane, w = F.wave, tid = F.tid;
    const float* modl = (const float*)(F.ws + WS_MOD) + (size_t)layer * B * 6 * D;
    constexpr int HP = 2064;
    LAS unsigned char* hth = F.lds;
    LAS unsigned char* htl = F.lds + 16 * HP;
    LAS float* PL = (LAS float*)(F.lds + 32 * HP);
    LAS float* abl = (LAS float*)(F.lds + 32 * HP + 16384);
    LAS int* r_e = (LAS int*)(F.lds + 32 * HP + 16384 + 8192);
    LAS int* r_rank = r_e + 256; LAS int* r_cnt = r_rank + 256; LAS int* r_base = r_cnt + 32;
    bf16x8 Bh[4][2], Bl[4][2];
    { const float* rw = INP(I_RW);
#pragma unroll
      for (int ks = 0; ks < 4; ++ks)
#pragma unroll
          for (int nt = 0; nt < 2; ++nt) { union { bf16x8 v; unsigned u[4]; } hh, ll; float hv[8], lv[8];
#pragma unroll
              for (int j = 0; j < 8; ++j) { const float v = rw[(size_t)(128 * w + 32 * ks + 8 * (lane >> 4) + j) * NE + 16 * nt + (lane & 15)]; const float hf = __uint_as_float(f2bf(v) << 16); hv[j] = hf; lv[j] = v - hf; }
#pragma unroll
              for (int q = 0; q < 4; ++q) { hh.u[q] = pk2(hv[2 * q], hv[2 * q + 1]); ll.u[q] = pk2(lv[2 * q], lv[2 * q + 1]); }
              Bh[ks][nt] = hh.v; Bl[ks][nt] = ll.v; } }
    const float* xin = (const float*)(F.ws + (layer ? WS_RESB : WS_RESA));
    bf16_t* xn = (bf16_t*)(F.ws + WS_XN);
    const float* gain = INP(I_NFFN) + layer * D; const float* rbias = INP(I_RB);
#pragma unroll 1
    for (int bc = F.bid; bc < T / 128; bc += F.G) {
        { const int bb = (bc * 128) / S;
          __syncthreads();
          for (int c = tid; c < D; c += NTHREADS) { abl[c] = gain[c] * (1.f + modl[(size_t)bb * 6 * D + 4 * D + c]); abl[D + c] = modl[(size_t)bb * 6 * D + 3 * D + c]; }
          if (tid < 32) r_cnt[tid] = 0;
          __syncthreads(); }
        RowRegs cur, nxt;
        row_load<1>(cur, xin, nullptr, nullptr, bc * 128 + 2 * w, lane);
#pragma unroll 1
        for (int g = 0; g < 8; ++g) {
            const int t0 = bc * 128 + 16 * g + 2 * w;
            row_load<1>(nxt, xin, nullptr, nullptr, g + 1 < 8 ? t0 + 16 : t0, lane);
            int lo4 = 4 * lane; asm volatile("" : "+v"(lo4));
            float ss0 = 0.f, ss1 = 0.f;
#pragma unroll
            for (int j = 0; j < 4; ++j) { const f32x4 a = cur.x[0][j], c = cur.x[1][j]; ss0 += (a[0] * a[0] + a[1] * a[1]) + (a[2] * a[2] + a[3] * a[3]); ss1 += (c[0] * c[0] + c[1] * c[1]) + (c[2] * c[2] + c[3] * c[3]); }
#pragma unroll
            for (int o = 1; o < 64; o <<= 1) { ss0 += __shfl_xor(ss0, o); ss1 += __shfl_xor(ss1, o); }
            const float rs[2] = {rsqrtf(ss0 * (1.f / D) + EPS), rsqrtf(ss1 * (1.f / D) + EPS)};
#pragma unroll
            for (int r = 0; r < 2; ++r)
#pragma unroll
                for (int j = 0; j < 4; ++j) { const f32x4 Aj = *(const LAS f32x4*)(abl + lo4 + 256 * j), Bj = *(const LAS f32x4*)(abl + D + lo4 + 256 * j);
                    const f32x4 h = cur.x[r][j] * rs[r] * Aj + Bj;
                    u32x2 wh; wh.x = pk2(h[0], h[1]); wh.y = pk2(h[2], h[3]);
                    *(unsigned*)((unsigned char*)xn + (size_t)(t0 + r) * D + 4 * lane + 256 * j) = pk4_fp8(h[0], h[1], h[2], h[3]);
                    u32x2 wl; wl.x = pk2(h[0] - __uint_as_float(wh.x << 16), h[1] - __uint_as_float(wh.x & 0xffff0000u)); wl.y = pk2(h[2] - __uint_as_float(wh.y << 16), h[3] - __uint_as_float(wh.y & 0xffff0000u));
                    *(LAS u32x2*)(hth + (2 * w + r) * HP + (lo4 + 256 * j) * 2) = wh; *(LAS u32x2*)(htl + (2 * w + r) * HP + (lo4 + 256 * j) * 2) = wl; }
            LDS_BARRIER();
            f32x4 acc[2] = {(f32x4){0.f, 0.f, 0.f, 0.f}, (f32x4){0.f, 0.f, 0.f, 0.f}};
#pragma unroll
            for (int ks = 0; ks < 4; ++ks) { const int ao = (lane & 15) * HP + (128 * w + 32 * ks + 8 * (lane >> 4)) * 2;
                const bf16x8 ah = *(const LAS bf16x8*)(hth + ao), al = *(const LAS bf16x8*)(htl + ao);
#pragma unroll
                for (int nt = 0; nt < 2; ++nt) { acc[nt] = __builtin_amdgcn_mfma_f32_16x16x32_bf16(ah, Bh[ks][nt], acc[nt], 0, 0, 0); acc[nt] = __builtin_amdgcn_mfma_f32_16x16x32_bf16(al, Bh[ks][nt], acc[nt], 0, 0, 0);
                    acc[nt] = __builtin_amdgcn_mfma_f32_16x16x32_bf16(ah, Bl[ks][nt], acc[nt], 0, 0, 0); } }
#pragma unroll
            for (int nt = 0; nt < 2; ++nt)
#pragma unroll
                for (int q = 0; q < 4; ++q) PL[(w * 16 + (lane >> 4) * 4 + q) * 32 + 16 * nt + (lane & 15)] = acc[nt][q];
            LDS_BARRIER();
            const int e = lane >> 1; const float rbe = rbias[e];
#pragma unroll
            for (int r = 0; r < 2; ++r) {
                float lg = 0.f;
#pragma unroll
                for (int ww = 0; ww < 8; ++ww) lg += PL[(ww * 16 + 2 * w + r) * 32 + e];
                const float sc = sigmoidf_(lg); const float sel = sc + rbe;
                float m1 = sel, s1 = sc; int e1 = e;
#pragma unroll
                for (int o = 2; o <= 8; o <<= 1) { const float ov = __shfl_xor(m1, o), os = __shfl_xor(s1, o); const int oe = __shfl_xor(e1, o); if (ov > m1 || (ov == m1 && oe < e1)) { m1 = ov; s1 = os; e1 = oe; } }
                float m2 = (e == e1) ? -INFINITY : sel, s2 = sc; int e2 = e;
#pragma unroll
                for (int o = 2; o <= 8; o <<= 1) { const float ov = __shfl_xor(m2, o), os = __shfl_xor(s2, o); const int oe = __shfl_xor(e2, o); if (ov > m2 || (ov == m2 && oe < e2)) { m2 = ov; s2 = os; e2 = oe; } }
                float gs = m1 + m2; int gg = e >> 3;
#pragma unroll
                for (int o = 16; o <= 32; o <<= 1) { const float ogs = __shfl_xor(gs, o); const int og = __shfl_xor(gg, o); const float os1 = __shfl_xor(s1, o), os2 = __shfl_xor(s2, o); const int oe1 = __shfl_xor(e1, o), oe2 = __shfl_xor(e2, o);
                    if (ogs > gs || (ogs == gs && og < gg)) { gs = ogs; gg = og; s1 = os1; s2 = os2; e1 = oe1; e2 = oe2; } }
                if (lane == 0) { const int t = t0 + r; const float inv = 1.f / (s1 + s2);
                    ((float*)(F.ws + WS_GW))[t * 2] = s1 * inv; ((float*)(F.ws + WS_GW))[t * 2 + 1] = s2 * inv;
                    const int lr = (t - bc * 128) * 2; r_e[lr] = e1; r_e[lr + 1] = e2; }
            }
            cur = nxt;
        }
        __syncthreads();
        unsigned* cnt = (unsigned*)(F.ws + WS_CTL) + CW_CNT + 32 * layer; int* list = (int*)(F.ws + WS_LIST);
        if (tid < 256) r_rank[tid] = atomicAdd((int*)&r_cnt[r_e[tid]], 1);
        __syncthreads();
        if (tid < 32) r_base[tid] = (int)atomicAdd(&cnt[tid], (unsigned)r_cnt[tid]);
        __syncthreads();
        if (tid < 256) { const int ee = r_e[tid]; list[ee * LCAP + r_base[ee] + r_rank[tid]] = (bc * 128) * 2 + tid; }
        __syncthreads();
    }
}

__global__ void __launch_bounds__(NTHREADS, 2) mk_fwd(Args args) {
    extern __shared__ __attribute__((aligned(16))) unsigned char lds_raw[];
    Frame F;
    F.lds = (LAS unsigned char*)lds_raw; F.tid = threadIdx.x; F.lane = F.tid & 63; F.wave = __builtin_amdgcn_readfirstlane(F.tid >> 6); F.G = gridDim.x; F.bid = blockIdx.x;
    if (F.tid == 0) {
#pragma unroll
        for (int i = 0; i < 28; ++i) *(LAS unsigned long long*)(F.lds + LDS_PTRS + 8 * i) = (unsigned long long)args.in[i];
    }
    F.out = args.out; F.ws = args.ws;
    const int lo = args.ph_lo, hi = args.ph_hi;
#define IN(k) (lo <= (k) && (k) < hi)
    volatile LAS unsigned* MISC = (volatile LAS unsigned*)(F.lds + LDS_BYTES - 256);
    if (F.tid < 64) MISC[F.tid] = 0u;
    __syncthreads();
    XcdBarrier bar = xcd_barrier_post((unsigned*)(F.ws + WS_CTL) + CW_BAR, MISC);
    unsigned long long t_mark = 0ull; float t_delta = 0.f;
    if (TIMED_PHASE == 0) t_mark = __builtin_amdgcn_s_memrealtime();
#define SEAM(k) do { if (TIMED_PHASE >= 0 && TIMED_LOCAL && (k) == TIMED_PHASE) t_delta = (float)(__builtin_amdgcn_s_memrealtime() - t_mark) * 0.01f * TIME_SCALE; if (IN(k) && IN((k) + 1)) xcd_barrier(bar); frame_refresh(F); \
        if (TIMED_PHASE >= 0) { const unsigned long long tn_ = __builtin_amdgcn_s_memrealtime(); if ((k) == TIMED_PHASE && !TIMED_LOCAL) t_delta = (float)(tn_ - t_mark) * 0.01f * TIME_SCALE; if ((k) + 1 == TIMED_PHASE) t_mark = tn_; } } while (0)
    LAS int* tpre = (LAS int*)(F.lds + pg8::STAGE_BYTES);
    if (IN(0)) REPEAT(0) ph_prologue(F);
    SEAM(0);
    if (IN(1)) REPEAT(1) ph_rowpass<0>(F, 0);
    SEAM(1);
    if (IN(2)) REPEAT(2) {
        fb_cumsum(F);
        pg8::DenseSched Sd; Sd.init(T, P0W, D, F.ws + WS_WIN0T, F.G, F.bid);
        pg8::EpiProj0 E{(bf16_t*)(F.ws + WS_PROJ), INP(I_EQG), INP(I_EKG)};
        pg8::gemm_phase<pg8::EpiProj0, pg8::DenseSched, true>(F.lds, (const char*)(F.ws + WS_XN), D, Sd, E);
        conv_tail_w13(F);
    }
    SEAM(2);
    if (IN(3)) REPEAT(3) ph_mixer0(F, lds_raw, rep_);
    SEAM(3);
    {
        if (IN(4)) _Pragma("unroll 1") for (int rep_ = 0; rep_ < REP[4]; ++rep_, __syncthreads()) {
            pg8::DenseSched Sd; Sd.init(T, D, D, F.ws + (WS_WOUT0T), F.G, F.bid);
            pg8::EpiResid E{INP(I_X), nullptr, (bf16_t*)(F.ws + WS_RESA), (const float*)(F.ws + WS_MOD) + (size_t)0 * B * 6 * D + 2 * D};
            pg8::gemm_phase<pg8::EpiResid, pg8::DenseSched, true>(F.lds, (const char*)(F.ws + WS_YMIX), D, Sd, E);
        }
        SEAM(4);
        if (IN(5)) ph_router(F, 0);
        SEAM(5);
        if (IN(6)) REPEAT(6) {
            pg8::MoeSched<true> Sm; Sm.init((const unsigned*)(F.ws + WS_CTL) + CW_CNT + 0, (const int*)(F.ws + WS_LIST), F.ws + WS_W13T + (size_t)0 * 64 * MiB, (size_t)1024 * 1024, D / 2, F.G, F.bid, tpre);
            pg8::EpiMoe1 E{F.ws + WS_HID};
            pg8::gemm_phase<pg8::EpiMoe1, pg8::MoeSched<true>, true, true, 121>(F.lds, (const char*)(F.ws + WS_XN), D / 2, Sm, E);
            conv_tail_w2(F);
        }
        SEAM(6);
        if (IN(7)) REPEAT(7) {
            pg8::MoeSched<false> Sm; Sm.init((const unsigned*)(F.ws + WS_CTL) + CW_CNT + 0, (const int*)(F.ws + WS_LIST), F.ws + WS_W2T + (size_t)0 * 32 * MiB, (size_t)1024 * 512, DE / 2, F.G, F.bid, tpre);
            pg8::EpiMoe2 E{(bf16_t*)(F.ws + WS_YBUF), (const int*)(F.ws + WS_LIST), tpre};
            pg8::gemm_phase<pg8::EpiMoe2, pg8::MoeSched<false>, true, true, 121>(F.lds, (const char*)(F.ws + WS_HID), DE / 2, Sm, E);
            conv_tail_l1(F);
        }
        SEAM(7);
    }
    {
            if (IN(8)) ph_rowpass<2>(F, 1);
            SEAM(8);
            if (IN(9)) REPEAT(9) {
                pg8::DenseSched Sd; Sd.init(T, P1W, D / 2, F.ws + WS_WIN1T, F.G, F.bid);
                pg8::EpiBf16 E{(bf16_t*)(F.ws + WS_PROJ), P1W};
                pg8::gemm_phase<pg8::EpiBf16, pg8::DenseSched, true, true, 121>(F.lds, (const char*)(F.ws + WS_XN), D / 2, Sd, E);
            }
            SEAM(9);
            if (IN(10)) REPEAT(10) gla::ph_g1(F);
            SEAM(10);
            if (IN(11)) REPEAT(11) gla::ph_g2(F);
            SEAM(11);
            if (IN(12)) REPEAT(12) gla::ph_g3(F);
            SEAM(12);
    }
    {
        if (IN(13)) _Pragma("unroll 1") for (int rep_ = 0; rep_ < 1; ++rep_, __syncthreads()) {
            pg8::DenseSched Sd; Sd.init(T, D, D, F.ws + (WS_WOUT1T), F.G, F.bid);
            pg8::EpiResid E{nullptr, (const bf16_t*)(F.ws + WS_RESB), (bf16_t*)(F.ws + WS_RESB), (const float*)(F.ws + WS_MOD) + (size_t)1 * B * 6 * D + 2 * D};
            pg8::gemm_phase<pg8::EpiResid, pg8::DenseSched, true>(F.lds, (const char*)(F.ws + WS_YMIX), D, Sd, E);
        }
        SEAM(13);
        if (IN(14)) ph_router(F, 1);
        SEAM(14);
        if (IN(15)) REPEAT(6) {
            pg8::MoeSched<true> Sm; Sm.init((const unsigned*)(F.ws + WS_CTL) + CW_CNT + 32, (const int*)(F.ws + WS_LIST), F.ws + WS_W13T + (size_t)1 * 64 * MiB, (size_t)1024 * 1024, D / 2, F.G, F.bid, tpre);
            pg8::EpiMoe1 E{F.ws + WS_HID};
            pg8::gemm_phase<pg8::EpiMoe1, pg8::MoeSched<true>, true, true, 121>(F.lds, (const char*)(F.ws + WS_XN), D / 2, Sm, E);
        }
        SEAM(15);
        if (IN(16)) REPEAT(7) {
            pg8::MoeSched<false> Sm; Sm.init((const unsigned*)(F.ws + WS_CTL) + CW_CNT + 32, (const int*)(F.ws + WS_LIST), F.ws + WS_W2T + (size_t)1 * 32 * MiB, (size_t)1024 * 512, DE / 2, F.G, F.bid, tpre);
            pg8::EpiMoe2 E{(bf16_t*)(F.ws + WS_YBUF), (const int*)(F.ws + WS_LIST), tpre};
            pg8::gemm_phase<pg8::EpiMoe2, pg8::MoeSched<false>, true, true, 121>(F.lds, (const char*)(F.ws + WS_HID), DE / 2, Sm, E);
        }
        SEAM(16);
    }
    if (IN(17)) ph_rowpass<3>(F, 1);
    if (TIMED_PHASE >= 0 && F.bid == TIMED_BLOCK && F.tid == 0) { if (TIMED_PHASE == 17) t_delta = (float)(__builtin_amdgcn_s_memrealtime() - t_mark) * 0.01f * TIME_SCALE; F.out[(size_t)TIMED_BLOCK * 128 * D] += t_delta; }
#undef SEAM
#undef IN
}

extern "C" void kernel_launch(void* const* d_in, const int* in_sizes, int n_in, void* d_out, int out_size, void* d_ws, size_t ws_size, hipStream_t stream) {
    static int grid = 0;
    if (grid == 0) {
        if (n_in != 28 || out_size != T * D || ws_size < WS_END) { fprintf(stderr, "kernel_launch: unexpected shapes (n_in %d out %d ws %zu)\n", n_in, out_size, ws_size); grid = -1; return; }
        int dev = 0, cus = 0, per_cu = 0;
        (void)hipGetDevice(&dev); (void)hipDeviceGetAttribute(&cus, hipDeviceAttributeMultiprocessorCount, dev);
        (void)hipFuncSetAttribute((const void*)mk_fwd, hipFuncAttributeMaxDynamicSharedMemorySize, LDS_BYTES);
        if (hipOccupancyMaxActiveBlocksPerMultiprocessor(&per_cu, (const void*)mk_fwd, NTHREADS, LDS_BYTES) != hipSuccess || per_cu < 1) { fprintf(stderr, "occupancy query failed (%d)\n", per_cu); per_cu = 1; }
        (void)hipGetLastError();
        grid = cus * 1;
        if (per_cu < 1) grid = -1;
    }
    if (grid < 0) return;
    const float* in[28]; for (int i = 0; i < 28; ++i) in[i] = (const float*)d_in[i];
    unsigned char* ws = (unsigned char*)d_ws; float* out = (float*)d_out;
    float* mod = (float*)(ws + WS_MOD); int* eidx = (int*)(ws + WS_EIDX); float* gw = (float*)(ws + WS_GW); float* logf = (float*)(ws + WS_LOGF); float* fb = (float*)(ws + WS_FB);
    float* glow = (float*)(ws + WS_GLOW); int* list = (int*)(ws + WS_LIST); unsigned* ctl = (unsigned*)(ws + WS_CTL);
    bf16_t* win0t = (bf16_t*)(ws + WS_WIN0T); bf16_t* wout0t = (bf16_t*)(ws + WS_WOUT0T); bf16_t* win1t = (bf16_t*)(ws + WS_WIN1T); bf16_t* wout1t = (bf16_t*)(ws + WS_WOUT1T);
    bf16_t* w13t = (bf16_t*)(ws + WS_W13T); bf16_t* w2t = (bf16_t*)(ws + WS_W2T); bf16_t* xn = (bf16_t*)(ws + WS_XN); bf16_t* ymix = (bf16_t*)(ws + WS_YMIX);
    bf16_t* proj = (bf16_t*)(ws + WS_PROJ); bf16_t* hid = (bf16_t*)(ws + WS_HID); bf16_t* ybuf = (bf16_t*)(ws + WS_YBUF); bf16_t* obuf = (bf16_t*)(ws + WS_XN);
    auto mk = [&](int lo, int hi) { Args a{}; for (int i = 0; i < 28; ++i) a.in[i] = in[i]; a.out = out; a.ws = ws; a.ph_lo = lo; a.ph_hi = hi;
        hipLaunchKernelGGL(mk_fwd, dim3(grid), dim3(NTHREADS), LDS_BYTES, stream, a); };
    (void)hipMemsetAsync(ws + WS_CTL, 0, CTL_ZERO_BYTES, stream);
    mk(0, 18);
}
```
